# Optimizing an MI355X kernel written in HIP

```python
import jax, jax.numpy as jnp
from jax import lax
import numpy as np

D_MODEL = 1024
BATCH = 2
SEQ = 16384
DEPTH = 2

HEAD_DIM = 64
N_HEADS = D_MODEL // HEAD_DIM
H_FOX = N_HEADS // 2
H_NSA = N_HEADS - H_FOX
NSA_GROUPS = 2
H_MOBA = N_HEADS
D_FF = -(-(8 * D_MODEL) // (3 * 256)) * 256
ROPE_THETA = 10000.0
RMS_EPS = 1e-6
Q_BLOCK = 128
CMP_STRIDE = 16
CMP_LEN = 2 * CMP_STRIDE
CMP_HIDDEN = 4 * HEAD_DIM
SLC_BLOCK = 64
SLC_TOPN = 16
WINDOW = 512
MOBA_BLOCK = 256
MOBA_TOPK = 3
MOBA_Q_CHUNK = 32
NEG_INF = -1e30

EVEN_SPLITS = (3 * [H_FOX * HEAD_DIM] + [H_FOX] + [H_NSA * HEAD_DIM]
               + 6 * [NSA_GROUPS * HEAD_DIM] + [3 * H_NSA])
EVEN_IN = sum(EVEN_SPLITS)
EVEN_SPLIT_IDX = [int(c) for c in np.cumsum(EVEN_SPLITS)[:-1]]

kernel_name = 'hybrid_fox_nsa_moba_trunk'


def rmsnorm(x, g):
    xf = x.astype(jnp.float32)
    y = xf * lax.rsqrt(jnp.mean(xf * xf, axis=-1, keepdims=True) + RMS_EPS)
    return (y * g.astype(jnp.float32)).astype(x.dtype)


def to_heads(t, n):
    b, s, _ = t.shape
    return t.reshape(b, s, n, HEAD_DIM).transpose(0, 2, 1, 3)


def from_heads(t):
    b, h, s, d = t.shape
    return t.transpose(0, 2, 1, 3).reshape(b, s, h * d)


def rope_tables(s):
    inv = ROPE_THETA ** (-jnp.arange(0, HEAD_DIM, 2, dtype=jnp.float32) / HEAD_DIM)
    ang = jnp.arange(s, dtype=jnp.float32)[:, None] * inv[None, :]
    return jnp.cos(ang), jnp.sin(ang)


def apply_rope(t, cos, sin):
    tf = t.astype(jnp.float32)
    t1, t2 = tf[..., :HEAD_DIM // 2], tf[..., HEAD_DIM // 2:]
    return jnp.concatenate([t1 * cos - t2 * sin, t2 * cos + t1 * sin], axis=-1).astype(t.dtype)


def masked_softmax(s, mask):
    s = jnp.where(mask, s, NEG_INF)
    e = jnp.where(mask, jnp.exp(s - jnp.max(s, axis=-1, keepdims=True)), 0.0)
    return e / jnp.maximum(jnp.sum(e, axis=-1, keepdims=True), 1e-30)


def sweep(fn, s, block):
    out = lax.map(fn, jnp.arange(s // block))
    nb, b, h, q, d = out.shape
    return out.transpose(1, 2, 0, 3, 4).reshape(b, h, nb * q, d)


def fox_attention(q, k, v, log_f):
    b, h, s, d = q.shape
    c = jnp.cumsum(log_f, axis=-1)
    kpos = jnp.arange(s)
    scale = d ** -0.5

    def block(i):
        qs = i * Q_BLOCK
        qb = lax.dynamic_slice_in_dim(q, qs, Q_BLOCK, axis=2)
        cb = lax.dynamic_slice_in_dim(c, qs, Q_BLOCK, axis=2)
        qpos = qs + jnp.arange(Q_BLOCK)
        sc = (jnp.einsum('bhqd,bhkd->bhqk', qb, k, preferred_element_type=jnp.float32) * scale
              + cb[..., :, None] - c[..., None, :])
        p = masked_softmax(sc, kpos[None, :] <= qpos[:, None])
        return jnp.einsum('bhqk,bhkd->bhqd', p.astype(v.dtype), v)

    return sweep(block, s, Q_BLOCK)


def nsa_compress(t, pe, w1, w2):
    b, g, s, d = t.shape
    ch = t.reshape(b, g, s // CMP_STRIDE, CMP_STRIDE, d)
    blk = jnp.concatenate([ch[:, :, :-1], ch[:, :, 1:]], axis=3) + pe
    blk = blk.reshape(b, g, blk.shape[2], CMP_LEN * d)
    return jax.nn.gelu(blk @ w1) @ w2


def nsa_attention(q, kc, vc, ks, vs, kw, vw, gates):
    b, h, s, d = q.shape
    g = ks.shape[1]
    r = h // g
    nc = kc.shape[2]
    ns = s // SLC_BLOCK
    n_sel = min(SLC_TOPN, ns)
    ratio = SLC_BLOCK // CMP_STRIDE
    scale = d ** -0.5
    cmp_end = jnp.arange(nc) * CMP_STRIDE + CMP_LEN - 1
    ks_blk = ks.reshape(b, g, ns, SLC_BLOCK, d)
    vs_blk = vs.reshape(b, g, ns, SLC_BLOCK, d)
    wpad = ((0, 0), (0, 0), (WINDOW, 0), (0, 0))
    kw_pad, vw_pad = jnp.pad(kw, wpad), jnp.pad(vw, wpad)
    bi = jnp.arange(b)[:, None, None, None]
    gi = jnp.arange(g)[None, :, None, None]
    sblk = jnp.arange(ns)

    def block(i):
        qs = i * Q_BLOCK
        qpos = qs + jnp.arange(Q_BLOCK)
        qb = lax.dynamic_slice_in_dim(q, qs, Q_BLOCK, axis=2).reshape(b, g, r, Q_BLOCK, d)
        gb = lax.dynamic_slice_in_dim(gates, qs, Q_BLOCK, axis=2).reshape(b, g, r, Q_BLOCK, 3)
        sc = jnp.einsum('bgrqd,bgcd->bgrqc', qb, kc, preferred_element_type=jnp.float32) * scale
        pc = masked_softmax(sc, cmp_end[None, :] <= qpos[:, None])
        oc = jnp.einsum('bgrqc,bgcd->bgrqd', pc.astype(vc.dtype), vc)
        imp = jnp.pad(pc.sum(axis=2), ((0, 0), (0, 0), (0, 0), (1, 1)))
        imp = imp[..., :ratio * ns].reshape(b, g, Q_BLOCK, ns, ratio).sum(-1) + imp[..., ratio::ratio]
        qblk = qpos // SLC_BLOCK
        forced = ((sblk[None, :] == 0) | (sblk[None, :] == qblk[:, None])
                  | (sblk[None, :] == qblk[:, None] - 1))
        imp = jnp.where(forced, 1e9, jnp.where(sblk[None, :] > qblk[:, None], -1e9, imp))
        _, idx = lax.top_k(imp, n_sel)
        ksel = ks_blk[bi, gi, idx].reshape(b, g, Q_BLOCK, n_sel * SLC_BLOCK, d)
        vsel = vs_blk[bi, gi, idx].reshape(b, g, Q_BLOCK, n_sel * SLC_BLOCK, d)
        spos = (idx[..., None] * SLC_BLOCK + jnp.arange(SLC_BLOCK)).reshape(b, g, 1, Q_BLOCK, n_sel * SLC_BLOCK)
        ss = jnp.einsum('bgrqd,bgqkd->bgrqk', qb, ksel, preferred_element_type=jnp.float32) * scale
        psl = masked_softmax(ss, spos <= qpos[:, None])
        osl = jnp.einsum('bgrqk,bgqkd->bgrqd', psl.astype(vsel.dtype), vsel)
        kwin = lax.dynamic_slice_in_dim(kw_pad, qs, WINDOW + Q_BLOCK, axis=2)
        vwin = lax.dynamic_slice_in_dim(vw_pad, qs, WINDOW + Q_BLOCK, axis=2)
        wpos = qs - WINDOW + jnp.arange(WINDOW + Q_BLOCK)
        dlt = qpos[:, None] - wpos[None, :]
        sw = jnp.einsum('bgrqd,bgkd->bgrqk', qb, kwin, preferred_element_type=jnp.float32) * scale
        pw = masked_softmax(sw, (dlt >= 0) & (dlt < WINDOW) & (wpos[None, :] >= 0))
        ow = jnp.einsum('bgrqk,bgkd->bgrqd', pw.astype(vwin.dtype), vwin)
        o = gb[..., 0:1] * oc + gb[..., 1:2] * osl + gb[..., 2:3] * ow
        return o.reshape(b, h, Q_BLOCK, d).astype(q.dtype)

    return sweep(block, s, Q_BLOCK)


def moba_attention(q, k, v):
    b, h, s, d = q.shape
    s_pad = -(-s // MOBA_BLOCK) * MOBA_BLOCK
    pad = ((0, 0), (0, 0), (0, s_pad - s), (0, 0))
    kp, vp = jnp.pad(k, pad), jnp.pad(v, pad)
    nb = s_pad // MOBA_BLOCK
    n_top = min(MOBA_TOPK, nb)
    n_s = n_top * MOBA_BLOCK
    kb = kp.reshape(b, h, nb, MOBA_BLOCK, d)
    vb = vp.reshape(b, h, nb, MOBA_BLOCK, d)
    kbar = jnp.mean(kb.astype(jnp.float32), axis=3)
    bi = jnp.arange(b)[:, None, None, None]
    hi = jnp.arange(h)[None, :, None, None]
    blk_ids = jnp.arange(nb)
    scale = d ** -0.5

    def chunk(i):
        qs = i * MOBA_Q_CHUNK
        cur = qs // MOBA_BLOCK
        qpos = qs + jnp.arange(MOBA_Q_CHUNK)
        qb = lax.dynamic_slice_in_dim(q, qs, MOBA_Q_CHUNK, axis=2)
        gate = jnp.einsum('bhqd,bhnd->bhqn', qb.astype(jnp.float32), kbar)
        gate = jnp.where(blk_ids < cur, gate, NEG_INF)
        _, idx = lax.top_k(gate, n_top)
        valid = jnp.broadcast_to((idx < cur)[..., None], idx.shape + (MOBA_BLOCK,))
        valid = valid.reshape(b, h, MOBA_Q_CHUNK, n_s)
        ksel = kb[bi, hi, idx].reshape(b, h, MOBA_Q_CHUNK, n_s, d)
        vsel = vb[bi, hi, idx].reshape(b, h, MOBA_Q_CHUNK, n_s, d)
        kown = lax.dynamic_slice_in_dim(kp, cur * MOBA_BLOCK, MOBA_BLOCK, axis=2)
        vown = lax.dynamic_slice_in_dim(vp, cur * MOBA_BLOCK, MOBA_BLOCK, axis=2)
        own_pos = cur * MOBA_BLOCK + jnp.arange(MOBA_BLOCK)
        own_mask = jnp.broadcast_to(own_pos[None, :] <= qpos[:, None], (b, h, MOBA_Q_CHUNK, MOBA_BLOCK))
        s_sel = jnp.einsum('bhqd,bhqkd->bhqk', qb, ksel, preferred_element_type=jnp.float32)
        s_own = jnp.einsum('bhqd,bhkd->bhqk', qb, kown, preferred_element_type=jnp.float32)
        p = masked_softmax(jnp.concatenate([s_sel, s_own], axis=-1) * scale,
                           jnp.concatenate([valid, own_mask], axis=-1)).astype(v.dtype)
        return (jnp.einsum('bhqk,bhqkd->bhqd', p[..., :n_s], vsel)
                + jnp.einsum('bhqk,bhkd->bhqd', p[..., n_s:], vown))

    return sweep(chunk, s, MOBA_Q_CHUNK)


def even_mixer(h, w_in, b_f, pe_k, w1_k, w2_k, pe_v, w1_v, w2_v, w_out, cos, sin):
    b, s, _ = h.shape
    (fq, fk, fv, f_logit, nq, kc, vc, ks, vs, kw, vw, g_logit) = jnp.split(h @ w_in, EVEN_SPLIT_IDX, axis=-1)
    log_f = jax.nn.log_sigmoid(f_logit.astype(jnp.float32) + b_f.astype(jnp.float32)).transpose(0, 2, 1)
    o_fox = fox_attention(to_heads(fq, H_FOX), to_heads(fk, H_FOX), to_heads(fv, H_FOX), log_f)
    rot = lambda t, n: apply_rope(to_heads(t, n), cos, sin)
    gates = jax.nn.sigmoid(g_logit.astype(jnp.float32)).reshape(b, s, H_NSA, 3).transpose(0, 2, 1, 3)
    o_nsa = nsa_attention(rot(nq, H_NSA),
                          nsa_compress(rot(kc, NSA_GROUPS), pe_k, w1_k, w2_k),
                          nsa_compress(to_heads(vc, NSA_GROUPS), pe_v, w1_v, w2_v),
                          rot(ks, NSA_GROUPS), to_heads(vs, NSA_GROUPS),
                          rot(kw, NSA_GROUPS), to_heads(vw, NSA_GROUPS), gates)
    return jnp.concatenate([from_heads(o_fox), from_heads(o_nsa)], axis=-1) @ w_out


def odd_mixer(h, w_in, w_out, cos, sin):
    q, k, v = jnp.split(h @ w_in, 3, axis=-1)
    o = moba_attention(apply_rope(to_heads(q, H_MOBA), cos, sin),
                       apply_rope(to_heads(k, H_MOBA), cos, sin),
                       to_heads(v, H_MOBA))
    return from_heads(o) @ w_out


def swiglu(h, w_gate, w_up, w_down):
    return (jax.nn.silu(h @ w_gate) * (h @ w_up)) @ w_down


def setup_inputs(seed: int = 0) -> dict:
    key = jax.random.key(seed)
    ks = jax.random.split(key, 20)
    ne, no = (DEPTH + 1) // 2, DEPTH // 2
    f32 = jnp.float32

    def dense(k, shape, fan_in):
        return jax.random.normal(k, shape, f32) * fan_in ** -0.5

    def gain(k):
        return 1.0 + 0.05 * jax.random.normal(k, (DEPTH, D_MODEL), f32)

    cmp_in = CMP_LEN * HEAD_DIM
    return {
        'x': jax.random.normal(ks[0], (BATCH, SEQ, D_MODEL), f32),
        'ev_w_in': dense(ks[1], (ne, D_MODEL, EVEN_IN), D_MODEL),
        'ev_b_f': jax.random.uniform(ks[2], (ne, H_FOX), f32, 1.0, 6.0),
        'ev_cmp_pe_k': 0.5 * jax.random.normal(ks[3], (ne, CMP_LEN, HEAD_DIM), f32),
        'ev_cmp_w1_k': dense(ks[4], (ne, cmp_in, CMP_HIDDEN), cmp_in),
        'ev_cmp_w2_k': dense(ks[5], (ne, CMP_HIDDEN, HEAD_DIM), CMP_HIDDEN),
        'ev_cmp_pe_v': 0.5 * jax.random.normal(ks[6], (ne, CMP_LEN, HEAD_DIM), f32),
        'ev_cmp_w1_v': dense(ks[7], (ne, cmp_in, CMP_HIDDEN), cmp_in),
        'ev_cmp_w2_v': dense(ks[8], (ne, CMP_HIDDEN, HEAD_DIM), CMP_HIDDEN),
        'ev_w_out': dense(ks[9], (ne, (H_FOX + H_NSA) * HEAD_DIM, D_MODEL), (H_FOX + H_NSA) * HEAD_DIM),
        'od_w_in': dense(ks[10], (no, D_MODEL, 3 * H_MOBA * HEAD_DIM), D_MODEL),
        'od_w_out': dense(ks[11], (no, H_MOBA * HEAD_DIM, D_MODEL), H_MOBA * HEAD_DIM),
        'g_mix_pre': gain(ks[12]),
        'g_mix_post': gain(ks[13]),
        'g_ffn_pre': gain(ks[14]),
        'g_ffn_post': gain(ks[15]),
        'ffn_w_gate': dense(ks[16], (DEPTH, D_MODEL, D_FF), D_MODEL),
        'ffn_w_up': dense(ks[17], (DEPTH, D_MODEL, D_FF), D_MODEL),
        'ffn_w_down': dense(ks[18], (DEPTH, D_FF, D_MODEL), D_FF),
    }


def reference(x, ev_w_in, ev_b_f, ev_cmp_pe_k, ev_cmp_w1_k, ev_cmp_w2_k, ev_cmp_pe_v,
              ev_cmp_w1_v, ev_cmp_w2_v, ev_w_out, od_w_in, od_w_out, g_mix_pre, g_mix_post,
              g_ffn_pre, g_ffn_post, ffn_w_gate, ffn_w_up, ffn_w_down):
    cos, sin = rope_tables(x.shape[1])
    for layer in range(DEPTH):
        h = rmsnorm(x, g_mix_pre[layer])
        if layer % 2 == 0:
            e = layer // 2
            y = even_mixer(h, ev_w_in[e], ev_b_f[e], ev_cmp_pe_k[e], ev_cmp_w1_k[e], ev_cmp_w2_k[e],
                           ev_cmp_pe_v[e], ev_cmp_w1_v[e], ev_cmp_w2_v[e], ev_w_out[e], cos, sin)
        else:
            o = layer // 2
            y = odd_mixer(h, od_w_in[o], od_w_out[o], cos, sin)
        x = x + rmsnorm(y, g_mix_post[layer])
        h = rmsnorm(x, g_ffn_pre[layer])
        x = x + rmsnorm(swiglu(h, ffn_w_gate[layer], ffn_w_up[layer], ffn_w_down[layer]), g_ffn_post[layer])
    return x
```

```cpp
#include <hip/hip_runtime.h>
#include <cstdio>
#include <cstdint>
#include <cstddef>

#ifndef N_LAUNCH_MODE
#define N_LAUNCH_MODE 0
#endif

#define LAS __attribute__((address_space(3)))
#define GAS __attribute__((address_space(1)))
typedef _Float16 f16;
typedef _Float16 h8 __attribute__((ext_vector_type(8)));
typedef _Float16 h2 __attribute__((ext_vector_type(2)));
typedef short s16x4 __attribute__((ext_vector_type(4)));
typedef float f32x2 __attribute__((ext_vector_type(2)));
typedef float f32x4 __attribute__((ext_vector_type(4)));
typedef float f32x16 __attribute__((ext_vector_type(16)));
typedef unsigned u32x4 __attribute__((ext_vector_type(4)));
typedef unsigned u32x2 __attribute__((ext_vector_type(2)));
typedef GAS unsigned gu32;

constexpr int NB = 2, SEQ = 16384, DM = 1024, MROWS = NB * SEQ, HD = 64, FF = 2816;
constexpr int NIN = 3072;
constexpr int EVEN_IN = 2848;
constexpr float RMS_EPS = 1e-6f;
constexpr float LOG2E = 1.4426950408889634f;
constexpr float QSCALE = 0.125f * LOG2E;
constexpr float NEG_BIG = -1e30f;

constexpr size_t MiB = 1u << 20;
constexpr size_t WS_CTL = 0, CTL_ZERO_BYTES = 1 * MiB;
constexpr size_t WS_COS = 1 * MiB, WS_SIN = 3 * MiB;
constexpr size_t WS_CBIAS = 5 * MiB;
constexpr size_t WS_KBAR = 5 * MiB + 65536;
constexpr size_t WS_C = 6 * MiB;
constexpr size_t WS_LOGF = 7 * MiB;
constexpr size_t WS_W_IN0 = 8 * MiB, WS_W_OUT0 = 14 * MiB, WS_W_IN1 = 16 * MiB, WS_W_OUT1 = 22 * MiB;
constexpr size_t WS_W_GU0 = 24 * MiB, WS_W_GU1 = 35 * MiB, WS_W_DN0 = 46 * MiB, WS_W_DN1 = 46 * MiB + 5632 * 1024, WS_W_C1K = 57 * MiB, WS_W_C1V = 58 * MiB;
constexpr size_t WS_W_C2K = 59 * MiB, WS_W_C2V = 59 * MiB + 131072;
constexpr size_t WS_GATES = 60 * MiB;
constexpr size_t WS_H = 64 * MiB;
constexpr size_t WS_HIDK = WS_H, WS_HIDV = WS_H + 2 * MiB;
constexpr size_t WS_KCMP = WS_H + 4 * MiB, WS_VCMP = WS_H + 4 * MiB + 524288;
constexpr size_t WS_NSEL = WS_H + 5 * MiB;
constexpr size_t WS_MSEL = WS_H + 8 * MiB;
constexpr size_t WS_O = 128 * MiB;
constexpr size_t WS_PROJ = 192 * MiB;
constexpr size_t WS_Y = 384 * MiB;
constexpr size_t WS_OC = WS_Y, WS_OW = WS_Y + 32 * MiB;
constexpr size_t WS_END = 512 * MiB;
constexpr size_t SLOT_BYTES = (size_t)NB * SEQ * HD * 2;

constexpr int CW_BAR = 4096;
constexpr int CW_Q = 16384;

constexpr int LDS_BYTES = 147456;
constexpr int L_KV = 0;
constexpr int L_OST = 32768;
constexpr int L_IMP = 65536;
constexpr int L_WSF = 131072;
constexpr int L_CS = 133120;
constexpr int L_SEL = 133632;
constexpr int L_MISC = 147456 - 256;

__device__ __forceinline__ unsigned pkh(float lo, float hi) { f32x2 v = {lo, hi}; h2 b = __builtin_convertvector(v, h2); return __builtin_bit_cast(unsigned, b); }
__device__ __forceinline__ float wave_sum(float v) {
#pragma unroll
    for (int o = 1; o < 64; o <<= 1) v += __shfl_xor(v, o);
    return v;
}
__device__ __forceinline__ int opaque_tid() { int t = threadIdx.x; asm volatile("" : "+v"(t)); return t; }
__device__ __forceinline__ float fexp2(float x) { return __builtin_amdgcn_exp2f(x); }
#define MFMA32(a, b, c) __builtin_amdgcn_mfma_f32_32x32x16_f16(a, b, c, 0, 0, 0)
#define MFMA16(a, b, c) __builtin_amdgcn_mfma_f32_16x16x32_f16(a, b, c, 0, 0, 0)
#define LDS_WAIT() asm volatile("s_waitcnt lgkmcnt(0)" ::: "memory")
#define VM_WAIT() asm volatile("s_waitcnt vmcnt(0)" ::: "memory")

#define XB_TMO      128
#define XB_XCNT(j)  (256  + 64 * (j))
#define XB_XSUB(j)  (1280 + 64 * (j))
#define XB_XGEN(j)  (2304 + 64 * (j))
#define XB_TOP      3328
#define XB_TOPGEN   3392
#define XCD_BAR_WORDS 3456
#define XB_SPIN_CAP (1u << 20)
__device__ __forceinline__ unsigned xb_ld(unsigned* p)              { return __hip_atomic_load(p, __ATOMIC_RELAXED, __HIP_MEMORY_SCOPE_AGENT); }
__device__ __forceinline__ unsigned xb_add(unsigned* p, unsigned v) { return __hip_atomic_fetch_add(p, v, __ATOMIC_RELAXED, __HIP_MEMORY_SCOPE_AGENT); }
__device__ __forceinline__ unsigned xb_xcc_id() { return (unsigned)__builtin_amdgcn_s_getreg((3 << 11) | 20) & 0xFu; }
#define XB_SPIN(cond, bar) do { unsigned _sp = 0; while (cond) { __builtin_amdgcn_s_sleep(1); \
    if ((++_sp & 255u) == 0u) { if (xb_ld(&(bar)[XB_TMO])) break; if (_sp > XB_SPIN_CAP) { atomicAdd(&(bar)[XB_TMO], 1u); break; } } } } while (0)
struct XcdBarrier { unsigned* bar; unsigned x; volatile LAS unsigned* st; };
__device__ __forceinline__ XcdBarrier xcd_barrier_post(unsigned* bar, volatile LAS unsigned* st) {
    XcdBarrier b; b.bar = bar; b.x = xb_xcc_id(); b.st = st;
    if (threadIdx.x == 0) (void)xb_add(&bar[XB_XCNT(b.x)], 1u);
    return b;
}
__device__ __forceinline__ void xcd_barrier_complete(unsigned* bar, unsigned x, unsigned& nloc, unsigned& nx) {
    const unsigned G = gridDim.x * gridDim.y * gridDim.z;
    unsigned sum, cnt, mine, sp = 0u;
    for (;;) {
        sum = 0u; cnt = 0u; mine = 0u;
#pragma unroll
        for (unsigned j = 0; j < 16; ++j) { const unsigned c = xb_ld(&bar[XB_XCNT(j)]); sum += c; cnt += (c > 0u) ? 1u : 0u; mine = (j == x) ? c : mine; }
        if (sum == G) break;
        __builtin_amdgcn_s_sleep(1);
        if ((++sp & 255u) == 0u) { if (xb_ld(&bar[XB_TMO])) break; if (sp > XB_SPIN_CAP) { atomicAdd(&bar[XB_TMO], 1u); break; } }
    }
    nloc = mine > 0u ? mine : 1u; nx = cnt > 0u ? cnt : 1u;
}
__device__ __forceinline__ void xcd_barrier(const XcdBarrier& b) {
    asm volatile("s_waitcnt vmcnt(0)" ::: "memory");
    __syncthreads();
    if (threadIdx.x == 0) {
        unsigned* bar = b.bar;
        __builtin_amdgcn_s_waitcnt(0);
        unsigned nloc = b.st[0], nx = b.st[1];
        if (nloc == 0u) { xcd_barrier_complete(bar, b.x, nloc, nx); b.st[0] = nloc; b.st[1] = nx; }
        const unsigned old = xb_add(&bar[XB_XSUB(b.x)], 1u);
        const unsigned gen = old / nloc;
        if (old + 1u == (gen + 1u) * nloc) {
            __builtin_amdgcn_fence(__ATOMIC_RELEASE, "agent");
            asm volatile("s_waitcnt vmcnt(0)" ::: "memory");
            const unsigned og = xb_add(&bar[XB_TOP], 1u);
            const unsigned tg = og / nx;
            if (og + 1u == (tg + 1u) * nx) xb_add(&bar[XB_TOPGEN], 1u);
            else XB_SPIN(xb_ld(&bar[XB_TOPGEN]) == tg, bar);
            __builtin_amdgcn_fence(__ATOMIC_ACQUIRE, "agent");
            xb_add(&bar[XB_XGEN(b.x)], 1u);
            asm volatile("s_waitcnt vmcnt(0)" ::: "memory");
        } else {
            XB_SPIN(xb_ld(&bar[XB_XGEN(b.x)]) == gen, bar);
            __builtin_amdgcn_fence(__ATOMIC_ACQUIRE, "agent");
            asm volatile("s_waitcnt vmcnt(0)" ::: "memory");
        }
    }
    __syncthreads();
}

namespace pg8 {
constexpr int BM = 256, BK = 64, HALF = 128, HTB = HALF * BK * 2, NXCD = 8, WGM = 8;
__host__ __device__ __forceinline__ int lds_byte(int r, int c) { const int st = (r >> 4) * 2 + (c >> 5), rr = r & 15, cc = c & 31, ob = rr * 64 + cc * 2; return st * 1024 + (ob ^ (((ob >> 9) & 1) << 5)); }
__host__ __device__ __forceinline__ void stage_rc(int b, int& R, int& C) { const int st = b / 1024, sb = b % 1024, swz = sb ^ (((sb >> 9) & 1) << 5); R = (st >> 1) * 16 + swz / 64; C = (st & 1) * 32 + (swz % 64) / 2; }
__host__ __device__ __forceinline__ int perm32(int rho) { const int n = rho >> 4, i = rho & 15; return 8 * (i >> 2) + 4 * n + (i & 3); }
struct Unit { int pm, pn; };
struct Gemm { const f16* A; const f16* Bt; int lda, K; };
struct StaticOrder {
    int nM, nN, nwg, G, c;
    __device__ void init(int M, int N, int G_, int c_) { nM = M / BM; nN = N / BM; nwg = nM * nN; G = G_; c = c_; }
    __device__ bool next(int i, Unit& u) const {
        const long L = (long)i * G + c; if (L >= nwg) return false;
        int wgid = (int)L; { const int q = nwg / NXCD, r = nwg % NXCD, xcd = wgid % NXCD, off = wgid / NXCD; wgid = (xcd < r ? xcd * (q + 1) : r * (q + 1) + (xcd - r) * q) + off; }
        const int nig = WGM * nN, gid = wgid / nig, fm = gid * WGM, gsz = (nM - fm) < WGM ? (nM - fm) : WGM;
        u.pm = fm + ((wgid % nig) % gsz); u.pn = (wgid % nig) / gsz; return true;
    }
};
struct SingleOrder { Unit u; int n; __device__ bool next(int i, Unit& o) const { if (i >= n) return false; o = u; return true; } };

template <class Epi, class Sched, bool ALIGN_EPI>
__device__ __forceinline__ void gemm_phase(LAS unsigned char* lds, const Gemm g, const Sched& S, const Epi& E) {
    const int tid = opaque_tid(), wid = __builtin_amdgcn_readfirstlane(tid >> 6), lane = tid & 63, wr = wid >> 2, wc = wid & 3, fr = lane & 15, fq = lane >> 4;
    const int K = g.K, nt = K / BK, lda = g.lda;
    unsigned voffA[2], voffB[2];
#pragma unroll
    for (int i = 0; i < 2; ++i) { int R, C; stage_rc(tid * 16 + i * 8192, R, C); const int Rb = (R & ~31) + perm32(R & 31);
        voffA[i] = (unsigned)(R * lda + C) * 2u; voffB[i] = (unsigned)(Rb * K + C) * 2u; }
    const size_t kstep = (size_t)(BK * 2);
    const size_t hstepA = (size_t)HALF * lda * 2, tstepA = 2 * hstepA;
    const size_t hstepB = (size_t)HALF * K * 2, tstepB = 2 * hstepB;
    const unsigned ldsw = (unsigned)wid * 1024u;
    const int aoff = lds_byte(wr * 64 + fr, fq * 8), boff = lds_byte(wc * 32 + fr, fq * 8);
#define PG8_SA(b, h) (((b) * 2 + (h)) * HTB)
#define PG8_SB(b, h) ((4 + (b) * 2 + (h)) * HTB)
#define PG8_STAGE(bufoff, gbase, voff) do { _Pragma("unroll") for (int _i = 0; _i < 2; ++_i) \
        __builtin_amdgcn_global_load_lds((const unsigned*)((const char*)(gbase) + (voff)[_i]), (LAS unsigned*)(lds + (bufoff) + ldsw + _i * 8192), 16, 0, 0); } while (0)
#define PG8_LDA(dst, b, h) do { _Pragma("unroll") for (int m = 0; m < 4; ++m) _Pragma("unroll") for (int k = 0; k < 2; ++k) dst[m][k] = *(const LAS h8*)(lds + PG8_SA(b, h) + aoff + m * 2048 + k * 1024); } while (0)
#define PG8_LDB(dst, b, h) do { _Pragma("unroll") for (int n = 0; n < 2; ++n) _Pragma("unroll") for (int k = 0; k < 2; ++k) dst[n][k] = *(const LAS h8*)(lds + PG8_SB(b, h) + boff + n * 2048 + k * 1024); } while (0)
#define PG8_MMA(ai, bj, At, Bt) do { __builtin_amdgcn_s_setprio(1); _Pragma("unroll") for (int m = 0; m < 4; ++m) _Pragma("unroll") for (int n = 0; n < 2; ++n) _Pragma("unroll") for (int k = 0; k < 2; ++k) \
        acc[ai][bj][m][n] = MFMA16(Bt[n][k], At[m][k], acc[ai][bj][m][n]); __builtin_amdgcn_s_setprio(0); } while (0)
#define PG8_WAIT_V(n) asm volatile("s_waitcnt vmcnt(" #n ")" ::: "memory")
#define PG8_WAIT_L(n) asm volatile("s_waitcnt lgkmcnt(" #n ")" ::: "memory")
#define PG8_BAR __builtin_amdgcn_s_barrier()
#define PG8_SCHED __builtin_amdgcn_sched_barrier(0)
    Unit cur, nxt; int ui = 0;
    if (!S.next(0, cur)) return;
    f32x4 acc[2][2][4][2];
#pragma unroll
    for (int a = 0; a < 2; ++a)
#pragma unroll
        for (int b = 0; b < 2; ++b)
#pragma unroll
            for (int m = 0; m < 4; ++m)
#pragma unroll
                for (int n = 0; n < 2; ++n) acc[a][b][m][n] = (f32x4){0.f, 0.f, 0.f, 0.f};
    h8 At[4][2], B0[2][2], B1[2][2];
    const char* cA = (const char*)g.A + (size_t)cur.pm * tstepA; const char* cB = (const char*)g.Bt + (size_t)cur.pn * tstepB;
    PG8_STAGE(PG8_SB(0, 0), cB, voffB); PG8_STAGE(PG8_SB(0, 1), cB + hstepB, voffB); PG8_STAGE(PG8_SA(0, 0), cA, voffA); PG8_STAGE(PG8_SA(0, 1), cA + hstepA, voffA);
    if (wr == 1) PG8_BAR;
    PG8_WAIT_V(2); PG8_BAR;
    PG8_STAGE(PG8_SB(1, 0), cB + kstep, voffB); PG8_STAGE(PG8_SA(1, 0), cA + kstep, voffA); PG8_STAGE(PG8_SB(1, 1), cB + hstepB + kstep, voffB);
    PG8_WAIT_V(6); PG8_BAR;
    for (;;) {
        const bool has_next = S.next(ui + 1, nxt);
        const char* nA = has_next ? (const char*)g.A + (size_t)nxt.pm * tstepA : cA; const char* nB = has_next ? (const char*)g.Bt + (size_t)nxt.pn * tstepB : cB;
#pragma unroll 1
        for (int t = 0; t < nt; t += 2) {
            const bool last = (t == nt - 2);
            const char* a1 = cA + (size_t)(t + 1) * kstep;
            const char* a2 = last ? nA : cA + (size_t)(t + 2) * kstep; const char* b2 = last ? nB : cB + (size_t)(t + 2) * kstep;
            const char* a3 = a2 + kstep; const char* b3 = b2 + kstep;
            PG8_LDB(B0, 0, 0); PG8_LDB(B1, 0, 1); PG8_SCHED; PG8_LDA(At, 0, 0); PG8_STAGE(PG8_SA(1, 1), a1 + hstepA, voffA);
            PG8_WAIT_V(8); PG8_WAIT_L(0); PG8_BAR; PG8_MMA(0, 0, At, B0); PG8_MMA(0, 1, At, B1); PG8_BAR; PG8_SCHED;
            PG8_LDA(At, 0, 1); PG8_STAGE(PG8_SB(0, 0), b2, voffB); PG8_STAGE(PG8_SB(0, 1), b2 + hstepB, voffB); PG8_STAGE(PG8_SA(0, 0), a2, voffA);
            PG8_WAIT_V(8); PG8_WAIT_L(0); PG8_BAR; PG8_MMA(1, 0, At, B0); PG8_MMA(1, 1, At, B1); PG8_BAR; PG8_SCHED;
            PG8_LDB(B0, 1, 0); PG8_LDB(B1, 1, 1); PG8_SCHED; PG8_LDA(At, 1, 0); PG8_STAGE(PG8_SA(0, 1), a2 + hstepA, voffA);
            PG8_WAIT_V(8); PG8_WAIT_L(0); PG8_BAR; PG8_MMA(0, 0, At, B0); PG8_MMA(0, 1, At, B1); PG8_BAR; PG8_SCHED;
            PG8_LDA(At, 1, 1); PG8_STAGE(PG8_SB(1, 0), b3, voffB); PG8_STAGE(PG8_SB(1, 1), b3 + hstepB, voffB); PG8_STAGE(PG8_SA(1, 0), a3, voffA);
            PG8_WAIT_V(8); PG8_WAIT_L(0); PG8_BAR; PG8_MMA(1, 0, At, B0); PG8_MMA(1, 1, At, B1); PG8_BAR; PG8_SCHED;
        }
        if constexpr (ALIGN_EPI) { if (wr == 0) PG8_BAR; }
        E(acc, cur, wr, wc, fr, fq);
        if (!has_next) break;
#pragma unroll
        for (int a = 0; a < 2; ++a)
#pragma unroll
            for (int b = 0; b < 2; ++b)
#pragma unroll
                for (int m = 0; m < 4; ++m)
#pragma unroll
                    for (int n = 0; n < 2; ++n) acc[a][b][m][n] = (f32x4){0.f, 0.f, 0.f, 0.f};
        cur = nxt; cA = nA; cB = nB; ++ui;
        if constexpr (ALIGN_EPI) { if (wr == 1) PG8_BAR; }
    }
    PG8_WAIT_V(0);
    if constexpr (!ALIGN_EPI) { if (wr == 0) PG8_BAR; }
    PG8_BAR;
#undef PG8_SA
#undef PG8_SB
#undef PG8_STAGE
#undef PG8_LDA
#undef PG8_LDB
#undef PG8_MMA
#undef PG8_WAIT_V
#undef PG8_WAIT_L
#undef PG8_BAR
#undef PG8_SCHED
}
typedef f32x4 Acc[2][2][4][2];

struct EpiF32 {
    float* Y; int ldc;
    __device__ __forceinline__ void operator()(const Acc& acc, const Unit& u, int wr, int wc, int fr, int fq) const {
        const int row0 = u.pm * BM + wr * 64 + fr, col0 = u.pn * BM + wc * 32 + 8 * fq;
#pragma unroll
        for (int ai = 0; ai < 2; ++ai)
#pragma unroll
            for (int m = 0; m < 4; ++m) { float* rowp = Y + (size_t)(row0 + ai * HALF + m * 16) * ldc + col0;
#pragma unroll
                for (int bj = 0; bj < 2; ++bj) { *(f32x4*)(rowp + bj * HALF) = acc[ai][bj][m][0]; *(f32x4*)(rowp + bj * HALF + 4) = acc[ai][bj][m][1]; } }
    }
};
struct EpiSwiGLU {
    f16* Hd;
    __device__ __forceinline__ void operator()(const Acc& acc, const Unit& u, int wr, int wc, int fr, int fq) const {
        const int row0 = u.pm * BM + wr * 64 + fr, col0 = u.pn * HALF + wc * 32 + 8 * fq;
#pragma unroll
        for (int ai = 0; ai < 2; ++ai)
#pragma unroll
            for (int m = 0; m < 4; ++m) {
                float o[8];
#pragma unroll
                for (int n = 0; n < 2; ++n)
#pragma unroll
                    for (int j = 0; j < 4; ++j) { const float gt = acc[ai][0][m][n][j], up = acc[ai][1][m][n][j]; o[4 * n + j] = gt * up / (1.f + __expf(-gt)); }
                u32x4 w; w.x = pkh(o[0], o[1]); w.y = pkh(o[2], o[3]); w.z = pkh(o[4], o[5]); w.w = pkh(o[6], o[7]);
                *(u32x4*)(Hd + (size_t)(row0 + ai * HALF + m * 16) * FF + col0) = w; }
    }
};
__device__ __forceinline__ float gelu_tanh(float x) { const float u = 0.7978845608028654f * (x + 0.044715f * x * x * x); const float e = __expf(2.f * u); return 0.5f * x * (2.f - 2.f / (e + 1.f)); }
struct EpiCmp1 {
    f16* Hd; const float* bias;
    __device__ __forceinline__ void operator()(const Acc& acc, const Unit& u, int wr, int wc, int fr, int fq) const {
        const int row0 = u.pm * BM + wr * 64 + fr, col0 = wc * 32 + 8 * fq;
        f32x4 bv[2][2];
#pragma unroll
        for (int bj = 0; bj < 2; ++bj)
#pragma unroll
            for (int n = 0; n < 2; ++n) bv[bj][n] = *(const f32x4*)(bias + col0 + bj * HALF + 4 * n);
#pragma unroll
        for (int ai = 0; ai < 2; ++ai)
#pragma unroll
            for (int m = 0; m < 4; ++m) {
#pragma unroll
                for (int bj = 0; bj < 2; ++bj) {
                    float o[8];
#pragma unroll
                    for (int n = 0; n < 2; ++n)
#pragma unroll
                        for (int j = 0; j < 4; ++j) o[4 * n + j] = gelu_tanh(acc[ai][bj][m][n][j] + bv[bj][n][j]);
                    u32x4 w; w.x = pkh(o[0], o[1]); w.y = pkh(o[2], o[3]); w.z = pkh(o[4], o[5]); w.w = pkh(o[6], o[7]);
                    *(u32x4*)(Hd + (size_t)(row0 + ai * HALF + m * 16) * 256 + col0 + bj * HALF) = w; }
                __builtin_amdgcn_sched_barrier(0); }
    }
};
struct EpiCmp2 {
    f16* Out;
    __device__ __forceinline__ void operator()(const Acc& acc, const Unit& u, int wr, int wc, int fr, int fq) const {
        if (wc >= 2) return;
        const int row0 = u.pm * BM + wr * 64 + fr, col0 = wc * 32 + 8 * fq;
#pragma unroll
        for (int ai = 0; ai < 2; ++ai)
#pragma unroll
            for (int m = 0; m < 4; ++m) {
                u32x4 w; w.x = pkh(acc[ai][0][m][0][0], acc[ai][0][m][0][1]); w.y = pkh(acc[ai][0][m][0][2], acc[ai][0][m][0][3]);
                w.z = pkh(acc[ai][0][m][1][0], acc[ai][0][m][1][1]); w.w = pkh(acc[ai][0][m][1][2], acc[ai][0][m][1][3]);
                *(u32x4*)(Out + (size_t)(row0 + ai * HALF + m * 16) * 64 + col0) = w; }
    }
};
struct EpiInProj {
    f16* proj; const float* cosT; const float* sinT; float* logf; float* gates; const float* b_f; int layer;
    __device__ __forceinline__ void operator()(const Acc& acc, const Unit& u, int wr, int wc, int fr, int fq) const {
        const int hs = u.pn * 4 + wc;
        int kind, dst;
        if (layer == 0) {
            if (hs < 8) { kind = 2; dst = hs; } else if (hs < 24) { kind = 0; dst = hs; } else if (hs < 32) { kind = 3; dst = hs; }
            else if (hs < 38) { kind = 1; dst = hs; } else if (hs == 38) { kind = 4; dst = 0; } else if (hs == 39) { kind = 5; dst = 0; }
            else if (hs < 46) { kind = 0; dst = hs - 2; } else { kind = 5; dst = 0; }
        } else { dst = hs; kind = hs < 16 ? 3 : (hs < 32 ? 1 : 0); }
        if (kind == 5) return;
        const int row0 = u.pm * BM + wr * 64 + fr;
        if (kind == 4) {
            const float bf0 = b_f[(8 * fq) & 7], bf1 = b_f[(8 * fq + 1) & 7], bf2 = b_f[(8 * fq + 2) & 7], bf3 = b_f[(8 * fq + 3) & 7], bf4 = b_f[(8 * fq + 4) & 7], bf5 = b_f[(8 * fq + 5) & 7], bf6 = b_f[(8 * fq + 6) & 7], bf7 = b_f[(8 * fq + 7) & 7];
            const float bfv[8] = {bf0, bf1, bf2, bf3, bf4, bf5, bf6, bf7};
#pragma unroll
            for (int ai = 0; ai < 2; ++ai)
#pragma unroll
                for (int m = 0; m < 4; ++m) { const int row = row0 + ai * HALF + m * 16; const int b = row / SEQ, s = row % SEQ;
#pragma unroll
                    for (int n = 0; n < 2; ++n)
#pragma unroll
                        for (int j = 0; j < 4; ++j) { const int d = 8 * fq + 4 * n + j; const float v = acc[ai][0][m][n][j];
                            if (fq == 0) { const float x = v + bfv[4 * n + j]; const float e = __expf(-fabsf(x));
                                const float l1p = e < 0.03f ? e * (1.f - e * (0.5f - e * (0.33333333f - 0.25f * e))) : __logf(1.f + e);
                                logf[((size_t)b * 8 + d) * SEQ + s] = fminf(x, 0.f) - l1p; }
                            else gates[(size_t)row * 24 + (d - 8)] = 1.f / (1.f + __expf(-v)); }
                    __builtin_amdgcn_sched_barrier(0); }
            return;
        }
        const float sc = (kind >= 2) ? QSCALE : 1.f; const bool rope = (kind == 1 || kind == 3);
        f16* base = proj + (size_t)dst * (NB * SEQ * HD);
#pragma unroll
        for (int ai = 0; ai < 2; ++ai)
#pragma unroll
            for (int m = 0; m < 4; ++m) { const int row = row0 + ai * HALF + m * 16; const int s = row % SEQ;
                f32x4 x1[2] = {acc[ai][0][m][0], acc[ai][0][m][1]}, x2[2] = {acc[ai][1][m][0], acc[ai][1][m][1]};
                if (rope) {
#pragma unroll
                    for (int n = 0; n < 2; ++n) { const f32x4 c = *(const f32x4*)(cosT + (size_t)s * 32 + 8 * fq + 4 * n), sn = *(const f32x4*)(sinT + (size_t)s * 32 + 8 * fq + 4 * n);
                        const f32x4 a = x1[n], bb = x2[n]; x1[n] = a * c - bb * sn; x2[n] = bb * c + a * sn; }
                }
                u32x4 w1, w2;
                w1.x = pkh(x1[0][0] * sc, x1[0][1] * sc); w1.y = pkh(x1[0][2] * sc, x1[0][3] * sc); w1.z = pkh(x1[1][0] * sc, x1[1][1] * sc); w1.w = pkh(x1[1][2] * sc, x1[1][3] * sc);
                w2.x = pkh(x2[0][0] * sc, x2[0][1] * sc); w2.y = pkh(x2[0][2] * sc, x2[0][3] * sc); w2.z = pkh(x2[1][0] * sc, x2[1][1] * sc); w2.w = pkh(x2[1][2] * sc, x2[1][3] * sc);
                f16* rp = base + (size_t)row * HD + 8 * fq;
                *(u32x4*)rp = w1; *(u32x4*)(rp + 32) = w2;
                __builtin_amdgcn_sched_barrier(0); }
    }
};
}

__device__ __forceinline__ int crow(int r, int hi) { return (r & 3) + 8 * (r >> 2) + 4 * hi; }
__device__ __forceinline__ float swapmax(float m) { auto rr = __builtin_amdgcn_permlane32_swap(__float_as_uint(m), __float_as_uint(m), false, false); return fmaxf(__uint_as_float(rr[0]), __uint_as_float(rr[1])); }
__device__ __forceinline__ float swapsum(float m) { auto rr = __builtin_amdgcn_permlane32_swap(__float_as_uint(m), __float_as_uint(m), false, false); return __uint_as_float(rr[0]) + __uint_as_float(rr[1]); }
struct KVStage { u32x4 k, v; };
__device__ __forceinline__ void kv_issue(KVStage& st, const char* kt, const char* vt, int wid, int lane) {
    st.k = *(const u32x4*)(kt + lane * 128 + wid * 16);
    st.v = *(const u32x4*)(vt + (16 * (wid & 3) + (lane >> 2)) * 128 + (wid >> 2) * 64 + (lane & 3) * 16);
}
__device__ __forceinline__ void kv_write(const KVStage& st, LAS unsigned char* buf, int wid, int lane) {
    *(LAS u32x4*)(buf + wid * 1024 + lane * 16) = st.k;
    *(LAS u32x4*)(buf + 8192 + wid * 1024 + lane * 16) = st.v;
}
__device__ __forceinline__ void qk_tile(f32x16& p0, f32x16& p1, const LAS unsigned char* kb, const h8 (&qr)[4], int r32, int hi) {
    const LAS unsigned char* kp = kb + hi * 1024 + r32 * 16;
#pragma unroll
    for (int r = 0; r < 16; ++r) { p0[r] = 0.f; p1[r] = 0.f; }
#pragma unroll
    for (int d0 = 0; d0 < 4; ++d0) {
        const h8 b0 = *(const LAS h8*)(kp + d0 * 2048), b1 = *(const LAS h8*)(kp + d0 * 2048 + 512);
        p0 = MFMA32(b0, qr[d0], p0); p1 = MFMA32(b1, qr[d0], p1);
    }
}
typedef short v4i16_t __attribute__((ext_vector_type(4)));
typedef short s16x8 __attribute__((ext_vector_type(8)));
__device__ __forceinline__ s16x4 vtr(const LAS unsigned char* p) { return __builtin_bit_cast(s16x4, __builtin_amdgcn_ds_read_tr16_b64_v4i16((LAS v4i16_t*)p)); }
__device__ __forceinline__ void pv_tile(f32x16 (&o)[2], const LAS unsigned char* vb, const u32x4 (&pw)[4], int lane, int hi) {
    const LAS unsigned char* vp = vb + ((lane >> 4) & 1) * 32 + (lane & 3) * 8 + (4 * hi + ((lane & 15) >> 2)) * 64;
#pragma unroll
    for (int d0 = 0; d0 < 2; ++d0)
#pragma unroll
        for (int ks = 0; ks < 4; ++ks) {
            const s16x4 lo = vtr(vp + d0 * 4096 + ks * 1024), hh = vtr(vp + d0 * 4096 + ks * 1024 + 512);
            const s16x8 vv = {lo[0], lo[1], lo[2], lo[3], hh[0], hh[1], hh[2], hh[3]};
            o[d0] = MFMA32(__builtin_bit_cast(h8, pw[ks]), __builtin_bit_cast(h8, vv), o[d0]);
        }
}
__device__ __forceinline__ void pack_p(u32x4 (&pw)[4], const f32x16& p0, const f32x16& p1) {
    pw[0] = (u32x4){pkh(p0[0], p0[1]), pkh(p0[2], p0[3]), pkh(p0[4], p0[5]), pkh(p0[6], p0[7])};
    pw[1] = (u32x4){pkh(p0[8], p0[9]), pkh(p0[10], p0[11]), pkh(p0[12], p0[13]), pkh(p0[14], p0[15])};
    pw[2] = (u32x4){pkh(p1[0], p1[1]), pkh(p1[2], p1[3]), pkh(p1[4], p1[5]), pkh(p1[6], p1[7])};
    pw[3] = (u32x4){pkh(p1[8], p1[9]), pkh(p1[10], p1[11]), pkh(p1[12], p1[13]), pkh(p1[14], p1[15])};
}
__device__ __forceinline__ float rowmax32(const f32x16& p0, const f32x16& p1) {
    float a = fmaxf(p0[0], p1[0]);
#pragma unroll
    for (int r = 1; r < 16; ++r) a = fmaxf(a, fmaxf(p0[r], p1[r]));
    return swapmax(a);
}
__device__ __forceinline__ void softmax_step(f32x16& p0, f32x16& p1, float& m, float& l, f32x16 (&o)[2], LAS float* wsf, int r32, int hi) {
    const float rm = rowmax32(p0, p1);
    const float mn = fmaxf(m, rm);
    const float alpha = fexp2(m - mn);
    m = mn;
    float s = 0.f;
#pragma unroll
    for (int r = 0; r < 16; ++r) { p0[r] = fexp2(p0[r] - mn); p1[r] = fexp2(p1[r] - mn); s += p0[r] + p1[r]; }
    l = l * alpha + s;
    if (__any(alpha != 1.f)) {
        if (hi == 0) wsf[r32] = alpha;
        LDS_WAIT();
#pragma unroll
        for (int r = 0; r < 16; ++r) { const float a = wsf[crow(r, hi)]; o[0][r] *= a; o[1][r] *= a; }
        LDS_WAIT();
    }
}
__device__ __forceinline__ void stage_o(const f32x16 (&o)[2], float rinv_lane, LAS float* wsf, LAS f16* stg, int r32, int hi) {
    if (hi == 0) wsf[32 + r32] = rinv_lane;
    LDS_WAIT();
#pragma unroll
    for (int r = 0; r < 16; ++r) { const int orow = crow(r, hi); const float rl = wsf[32 + orow];
        stg[orow * 64 + r32] = (f16)(o[0][r] * rl); stg[orow * 64 + 32 + r32] = (f16)(o[1][r] * rl); }
    LDS_WAIT();
}

template <class F> __device__ __forceinline__ void attn_unit(F& f, LAS unsigned char* lds) {
    const int tid = opaque_tid(), lane = tid & 63, r32 = lane & 31, hi = lane >> 5; const int wid = __builtin_amdgcn_readfirstlane(tid >> 6);
    LAS unsigned char* kv = lds + L_KV; LAS float* wsf = (LAS float*)(lds + L_WSF) + wid * 64; LAS f16* stg = (LAS f16*)(lds + L_OST) + wid * 2048;
    LAS float* csl = (LAS float*)(lds + L_CS);
    f.init(wid, r32, hi);
    const f16* qp = f.qrow();
    h8 qr[4];
#pragma unroll
    for (int d0 = 0; d0 < 4; ++d0) qr[d0] = *(const h8*)(qp + 16 * d0 + 8 * hi);
    float m = NEG_BIG, l = 0.f; f32x16 o[2];
#pragma unroll
    for (int r = 0; r < 16; ++r) { o[0][r] = 0.f; o[1][r] = 0.f; }
    const int t0 = f.t_begin(), t1 = f.t_end();
    KVStage st; float csv = 0.f;
    __syncthreads();
    f.unit_prep(lds, tid);
    kv_issue(st, f.ktile(t0), f.vtile(t0), wid, lane);
    if constexpr (F::HAS_CS) { if (wid == 0) csv = f.cs_src(t0)[lane]; }
    kv_write(st, kv, wid, lane);
    if constexpr (F::HAS_CS) { if (wid == 0) csl[lane] = csv; }
    __syncthreads();
    for (int t = t0; t < t1; ++t) {
        const int cur = (t - t0) & 1;
        const bool more = (t + 1 < t1);
        if (more) { kv_issue(st, f.ktile(t + 1), f.vtile(t + 1), wid, lane); if constexpr (F::HAS_CS) { if (wid == 0) csv = f.cs_src(t + 1)[lane]; } }
        if (f.active(t)) {
            f32x16 p0, p1;
            qk_tile(p0, p1, kv + cur * 16384, qr, r32, hi);
            f.mask(p0, p1, t, csl + cur * 64, hi);
            softmax_step(p0, p1, m, l, o, wsf, r32, hi);
            u32x4 pw[4]; pack_p(pw, p0, p1);
            pv_tile(o, kv + cur * 16384 + 8192, pw, lane, hi);
        }
        if (more) { kv_write(st, kv + (cur ^ 1) * 16384, wid, lane); if constexpr (F::HAS_CS) { if (wid == 0) csl[(cur ^ 1) * 64 + lane] = csv; } }
        __syncthreads();
    }
    const float lt = swapsum(l);
    stage_o(o, lt > 0.f ? 1.f / lt : 0.f, wsf, stg, r32, hi);
    f.store(stg, lane);
}

struct FoxF {
    static constexpr bool HAS_CS = true;
    const f16 *q, *k, *v; const float* c; f16* O; int b, h, qb;
    int wid_, qpos; float ct;
    __device__ __forceinline__ void init(int wid, int r32, int hi) { wid_ = wid; qpos = 256 * qb + 32 * wid + r32; ct = c[qpos]; }
    __device__ __forceinline__ const f16* qrow() const { return q + (size_t)qpos * HD; }
    __device__ __forceinline__ int t_begin() const { return 0; }
    __device__ __forceinline__ int t_end() const { return 4 * qb + 4; }
    __device__ __forceinline__ const char* ktile(int t) const { return (const char*)k + (size_t)t * 8192; }
    __device__ __forceinline__ const char* vtile(int t) const { return (const char*)v + (size_t)t * 8192; }
    __device__ __forceinline__ const float* cs_src(int t) const { return c + 64 * t; }
    __device__ __forceinline__ void unit_prep(LAS unsigned char*, int) const {}
    __device__ __forceinline__ bool active(int) const { return true; }
    __device__ __forceinline__ void mask(f32x16& p0, f32x16& p1, int t, const LAS float* cs, int hi) const {
#pragma unroll
        for (int g = 0; g < 4; ++g) {
            const f32x4 c0 = *(const LAS f32x4*)(cs + 4 * hi + 8 * g), c1 = *(const LAS f32x4*)(cs + 32 + 4 * hi + 8 * g);
#pragma unroll
            for (int j = 0; j < 4; ++j) { const int kvp = 64 * t + 4 * hi + 8 * g + j;
                p0[4 * g + j] = (kvp <= qpos) ? p0[4 * g + j] + (ct - c0[j]) : -INFINITY;
                p1[4 * g + j] = (kvp + 32 <= qpos) ? p1[4 * g + j] + (ct - c1[j]) : -INFINITY; }
        }
    }
    __device__ __forceinline__ void store(const LAS f16* stg, int lane) const {
#pragma unroll
        for (int i = 0; i < 4; ++i) { const int row = i * 8 + (lane >> 3), ch = lane & 7;
            *(u32x4*)(O + ((size_t)b * SEQ + 256 * qb + 32 * wid_ + row) * DM + h * HD + ch * 8) = *(const LAS u32x4*)(stg + row * 64 + ch * 8); }
    }
};
struct WinF {
    static constexpr bool HAS_CS = false;
    const f16* proj; f16* ow; int b, g, qt;
    int hd_, qpos, q0w;
    __device__ __forceinline__ void init(int wid, int r32, int hi) { hd_ = 4 * g + (wid >> 1); q0w = 64 * qt + 32 * (wid & 1); qpos = q0w + r32; }
    __device__ __forceinline__ const f16* qrow() const { return proj + (size_t)(24 + hd_) * (NB * SEQ * HD) + ((size_t)b * SEQ + qpos) * HD; }
    __device__ __forceinline__ int t_begin() const { return qt >= 8 ? qt - 8 : 0; }
    __device__ __forceinline__ int t_end() const { return qt + 1; }
    __device__ __forceinline__ const char* ktile(int t) const { return (const char*)(proj + (size_t)(36 + g) * (NB * SEQ * HD) + (size_t)b * SEQ * HD) + (size_t)t * 8192; }
    __device__ __forceinline__ const char* vtile(int t) const { return (const char*)(proj + (size_t)(42 + g) * (NB * SEQ * HD) + (size_t)b * SEQ * HD) + (size_t)t * 8192; }
    __device__ __forceinline__ const float* cs_src(int) const { return nullptr; }
    __device__ __forceinline__ void unit_prep(LAS unsigned char*, int) const {}
    __device__ __forceinline__ bool active(int) const { return true; }
    __device__ __forceinline__ void mask(f32x16& p0, f32x16& p1, int t, const LAS float*, int hi) const {
#pragma unroll
        for (int r = 0; r < 16; ++r) { const int d0 = qpos - (64 * t + crow(r, hi)), d1 = d0 - 32;
            if (!(d0 >= 0 && d0 < 512)) p0[r] = -INFINITY;
            if (!(d1 >= 0 && d1 < 512)) p1[r] = -INFINITY; }
    }
    __device__ __forceinline__ void store(const LAS f16* stg, int lane) const {
#pragma unroll
        for (int i = 0; i < 4; ++i) { const int row = i * 8 + (lane >> 3), ch = lane & 7;
            *(u32x4*)(ow + (((size_t)b * 8 + hd_) * SEQ + q0w + row) * HD + ch * 8) = *(const LAS u32x4*)(stg + row * 64 + ch * 8); }
    }
};
struct SelF {
    static constexpr bool HAS_CS = false;
    const f16* proj; const unsigned* nsel; const f16 *oc, *ow; const float* gates; f16* O; int b, g, qt;
    int wid_, qpos, hd_, ql; unsigned bit; const LAS unsigned* sl;
    __device__ __forceinline__ void init(int wid, int r32, int hi) { wid_ = wid; ql = 8 * wid + (r32 >> 2); hd_ = 4 * g + (r32 & 3); qpos = 64 * qt + ql; bit = 0; }
    __device__ __forceinline__ const f16* qrow() const { return proj + (size_t)(24 + hd_) * (NB * SEQ * HD) + ((size_t)b * SEQ + qpos) * HD; }
    __device__ __forceinline__ int t_begin() const { return 0; }
    __device__ __forceinline__ int t_end() const { return qt + 1; }
    __device__ __forceinline__ const char* ktile(int t) const { return (const char*)(proj + (size_t)(34 + g) * (NB * SEQ * HD) + (size_t)b * SEQ * HD) + (size_t)t * 8192; }
    __device__ __forceinline__ const char* vtile(int t) const { return (const char*)(proj + (size_t)(40 + g) * (NB * SEQ * HD) + (size_t)b * SEQ * HD) + (size_t)t * 8192; }
    __device__ __forceinline__ const float* cs_src(int) const { return nullptr; }
    __device__ __forceinline__ void unit_prep(LAS unsigned char* lds, int tid) { sl = (const LAS unsigned*)(lds + L_SEL);
        ((LAS unsigned*)(lds + L_SEL))[tid] = nsel[(((size_t)b * 2 + g) * SEQ + 64 * qt) * 8 + tid]; }
    __device__ __forceinline__ bool active(int t) { bit = (sl[ql * 8 + (t >> 5)] >> (t & 31)) & 1u; return __any(bit != 0u); }
    __device__ __forceinline__ void mask(f32x16& p0, f32x16& p1, int t, const LAS float*, int hi) const {
        const bool own = (t == qt);
#pragma unroll
        for (int r = 0; r < 16; ++r) { const int kvp = 64 * t + crow(r, hi);
            if (!bit || (own && kvp > qpos)) p0[r] = -INFINITY;
            if (!bit || (own && kvp + 32 > qpos)) p1[r] = -INFINITY; }
    }
    __device__ __forceinline__ void store(const LAS f16* stg, int lane) const {
#pragma unroll
        for (int i = 0; i < 4; ++i) { const int row = i * 8 + (lane >> 3), ch = lane & 7;
            const int q = 64 * qt + 8 * wid_ + (row >> 2), hd = 4 * g + (row & 3);
            const float* gp = gates + ((size_t)b * SEQ + q) * 24 + hd * 3; float g0 = gp[0], g1 = gp[1], g2 = gp[2];
#ifdef ABL_OC
            g0 = 0.f;
#endif
#ifdef ABL_SEL
            g1 = 0.f;
#endif
#ifdef ABL_WIN
            g2 = 0.f;
#endif
            const size_t ho = (((size_t)b * 8 + hd) * SEQ + q) * HD + ch * 8;
            const h8 a = *(const h8*)(oc + ho), w = *(const h8*)(ow + ho), s = *(const LAS h8*)(stg + row * 64 + ch * 8);
            float r_[8];
#pragma unroll
            for (int e = 0; e < 8; ++e) r_[e] = g0 * (float)a[e] + g1 * (float)s[e] + g2 * (float)w[e];
            u32x4 o4; o4.x = pkh(r_[0], r_[1]); o4.y = pkh(r_[2], r_[3]); o4.z = pkh(r_[4], r_[5]); o4.w = pkh(r_[6], r_[7]);
            *(u32x4*)(O + ((size_t)b * SEQ + q) * DM + 512 + hd * HD + ch * 8) = o4; }
    }
};
struct MobaF {
    static constexpr bool HAS_CS = false;
    const f16 *q, *k, *v; const unsigned long long* msel; f16* O; int b, h, qb;
    int wid_, qpos; unsigned long long mk; unsigned bit;
    __device__ __forceinline__ void init(int wid, int r32, int hi) { wid_ = wid; qpos = 256 * qb + 32 * wid + r32; mk = msel[qpos]; bit = 0; }
    __device__ __forceinline__ const f16* qrow() const { return q + (size_t)qpos * HD; }
    __device__ __forceinline__ int t_begin() const { return 0; }
    __device__ __forceinline__ int t_end() const { return 4 * qb + 4; }
    __device__ __forceinline__ const char* ktile(int t) const { return (const char*)k + (size_t)t * 8192; }
    __device__ __forceinline__ const char* vtile(int t) const { return (const char*)v + (size_t)t * 8192; }
    __device__ __forceinline__ const float* cs_src(int) const { return nullptr; }
    __device__ __forceinline__ void unit_prep(LAS unsigned char*, int) const {}
    __device__ __forceinline__ bool active(int t) { const int kb = t >> 2; if (kb == qb) { bit = 1u; return true; } bit = (unsigned)((mk >> kb) & 1ull); return __any(bit != 0u); }
    __device__ __forceinline__ void mask(f32x16& p0, f32x16& p1, int t, const LAS float*, int hi) const {
        const bool own = ((t >> 2) == qb);
#pragma unroll
        for (int r = 0; r < 16; ++r) { const int kvp = 64 * t + crow(r, hi);
            if (!bit || (own && kvp > qpos)) p0[r] = -INFINITY;
            if (!bit || (own && kvp + 32 > qpos)) p1[r] = -INFINITY; }
    }
    __device__ __forceinline__ void store(const LAS f16* stg, int lane) const {
#pragma unroll
        for (int i = 0; i < 4; ++i) { const int row = i * 8 + (lane >> 3), ch = lane & 7;
            *(u32x4*)(O + ((size_t)b * SEQ + 256 * qb + 32 * wid_ + row) * DM + h * HD + ch * 8) = *(const LAS u32x4*)(stg + row * 64 + ch * 8); }
    }
};

__device__ __forceinline__ void lds_fadd(LAS float* p, float v) { (void)__hip_atomic_fetch_add(p, v, __ATOMIC_RELAXED, __HIP_MEMORY_SCOPE_WORKGROUP); }
__device__ __forceinline__ float quad_sum(float v) {
    v += __int_as_float(__builtin_amdgcn_mov_dpp(__float_as_int(v), 0xB1, 0xF, 0xF, true));
    v += __int_as_float(__builtin_amdgcn_mov_dpp(__float_as_int(v), 0x4E, 0xF, 0xF, true));
    return v;
}
__device__ __forceinline__ void nsa_cmp_unit(const f16* proj, const f16* kcmp, const f16* vcmp, f16* oc, unsigned* nsel, int b, int g, int qt, LAS unsigned char* lds) {
    const int tid = opaque_tid(), lane = tid & 63, r32 = lane & 31, hi = lane >> 5; const int wid = __builtin_amdgcn_readfirstlane(tid >> 6);
    LAS unsigned char* kv = lds + L_KV; LAS float* wsf = (LAS float*)(lds + L_WSF) + wid * 64; LAS f16* stg = (LAS f16*)(lds + L_OST) + wid * 2048;
    LAS float* imp = (LAS float*)(lds + L_IMP);
    const int ql = 8 * wid + (r32 >> 2), hd = 4 * g + (r32 & 3), qpos = 64 * qt + ql;
    const int pair = g * 2 + b;
    const char* kc = (const char*)(kcmp + (size_t)pair * 1024 * HD); const char* vc = (const char*)(vcmp + (size_t)pair * 1024 * HD);
    const f16* qp = proj + (size_t)(24 + hd) * (NB * SEQ * HD) + ((size_t)b * SEQ + qpos) * HD;
    h8 qr[4];
#pragma unroll
    for (int d0 = 0; d0 < 4; ++d0) qr[d0] = *(const h8*)(qp + 16 * d0 + 8 * hi);
    const int cmaxq = (qpos >= 31) ? ((qpos - 31) >> 4) : -1;
    const int nt = ((4 * qt + 2) >> 6) + 1;
    __syncthreads();
    for (int i = tid; i < 64 * 256; i += 512) imp[i] = 0.f;
    KVStage st;
    float m = NEG_BIG, l = 0.f;
    for (int pass = 0; pass < 2; ++pass) {
        f32x16 o[2];
#pragma unroll
        for (int r = 0; r < 16; ++r) { o[0][r] = 0.f; o[1][r] = 0.f; }
        float invl = 0.f;
        if (pass == 1) { const float lt = swapsum(l); invl = lt > 0.f ? 1.f / lt : 0.f; }
        __syncthreads();
        kv_issue(st, kc, vc, wid, lane); kv_write(st, kv, wid, lane);
        __syncthreads();
        for (int t = 0; t < nt; ++t) {
            const int cur = t & 1; const bool more = (t + 1 < nt);
            if (more) kv_issue(st, kc + (size_t)(t + 1) * 8192, vc + (size_t)(t + 1) * 8192, wid, lane);
            f32x16 p0, p1;
            qk_tile(p0, p1, kv + cur * 16384, qr, r32, hi);
#pragma unroll
            for (int r = 0; r < 16; ++r) { const int c = 64 * t + crow(r, hi); if (c > cmaxq) p0[r] = -INFINITY; if (c + 32 > cmaxq) p1[r] = -INFINITY; }
            if (pass == 0) {
                const float rm = rowmax32(p0, p1); const float mn = fmaxf(m, rm); const float alpha = fexp2(m - mn); m = mn;
                float s = 0.f;
#pragma unroll
                for (int r = 0; r < 16; ++r) s += fexp2(p0[r] - mn) + fexp2(p1[r] - mn);
                l = l * alpha + s;
            } else {
#pragma unroll
                for (int r = 0; r < 16; ++r) { p0[r] = fexp2(p0[r] - m) * invl; p1[r] = fexp2(p1[r] - m) * invl; }
                const bool wr_lane = ((r32 & 3) == 0);
                LAS float* irow = imp + ql * 256 + 16 * t;
#pragma unroll
                for (int gq = 0; gq < 4; ++gq) {
                    const float a0 = quad_sum(p0[4 * gq]), a1 = quad_sum(p0[4 * gq + 1]), a2 = quad_sum(p0[4 * gq + 2]), a3 = quad_sum(p0[4 * gq + 3]);
                    const float b0 = quad_sum(p1[4 * gq]), b1 = quad_sum(p1[4 * gq + 1]), b2 = quad_sum(p1[4 * gq + 2]), b3 = quad_sum(p1[4 * gq + 3]);
                    if (wr_lane) {
                        const int a = hi + 2 * gq;
                        lds_fadd(irow + a, (a0 + a1) + (a2 + a3)); lds_fadd(irow + 8 + a, (b0 + b1) + (b2 + b3));
                        lds_fadd(irow + a + 1, a3);
                        if (16 * t + 8 + a + 1 < 256) lds_fadd(irow + 8 + a + 1, b3);
                    }
                }
                u32x4 pw[4]; pack_p(pw, p0, p1);
                pv_tile(o, kv + cur * 16384 + 8192, pw, lane, hi);
            }
            if (more) kv_write(st, kv + (cur ^ 1) * 16384, wid, lane);
            __syncthreads();
        }
        if (pass == 1) {
            stage_o(o, 1.f, wsf, stg, r32, hi);
#pragma unroll
            for (int i = 0; i < 4; ++i) { const int row = i * 8 + (lane >> 3), ch = lane & 7; const int q = 64 * qt + 8 * wid + (row >> 2), hh = 4 * g + (row & 3);
                *(u32x4*)(oc + (((size_t)b * 8 + hh) * SEQ + q) * HD + ch * 8) = *(const LAS u32x4*)(stg + row * 64 + ch * 8); }
        }
    }
    for (int qi = 0; qi < 8; ++qi) {
        const int q = 8 * wid + qi;
        const LAS float* irow = imp + q * 256;
        float v[4]; bool sel[4];
#pragma unroll
        for (int i = 0; i < 4; ++i) { const int j = lane + 64 * i; const bool forced = (j == 0) || (j == qt) || (j == qt - 1); const bool fre = (j >= 1) && (j <= qt - 2);
            sel[i] = forced; v[i] = fre ? irow[j] : -1.f; }
        const int nfree = qt - 2;
        if (nfree <= 13) {
#pragma unroll
            for (int i = 0; i < 4; ++i) sel[i] = sel[i] || (v[i] >= 0.f);
        } else {
            for (int round = 0; round < 13; ++round) {
                float bv = v[0]; int bj = lane;
#pragma unroll
                for (int i = 1; i < 4; ++i) if (v[i] > bv) { bv = v[i]; bj = lane + 64 * i; }
#pragma unroll
                for (int off = 1; off < 64; off <<= 1) { const float ov = __shfl_xor(bv, off); const int oj = __shfl_xor(bj, off); if (ov > bv || (ov == bv && oj < bj)) { bv = ov; bj = oj; } }
#pragma unroll
                for (int i = 0; i < 4; ++i) if (bj == lane + 64 * i) { v[i] = -1.f; sel[i] = true; }
            }
        }
        unsigned long long bal[4];
#pragma unroll
        for (int i = 0; i < 4; ++i) bal[i] = __ballot(sel[i]);
        if (lane < 8) { const unsigned long long bb = (lane >> 1) == 0 ? bal[0] : (lane >> 1) == 1 ? bal[1] : (lane >> 1) == 2 ? bal[2] : bal[3];
            nsel[(((size_t)b * 2 + g) * SEQ + 64 * qt + q) * 8 + lane] = (unsigned)((lane & 1) ? (bb >> 32) : bb); }
    }
}

__device__ __forceinline__ void moba_gate_pair(const f16* qslot, const float* kbar, unsigned long long* msel, int unit0, LAS unsigned char* lds) {
    const int tid = opaque_tid(), half = tid >> 8, t = tid & 255;
    const int unit = unit0 + half;
    const int bh = unit >> 6, blk = unit & 63;
    LAS float* kb = (LAS float*)(lds);
    __syncthreads();
    for (int i = tid; i < 4096; i += 512) kb[i] = kbar[(size_t)bh * 4096 + i];
    __syncthreads();
    const int qpos = 256 * blk + t;
    const f16* qp = qslot + ((size_t)bh * SEQ + qpos) * HD;
    float qv[64];
#pragma unroll
    for (int c = 0; c < 8; ++c) { const h8 x = *(const h8*)(qp + 8 * c);
#pragma unroll
        for (int e = 0; e < 8; ++e) qv[8 * c + e] = (float)x[e]; }
    float v0 = -INFINITY, v1 = -INFINITY, v2 = -INFINITY; int i0 = -1, i1 = -1, i2 = -1;
    for (int n = 0; n < blk; ++n) {
        const LAS float* kr = kb + n * 64; float s0 = 0.f, s1 = 0.f, s2 = 0.f, s3 = 0.f;
#pragma unroll
        for (int d = 0; d < 64; d += 4) { const f32x4 kk = *(const LAS f32x4*)(kr + d); s0 += qv[d] * kk[0]; s1 += qv[d + 1] * kk[1]; s2 += qv[d + 2] * kk[2]; s3 += qv[d + 3] * kk[3]; }
        const float s = (s0 + s1) + (s2 + s3);
        if (s > v0) { v2 = v1; i2 = i1; v1 = v0; i1 = i0; v0 = s; i0 = n; }
        else if (s > v1) { v2 = v1; i2 = i1; v1 = s; i1 = n; }
        else if (s > v2) { v2 = s; i2 = n; }
    }
    unsigned long long mk = 0ull;
    if (i0 >= 0) mk |= 1ull << i0; if (i1 >= 0) mk |= 1ull << i1; if (i2 >= 0) mk |= 1ull << i2;
    msel[(size_t)bh * SEQ + qpos] = mk;
}
__device__ __forceinline__ void kbar_block(const f16* kslot, float* kbar, int unit, int lane) {
    const int kg = lane >> 3, dc = lane & 7;
    const f16* kp = kslot + ((size_t)(unit >> 6) * SEQ + 256 * (unit & 63)) * HD + dc * 8;
    float a[8];
#pragma unroll
    for (int e = 0; e < 8; ++e) a[e] = 0.f;
    for (int i = 0; i < 32; ++i) { const h8 x = *(const h8*)(kp + (size_t)(kg + 8 * i) * HD);
#pragma unroll
        for (int e = 0; e < 8; ++e) a[e] += (float)x[e]; }
#pragma unroll
    for (int e = 0; e < 8; ++e) { a[e] += __shfl_xor(a[e], 8); a[e] += __shfl_xor(a[e], 16); a[e] += __shfl_xor(a[e], 32); }
    if (kg == 0) {
#pragma unroll
        for (int e = 0; e < 8; ++e) kbar[(size_t)unit * 64 + dc * 8 + e] = a[e] * (1.f / 256.f);
    }
}
__device__ __forceinline__ void scan_bh(const float* logf, float* c, LAS unsigned char* lds) {
    const int tid = opaque_tid(), lane = tid & 63, wid = tid >> 6;
    LAS double* wsum = (LAS double*)lds;
    float x[32]; double run = 0.0;
#pragma unroll
    for (int i = 0; i < 8; ++i) { const f32x4 v = *(const f32x4*)(logf + tid * 32 + 4 * i); x[4 * i] = v[0]; x[4 * i + 1] = v[1]; x[4 * i + 2] = v[2]; x[4 * i + 3] = v[3]; }
#pragma unroll
    for (int i = 0; i < 32; ++i) run += (double)x[i];
    double inc = run;
#pragma unroll
    for (int o = 1; o < 64; o <<= 1) { const double y = __shfl_up(inc, o); if (lane >= o) inc += y; }
    __syncthreads();
    if (lane == 63) wsum[wid] = inc;
    __syncthreads();
    double base = inc - run;
    for (int w = 0; w < wid; ++w) base += wsum[w];
    double acc = base;
#pragma unroll
    for (int i = 0; i < 8; ++i) { f32x4 o;
#pragma unroll
        for (int j = 0; j < 4; ++j) { acc += (double)x[4 * i + j]; o[j] = (float)(acc * (double)LOG2E); }
        *(f32x4*)(c + tid * 32 + 4 * i) = o; }
    __syncthreads();
}

__device__ __forceinline__ void norm_row(const float* xin, const float* y, float* xout, f16* h, const float* gpost, const float* gpre, int lane) {
    f32x4 xv[4], yv[4]; float ss = 0.f;
#pragma unroll
    for (int j = 0; j < 4; ++j) { xv[j] = *(const f32x4*)(xin + 4 * lane + 256 * j); yv[j] = *(const f32x4*)(y + 4 * lane + 256 * j); ss += (yv[j][0] * yv[j][0] + yv[j][1] * yv[j][1]) + (yv[j][2] * yv[j][2] + yv[j][3] * yv[j][3]); }
    const float rs = 1.f / sqrtf(wave_sum(ss) * (1.f / DM) + RMS_EPS);
    float s2 = 0.f;
#pragma unroll
    for (int j = 0; j < 4; ++j) { const f32x4 gp = *(const f32x4*)(gpost + 4 * lane + 256 * j); xv[j] = xv[j] + yv[j] * rs * gp; *(f32x4*)(xout + 4 * lane + 256 * j) = xv[j];
        s2 += (xv[j][0] * xv[j][0] + xv[j][1] * xv[j][1]) + (xv[j][2] * xv[j][2] + xv[j][3] * xv[j][3]); }
    if (gpre) {
        const float r2 = 1.f / sqrtf(wave_sum(s2) * (1.f / DM) + RMS_EPS);
#pragma unroll
        for (int j = 0; j < 4; ++j) { const f32x4 gq = *(const f32x4*)(gpre + 4 * lane + 256 * j); const f32x4 hv = xv[j] * r2 * gq;
            u32x2 w; w.x = pkh(hv[0], hv[1]); w.y = pkh(hv[2], hv[3]); *(u32x2*)(h + 4 * lane + 256 * j) = w; }
    }
}
__device__ __forceinline__ void norm0_row(const float* xin, f16* h, const float* gpre, int lane) {
    f32x4 xv[4]; float s2 = 0.f;
#pragma unroll
    for (int j = 0; j < 4; ++j) { xv[j] = *(const f32x4*)(xin + 4 * lane + 256 * j); s2 += (xv[j][0] * xv[j][0] + xv[j][1] * xv[j][1]) + (xv[j][2] * xv[j][2] + xv[j][3] * xv[j][3]); }
    const float r2 = 1.f / sqrtf(wave_sum(s2) * (1.f / DM) + RMS_EPS);
#pragma unroll
    for (int j = 0; j < 4; ++j) { const f32x4 gq = *(const f32x4*)(gpre + 4 * lane + 256 * j); const f32x4 hv = xv[j] * r2 * gq;
        u32x2 w; w.x = pkh(hv[0], hv[1]); w.y = pkh(hv[2], hv[3]); *(u32x2*)(h + 4 * lane + 256 * j) = w; }
}

struct RmId { __device__ __forceinline__ int operator()(int n) const { return n; } };
struct RmGate { int off; __device__ __forceinline__ int operator()(int n) const { return (n >> 7) * 256 + off + (n & 127); } };
__device__ __forceinline__ int slot_row(int hs, int d) { return (hs >> 2) * 256 + (d >> 5) * 128 + (hs & 3) * 32 + (d & 31); }
struct RmIn0 { __device__ __forceinline__ int operator()(int n) const {
    int hs, d;
    if (n < 1536) { hs = n >> 6; d = n & 63; }
    else if (n < 1544) { hs = 38; d = n - 1536; }
    else if (n < 2056) { hs = 24 + ((n - 1544) >> 6); d = (n - 1544) & 63; }
    else if (n < 2184) { hs = 32 + ((n - 2056) >> 6); d = (n - 2056) & 63; }
    else if (n < 2312) { hs = 40 + ((n - 2184) >> 6); d = (n - 2184) & 63; }
    else if (n < 2440) { hs = 34 + ((n - 2312) >> 6); d = (n - 2312) & 63; }
    else if (n < 2568) { hs = 42 + ((n - 2440) >> 6); d = (n - 2440) & 63; }
    else if (n < 2696) { hs = 36 + ((n - 2568) >> 6); d = (n - 2568) & 63; }
    else if (n < 2824) { hs = 44 + ((n - 2696) >> 6); d = (n - 2696) & 63; }
    else { hs = 38; d = 8 + (n - 2824); }
    return slot_row(hs, d); } };
struct RmIn1 { __device__ __forceinline__ int operator()(int n) const { return slot_row(n >> 6, n & 63); } };
template <class RM> __device__ __forceinline__ void transpose_item(const float* W, int K, int N, f16* WT, const RM rm, LAS float* scr, int item, int lane) {
    const int nblk = N / 32, kb = item / nblk, nb = item % nblk, k0 = 64 * kb, n0 = 32 * nb;
#pragma unroll 8
    for (int i = 0; i < 32; ++i) { const int kk = 2 * i + (lane >> 5); scr[kk * 33 + (lane & 31)] = W[(size_t)(k0 + kk) * N + n0 + (lane & 31)]; }
    LDS_WAIT(); asm volatile("" ::: "memory");
    const int c = lane & 7;
#pragma unroll
    for (int j = 0; j < 4; ++j) { const int n = (lane >> 3) + 8 * j; const LAS float* s = scr + (8 * c) * 33 + n;
        u32x4 o; o.x = pkh(s[0 * 33], s[1 * 33]); o.y = pkh(s[2 * 33], s[3 * 33]); o.z = pkh(s[4 * 33], s[5 * 33]); o.w = pkh(s[6 * 33], s[7 * 33]);
        *(u32x4*)(WT + (size_t)rm(n0 + n) * K + k0 + 8 * c) = o; }
    LDS_WAIT(); asm volatile("" ::: "memory");
}

constexpr int N_PHASES = 19;
struct Args { const float* in[19]; float* out; unsigned char* ws; int ph_lo, ph_hi; };
static_assert(sizeof(Args) == 176 && offsetof(Args, out) == 152 && offsetof(Args, ws) == 160 && offsetof(Args, ph_lo) == 168, "kernarg offsets used by arg_in()");
__device__ __forceinline__ int q_next(gu32* ctr, volatile LAS int* slot, int) {
    __syncthreads();
    if (threadIdx.x == 0) *slot = (int)__hip_atomic_fetch_add(ctr, 1u, __ATOMIC_RELAXED, __HIP_MEMORY_SCOPE_AGENT);
    __syncthreads();
    return *slot;
}
#define CAS __attribute__((address_space(4)))
__device__ __forceinline__ const float* arg_in(int k) { const CAS char* kp = (const CAS char*)__builtin_amdgcn_kernarg_segment_ptr(); asm volatile("" : "+s"(kp)); return *(const float* const CAS*)(kp + 8 * k); }
__device__ __forceinline__ f16* slot_ptr(unsigned char* ws, int slot, int b) { return (f16*)(ws + WS_PROJ) + ((size_t)slot * NB + b) * SEQ * HD; }

__global__ void __launch_bounds__(512, 2) trunk_fwd(Args args) {
    extern __shared__ __attribute__((aligned(16))) unsigned char lds_raw[];
    LAS unsigned char* lds = (LAS unsigned char*)lds_raw;
    volatile LAS unsigned* MISC = (volatile LAS unsigned*)(lds + L_MISC);
    volatile LAS int* qslot = (volatile LAS int*)(lds + L_MISC);
    const int G = gridDim.x, bid = blockIdx.x, NGW = G * 8;
    unsigned char* ws_ = (unsigned char*)arg_in(20);
    gu32* ctl = (gu32*)(ws_ + WS_CTL);
#define PH_LOCALS unsigned char* ws = ws_; asm volatile("" : "+s"(ws)); const int tid = opaque_tid(), lane = tid & 63; const int wave = __builtin_amdgcn_readfirstlane(tid >> 6); const int gw = bid * 8 + wave; \
    f16* Hb = (f16*)(ws + WS_H); f16* Ob = (f16*)(ws + WS_O); float* Yb = (float*)(ws + WS_Y); f16* PROJ = (f16*)(ws + WS_PROJ); f16* HID = (f16*)(ws + WS_PROJ); \
    (void)tid; (void)lane; (void)wave; (void)gw; (void)Hb; (void)Ob; (void)Yb; (void)PROJ; (void)HID
    if (threadIdx.x < 64) MISC[threadIdx.x] = 0u;
    __syncthreads();
    XcdBarrier bar; bar.bar = (unsigned*)(ctl + CW_BAR); bar.x = 0; bar.st = nullptr;
    if (N_LAUNCH_MODE) bar = xcd_barrier_post((unsigned*)(ctl + CW_BAR), MISC + 8);
    const int lo = ((const CAS int*)__builtin_amdgcn_kernarg_segment_ptr())[42], hi_ = ((const CAS int*)__builtin_amdgcn_kernarg_segment_ptr())[43];
#ifndef PH_MASK
#define PH_MASK 0x3FFu
#endif
#define IN(k) (lo <= (k) && (k) < hi_)
#define INR(r) ((((PH_MASK) >> (r)) & 1u) && IN(pb + (r)))
#define SEAM(k) do { if (IN(k) && IN((k) + 1)) xcd_barrier(bar); } while (0)

    (void)args;

    if (((PH_MASK >> 9) & 1u) && IN(0)) {
        PH_LOCALS;
        LAS float* scr = (LAS float*)(lds + wave * 16384);
        constexpr int I_IN0 = 16 * 89, I_OUT = 16 * 32, I_IN1 = 16 * 96, I_GU = 16 * 88, I_DN = 44 * 32, I_C1 = 32 * 8, I_C2 = 4 * 2;
        constexpr int E0 = I_IN0, E1 = E0 + I_OUT, E2 = E1 + I_IN1, E3 = E2 + I_OUT, E4 = E3 + 4 * I_GU, E5 = E4 + 2 * I_DN, E6 = E5 + 2 * I_C1, E7 = E6 + 2 * I_C2;
        constexpr int Z0 = E7 + 224, Z1 = Z0 + 384, R0 = Z1 + (SEQ * 32) / 64, CB = R0 + 8;
        for (int it = gw; it < CB; it += NGW) {
            if (it < E0) { transpose_item(arg_in(1), 1024, EVEN_IN, (f16*)(ws + WS_W_IN0), RmIn0{}, scr, it, lane); }
            else if (it < E1) { transpose_item(arg_in(9), 1024, 1024, (f16*)(ws + WS_W_OUT0), RmId{}, scr, it - E0, lane); }
            else if (it < E2) { transpose_item(arg_in(10), 1024, 3072, (f16*)(ws + WS_W_IN1), RmIn1{}, scr, it - E1, lane); }
            else if (it < E3) { transpose_item(arg_in(11), 1024, 1024, (f16*)(ws + WS_W_OUT1), RmId{}, scr, it - E2, lane); }
            else if (it < E4) { const int r = it - E3, w = r / I_GU, i = r % I_GU; const int layer = w >> 1, up = w & 1;
                transpose_item(arg_in(up ? 17 : 16) + (size_t)layer * 1024 * FF, 1024, FF, (f16*)(ws + (layer ? WS_W_GU1 : WS_W_GU0)), RmGate{up * 128}, scr, i, lane); }
            else if (it < E5) { const int r = it - E4, layer = r / I_DN, i = r % I_DN;
                transpose_item(arg_in(18) + (size_t)layer * FF * 1024, FF, 1024, (f16*)(ws + (layer ? WS_W_DN1 : WS_W_DN0)), RmId{}, scr, i, lane); }
            else if (it < E6) { const int r = it - E5, w = r / I_C1, i = r % I_C1;
                transpose_item(arg_in(w ? 7 : 4), 2048, 256, (f16*)(ws + (w ? WS_W_C1V : WS_W_C1K)), RmId{}, scr, i, lane); }
            else if (it < E7) { const int r = it - E6, w = r / I_C2, i = r % I_C2;
                transpose_item(arg_in(w ? 8 : 5), 256, 64, (f16*)(ws + (w ? WS_W_C2V : WS_W_C2K)), RmId{}, scr, i, lane); }
            else if (it < Z0) { const int r = it - E7; int row;
                if (r < 32) row = slot_row(38, 32 + r); else if (r < 96) row = slot_row(39, r - 32); else if (r < 160) row = slot_row(46, r - 96); else row = slot_row(47, r - 160);
                u32x4 z = {0u, 0u, 0u, 0u}; u32x4* p = (u32x4*)((f16*)(ws + WS_W_IN0) + (size_t)row * 1024); p[lane] = z; p[lane + 64] = z; }
            else if (it < Z1) { const int r = it - Z0, w = r / 192, row = 64 + r % 192;
                if (lane < 32) ((u32x4*)((f16*)(ws + (w ? WS_W_C2V : WS_W_C2K)) + (size_t)row * 256))[lane] = (u32x4){0u, 0u, 0u, 0u}; }
            else if (it < R0) { const int e = (it - Z1) * 64 + lane; const int pos = e >> 5, i = e & 31;
                const float inv = (float)pow(10000.0, -(double)(2 * i) / 64.0); const float ang = (float)pos * inv;
                ((float*)(ws + WS_COS))[e] = (float)cos((double)ang); ((float*)(ws + WS_SIN))[e] = (float)sin((double)ang); }
            else { const int r = it - R0, w = r >> 2, n = (r & 3) * 64 + lane;
                const float* pe = arg_in(w ? 6 : 3); const float* w1 = arg_in(w ? 7 : 4); float s = 0.f;
                for (int k = 0; k < 2048; ++k) s += pe[k] * w1[(size_t)k * 256 + n];
                ((float*)(ws + WS_CBIAS))[w * 256 + n] = s; }
        }
        const float* xin0 = arg_in(0); const float* g0p = arg_in(12);
        for (int m = gw; m < MROWS; m += NGW) norm0_row(xin0 + (size_t)m * DM, Hb + (size_t)m * DM, g0p, lane);
    }
    SEAM(0);

    for (int layer = 0; layer < 2; ++layer) {
        const int pb = 1 + 9 * layer;
        if (INR(0)) {
            PH_LOCALS;
            pg8::Gemm g{Hb, (const f16*)(ws + (layer ? WS_W_IN1 : WS_W_IN0)), 1024, 1024}; pg8::StaticOrder S; S.init(MROWS, NIN, G, bid);
            pg8::EpiInProj E{PROJ, (const float*)(ws + WS_COS), (const float*)(ws + WS_SIN), (float*)(ws + WS_LOGF), (float*)(ws + WS_GATES), arg_in(2), layer};
            pg8::gemm_phase<pg8::EpiInProj, pg8::StaticOrder, true>(lds, g, S, E);
        }
        SEAM(pb);
        if (layer == 0) {
            if (INR(1)) {
            PH_LOCALS;
#ifndef NO_CMP
                if (bid < 32) {
                    const int which = bid >> 4, pm = bid & 15;
                    int c1k = 2048, c1lda = 1024, c2k = 256; asm volatile("" : "+s"(c1k), "+s"(c1lda), "+s"(c2k));
                    f16* hid = (f16*)(ws + (which ? WS_HIDV : WS_HIDK));
                    { pg8::Gemm g{slot_ptr(ws, which ? 38 : 32, 0), (const f16*)(ws + (which ? WS_W_C1V : WS_W_C1K)), c1lda, c1k}; pg8::SingleOrder S{{pm, 0}, G > 0 ? 1 : 0};
                      pg8::EpiCmp1 E{hid, (const float*)(ws + WS_CBIAS) + which * 256};
                      pg8::gemm_phase<pg8::EpiCmp1, pg8::SingleOrder, false>(lds, g, S, E); }
                    VM_WAIT(); __syncthreads(); __builtin_amdgcn_fence(__ATOMIC_ACQUIRE, "agent"); VM_WAIT(); __syncthreads();
                    { pg8::Gemm g{hid, (const f16*)(ws + (which ? WS_W_C2V : WS_W_C2K)), c2k, c2k}; pg8::SingleOrder S{{pm, 0}, G > 0 ? 1 : 0};
                      pg8::EpiCmp2 E{(f16*)(ws + (which ? WS_VCMP : WS_KCMP))};
                      pg8::gemm_phase<pg8::EpiCmp2, pg8::SingleOrder, false>(lds, g, S, E); }
                } else
#endif
#ifndef NO_SCAN
                if (bid >= 32 && bid < 48) {
                    const int bh = bid - 32;
                    scan_bh((const float*)(ws + WS_LOGF) + (size_t)bh * SEQ, (float*)(ws + WS_C) + (size_t)bh * SEQ, lds);
                }
#else
                {}
#endif
#ifndef NO_WIN
                for (int u = q_next(ctl + CW_Q, qslot, tid); u < 1024; u = q_next(ctl + CW_Q, qslot, tid)) {
                    WinF f; f.proj = PROJ; f.ow = (f16*)(ws + WS_OW); f.qt = 255 - (u >> 2); f.b = (u & 3) >> 1; f.g = u & 1;
                    attn_unit(f, lds);
                }
#endif
            }
            SEAM(pb + 1);
            if (INR(2)) {
            PH_LOCALS;
                for (int u = q_next(ctl + CW_Q + 64, qslot, tid); u < 1024; u = q_next(ctl + CW_Q + 64, qslot, tid)) {
                    FoxF f; f.qb = 63 - (u >> 4); f.b = (u & 15) >> 3; f.h = u & 7;
                    f.q = slot_ptr(ws, f.h, f.b); f.k = slot_ptr(ws, 8 + f.h, f.b); f.v = slot_ptr(ws, 16 + f.h, f.b);
                    f.c = (const float*)(ws + WS_C) + ((size_t)f.b * 8 + f.h) * SEQ; f.O = Ob;
                    attn_unit(f, lds);
                }
                for (int u = q_next(ctl + CW_Q + 128, qslot, tid); u < 1024; u = q_next(ctl + CW_Q + 128, qslot, tid)) {
                    nsa_cmp_unit(PROJ, (const f16*)(ws + WS_KCMP), (const f16*)(ws + WS_VCMP), (f16*)(ws + WS_OC), (unsigned*)(ws + WS_NSEL), (u & 3) >> 1, u & 1, 255 - (u >> 2), lds);
                }
            }
            SEAM(pb + 2);
            if (INR(3)) {
            PH_LOCALS;
                for (int u = q_next(ctl + CW_Q + 192, qslot, tid); u < 1024; u = q_next(ctl + CW_Q + 192, qslot, tid)) {
                    SelF f; f.proj = PROJ; f.nsel = (const unsigned*)(ws + WS_NSEL); f.oc = (const f16*)(ws + WS_OC); f.ow = (const f16*)(ws + WS_OW);
                    f.gates = (const float*)(ws + WS_GATES); f.O = Ob; f.qt = 255 - (u >> 2); f.b = (u & 3) >> 1; f.g = u & 1;
                    attn_unit(f, lds);
                }
            }
            SEAM(pb + 3);
        } else {
            if (INR(1)) { PH_LOCALS; for (int u = gw; u < 2048; u += NGW) kbar_block(slot_ptr(ws, 16, 0), (float*)(ws + WS_KBAR), u, lane); }
            SEAM(pb + 1);
            if (INR(2)) { PH_LOCALS; for (int pu = bid; pu < 1024; pu += G) moba_gate_pair(slot_ptr(ws, 0, 0), (const float*)(ws + WS_KBAR), (unsigned long long*)(ws + WS_MSEL), 2 * pu, lds); }
            SEAM(pb + 2);
            if (INR(3)) {
            PH_LOCALS;
                for (int u = q_next(ctl + CW_Q + 256, qslot, tid); u < 2048; u = q_next(ctl + CW_Q + 256, qslot, tid)) {
                    MobaF f; f.qb = 63 - (u >> 5); const int bh = u & 31; f.h = bh >> 1; f.b = bh & 1;
                    f.q = slot_ptr(ws, 0, 0) + (size_t)bh * SEQ * HD; f.k = slot_ptr(ws, 16, 0) + (size_t)bh * SEQ * HD; f.v = slot_ptr(ws, 32, 0) + (size_t)bh * SEQ * HD;
                    f.msel = (const unsigned long long*)(ws + WS_MSEL) + (size_t)bh * SEQ; f.O = Ob;
                    attn_unit(f, lds);
                }
            }
            SEAM(pb + 3);
        }
        if (INR(4)) {
            PH_LOCALS;
            pg8::Gemm g{Ob, (const f16*)(ws + (layer ? WS_W_OUT1 : WS_W_OUT0)), 1024, 1024}; pg8::StaticOrder S; S.init(MROWS, DM, G, bid);
            pg8::EpiF32 E{Yb, DM};
            pg8::gemm_phase<pg8::EpiF32, pg8::StaticOrder, true>(lds, g, S, E);
        }
        SEAM(pb + 4);
        if (INR(5)) {
            PH_LOCALS;
            float* xres = (float*)arg_in(19); const float* xsrc = layer == 0 ? arg_in(0) : xres;
            for (int m = gw; m < MROWS; m += NGW) norm_row(xsrc + (size_t)m * DM, Yb + (size_t)m * DM, xres + (size_t)m * DM, Hb + (size_t)m * DM, arg_in(13) + layer * DM, arg_in(14) + layer * DM, lane);
        }
        SEAM(pb + 5);
        if (INR(6)) {
            PH_LOCALS;
            pg8::Gemm g{Hb, (const f16*)(ws + (layer ? WS_W_GU1 : WS_W_GU0)), 1024, 1024}; pg8::StaticOrder S; S.init(MROWS, 2 * FF, G, bid);
            pg8::EpiSwiGLU E{HID};
            pg8::gemm_phase<pg8::EpiSwiGLU, pg8::StaticOrder, true>(lds, g, S, E);
        }
        SEAM(pb + 6);
        if (INR(7)) {
            PH_LOCALS;
            pg8::Gemm g{HID, (const f16*)(ws + (layer ? WS_W_DN1 : WS_W_DN0)), FF, FF}; pg8::StaticOrder S; S.init(MROWS, DM, G, bid);
            pg8::EpiF32 E{Yb, DM};
            pg8::gemm_phase<pg8::EpiF32, pg8::StaticOrder, true>(lds, g, S, E);
        }
        SEAM(pb + 7);
        if (INR(8)) {
            PH_LOCALS;
            float* xres = (float*)arg_in(19);
            for (int m = gw; m < MROWS; m += NGW) norm_row(xres + (size_t)m * DM, Yb + (size_t)m * DM, xres + (size_t)m * DM, Hb + (size_t)m * DM, arg_in(15) + layer * DM, layer == 0 ? arg_in(12) + DM : nullptr, lane);
        }
        SEAM(pb + 8);
    }
#undef IN
#undef SEAM
}

extern "C" void kernel_launch(void* const* d_in, const int* in_sizes, int n_in, void* d_out, int out_size, void* d_ws, size_t ws_size, hipStream_t stream) {
    static int grid = 0;
    if (grid == 0) {
        if (n_in != 19 || out_size != MROWS * DM || ws_size < WS_END) { fprintf(stderr, "kernel_launch: unexpected problem (n_in %d, out %d, ws %zu)\n", n_in, out_size, ws_size); grid = -1; return; }
        int dev = 0, cus = 0, per_cu = 0;
        if (hipGetDevice(&dev) != hipSuccess || hipDeviceGetAttribute(&cus, hipDeviceAttributeMultiprocessorCount, dev) != hipSuccess) { grid = -1; return; }
        if (hipFuncSetAttribute((const void*)trunk_fwd, hipFuncAttributeMaxDynamicSharedMemorySize, LDS_BYTES) != hipSuccess) { fprintf(stderr, "kernel_launch: hipFuncSetAttribute failed\n"); grid = -1; return; }
        if (hipOccupancyMaxActiveBlocksPerMultiprocessor(&per_cu, (const void*)trunk_fwd, 512, LDS_BYTES) != hipSuccess || per_cu < 1) fprintf(stderr, "kernel_launch: occupancy query says %d\n", per_cu);
        (void)hipGetLastError();
        grid = cus;
    }
    if (grid < 0) return;
    (void)hipMemsetAsync((char*)d_ws + WS_CTL, 0, CTL_ZERO_BYTES, stream);
    Args a{};
    for (int i = 0; i < 19; ++i) a.in[i] = (const float*)d_in[i];
    a.out = (float*)d_out; a.ws = (unsigned char*)d_ws;
#if N_LAUNCH_MODE
    a.ph_lo = 0; a.ph_hi = N_PHASES;
    hipLaunchKernelGGL(trunk_fwd, dim3(grid), dim3(512), LDS_BYTES, stream, a);
#else
    for (int p = 0; p < N_PHASES; ++p) { a.ph_lo = p; a.ph_hi = p + 1; hipLaunchKernelGGL(trunk_fwd, dim3(grid), dim3(512), LDS_BYTES, stream, a); }
#endif
}
```

```cpp
#include <hip/hip_runtime.h>
#include <cstdio>
#include <cstdint>
#include <cstddef>

#ifndef N_LAUNCH_MODE
#define N_LAUNCH_MODE 1

#endif

#define LAS __attribute__((address_space(3)))
#define GAS __attribute__((address_space(1)))
#define CAS __attribute__((address_space(4)))
typedef _Float16 f16;
typedef _Float16 h8 __attribute__((ext_vector_type(8)));
typedef _Float16 h2 __attribute__((ext_vector_type(2)));
typedef _Float16 h4 __attribute__((ext_vector_type(4)));
typedef short s16x4 __attribute__((ext_vector_type(4)));
typedef float f32x2 __attribute__((ext_vector_type(2)));
typedef float f32x4 __attribute__((ext_vector_type(4)));
typedef float f32x16 __attribute__((ext_vector_type(16)));
typedef unsigned u32x4 __attribute__((ext_vector_type(4)));
typedef unsigned u32x2 __attribute__((ext_vector_type(2)));
typedef GAS unsigned gu32;

constexpr int NB = 2, SEQ = 16384, DM = 1024, MROWS = NB * SEQ, HD = 64, FF = 2816;
constexpr int NIN = 3072;
constexpr int EVEN_IN = 2848;
constexpr float RMS_EPS = 1e-6f;
constexpr float LOG2E = 1.4426950408889634f;
constexpr float QSCALE = 0.125f * LOG2E;
constexpr float NEG_BIG = -1e30f;

constexpr size_t MiB = 1u << 20;
constexpr size_t WS_CTL = 0, CTL_ZERO_BYTES = 1 * MiB;
constexpr size_t WS_COS = 1 * MiB, WS_SIN = 3 * MiB;
constexpr size_t WS_CBIAS = 5 * MiB;
constexpr size_t WS_KBAR = 5 * MiB + 65536;
constexpr size_t WS_C = 6 * MiB;
constexpr size_t WS_LOGF = 7 * MiB;
constexpr size_t WS_W_IN0 = 8 * MiB, WS_W_OUT0 = 14 * MiB, WS_W_IN1 = 16 * MiB, WS_W_OUT1 = 22 * MiB;
constexpr size_t WS_W_GU0 = 24 * MiB, WS_W_GU1 = 35 * MiB, WS_W_DN0 = 46 * MiB, WS_W_DN1 = 46 * MiB + 5632 * 1024, WS_W_C1K = 57 * MiB, WS_W_C1V = 58 * MiB;
constexpr size_t WS_W_C2K = 59 * MiB, WS_W_C2V = 59 * MiB + 131072;
constexpr size_t WS_GATES = 60 * MiB;
constexpr size_t WS_H = 64 * MiB;
constexpr size_t WS_HIDK = WS_H, WS_HIDV = WS_H + 2 * MiB;
constexpr size_t WS_KCMP = WS_H + 4 * MiB, WS_VCMP = WS_H + 4 * MiB + 524288;
constexpr size_t WS_NSEL = WS_H + 5 * MiB;
constexpr size_t WS_LISTS = WS_H + 8 * MiB;
constexpr size_t WS_O = 128 * MiB;
constexpr size_t WS_PROJ = 192 * MiB;
constexpr size_t WS_Y = 384 * MiB;
constexpr size_t WS_OC = WS_Y, WS_OW = WS_Y + 32 * MiB;
constexpr size_t WS_PO = WS_Y, WS_PML = WS_Y + 96 * MiB;
constexpr size_t WS_SLIST = WS_H + 8 * MiB;
constexpr size_t WS_SPML = WS_H + 40 * MiB;
constexpr size_t WS_SPO = WS_Y;
constexpr size_t SPO_STRIDE = 56 * MiB, SPML_STRIDE = 8 * MiB;
constexpr size_t WS_END = 512 * MiB;
constexpr size_t SLOT_BYTES = (size_t)NB * SEQ * HD * 2;

constexpr int CW_BAR = 4096;
constexpr int CW_Q = 16384;
constexpr int CW_LCNT = 32768;
constexpr int CW_SCNT = 40960;
constexpr int CW_KN2 = 36864;
constexpr size_t WS_QN2 = WS_CBIAS + 32768;

constexpr int LDS_BYTES = 147456;
constexpr int L_KV = 0;
constexpr int L_OST = 32768;
constexpr int L_IMP = 65536;
constexpr int L_WSF = 131072;
constexpr int L_CS = 133120;
constexpr int L_SEL = 133632;
constexpr int L_MISC = 147456 - 256;

__device__ __forceinline__ unsigned pkh(float lo, float hi) { f32x2 v = {lo, hi}; h2 b = __builtin_convertvector(v, h2); return __builtin_bit_cast(unsigned, b); }
__device__ __forceinline__ float wave_sum(float v) {
#pragma unroll
    for (int o = 1; o < 64; o <<= 1) v += __shfl_xor(v, o);
    return v;
}
__device__ __forceinline__ int opaque_tid() { int t = threadIdx.x; asm volatile("" : "+v"(t)); return t; }
__device__ __forceinline__ float fexp2(float x) { return __builtin_amdgcn_exp2f(x); }
#define MFMA32(a, b, c) __builtin_amdgcn_mfma_f32_32x32x16_f16(a, b, c, 0, 0, 0)
#define MFMA16(a, b, c) __builtin_amdgcn_mfma_f32_16x16x32_f16(a, b, c, 0, 0, 0)
#define LDS_WAIT() asm volatile("s_waitcnt lgkmcnt(0)" ::: "memory")
#define VM_WAIT() asm volatile("s_waitcnt vmcnt(0)" ::: "memory")

#define XB_TMO      128
#define XB_XCNT(j)  (256  + 64 * (j))
#define XB_XSUB(j)  (1280 + 64 * (j))
#define XB_XGEN(j)  (2304 + 64 * (j))
#define XB_TOP      3328
#define XB_TOPGEN   3392
#define XCD_BAR_WORDS 3456
#define XB_SPIN_CAP (1u << 20)
__device__ __forceinline__ unsigned xb_ld(unsigned* p)              { return __hip_atomic_load(p, __ATOMIC_RELAXED, __HIP_MEMORY_SCOPE_AGENT); }
__device__ __forceinline__ unsigned xb_add(unsigned* p, unsigned v) { return __hip_atomic_fetch_add(p, v, __ATOMIC_RELAXED, __HIP_MEMORY_SCOPE_AGENT); }
__device__ __forceinline__ unsigned xb_xcc_id() { return (unsigned)__builtin_amdgcn_s_getreg((3 << 11) | 20) & 0xFu; }
#define XB_SPIN(cond, bar) do { unsigned _sp = 0; while (cond) { __builtin_amdgcn_s_sleep(1); \
    if ((++_sp & 255u) == 0u) { if (xb_ld(&(bar)[XB_TMO])) break; if (_sp > XB_SPIN_CAP) { atomicAdd(&(bar)[XB_TMO], 1u); break; } } } } while (0)
struct XcdBarrier { unsigned* bar; unsigned x; volatile LAS unsigned* st; };
__device__ __forceinline__ XcdBarrier xcd_barrier_post(unsigned* bar, volatile LAS unsigned* st) {
    XcdBarrier b; b.bar = bar; b.x = xb_xcc_id(); b.st = st;
    if (threadIdx.x == 0) (void)xb_add(&bar[XB_XCNT(b.x)], 1u);
    return b;
}
__device__ __forceinline__ void xcd_barrier_complete(unsigned* bar, unsigned x, unsigned& nloc, unsigned& nx) {
    const unsigned G = gridDim.x * gridDim.y * gridDim.z;
    unsigned sum, cnt, mine, sp = 0u;
    for (;;) {
        sum = 0u; cnt = 0u; mine = 0u;
#pragma unroll
        for (unsigned j = 0; j < 16; ++j) { const unsigned c = xb_ld(&bar[XB_XCNT(j)]); sum += c; cnt += (c > 0u) ? 1u : 0u; mine = (j == x) ? c : mine; }
        if (sum == G) break;
        __builtin_amdgcn_s_sleep(1);
        if ((++sp & 255u) == 0u) { if (xb_ld(&bar[XB_TMO])) break; if (sp > XB_SPIN_CAP) { atomicAdd(&bar[XB_TMO], 1u); break; } }
    }
    nloc = mine > 0u ? mine : 1u; nx = cnt > 0u ? cnt : 1u;
}
__device__ __forceinline__ void xcd_barrier(const XcdBarrier& b) {
    asm volatile("s_waitcnt vmcnt(0)" ::: "memory");
    __syncthreads();
    if (threadIdx.x == 0) {
        unsigned* bar = b.bar;
        __builtin_amdgcn_s_waitcnt(0);
        unsigned nloc = b.st[0], nx = b.st[1];
        if (nloc == 0u) { xcd_barrier_complete(bar, b.x, nloc, nx); b.st[0] = nloc; b.st[1] = nx; }
        const unsigned old = xb_add(&bar[XB_XSUB(b.x)], 1u);
        const unsigned gen = old / nloc;
        if (old + 1u == (gen + 1u) * nloc) {
            __builtin_amdgcn_fence(__ATOMIC_RELEASE, "agent");
            asm volatile("s_waitcnt vmcnt(0)" ::: "memory");
            const unsigned og = xb_add(&bar[XB_TOP], 1u);
            const unsigned tg = og / nx;
            if (og + 1u == (tg + 1u) * nx) xb_add(&bar[XB_TOPGEN], 1u);
            else XB_SPIN(xb_ld(&bar[XB_TOPGEN]) == tg, bar);
            __builtin_amdgcn_fence(__ATOMIC_ACQUIRE, "agent");
            xb_add(&bar[XB_XGEN(b.x)], 1u);
            asm volatile("s_waitcnt vmcnt(0)" ::: "memory");
        } else {
            XB_SPIN(xb_ld(&bar[XB_XGEN(b.x)]) == gen, bar);
            __builtin_amdgcn_fence(__ATOMIC_ACQUIRE, "agent");
            asm volatile("s_waitcnt vmcnt(0)" ::: "memory");
        }
    }
    __syncthreads();
}

namespace pg8 {
constexpr int BM = 256, BK = 64, HALF = 128, HTB = HALF * BK * 2, NXCD = 8, WGM = 8;
__host__ __device__ __forceinline__ int lds_byte(int r, int c) { const int st = (r >> 4) * 2 + (c >> 5), rr = r & 15, cc = c & 31, ob = rr * 64 + cc * 2; return st * 1024 + (ob ^ (((ob >> 9) & 1) << 5)); }
__host__ __device__ __forceinline__ void stage_rc(int b, int& R, int& C) { const int st = b / 1024, sb = b % 1024, swz = sb ^ (((sb >> 9) & 1) << 5); R = (st >> 1) * 16 + swz / 64; C = (st & 1) * 32 + (swz % 64) / 2; }
__host__ __device__ __forceinline__ int perm32(int rho) { const int n = rho >> 4, i = rho & 15; return 8 * (i >> 2) + 4 * n + (i & 3); }
struct Unit { int pm, pn; };
struct Gemm { const f16* A; const f16* Bt; int lda, K; };
struct StaticOrder {
    int nM, nN, nwg, G, c;
    __device__ void init(int M, int N, int G_, int c_) { nM = M / BM; nN = N / BM; nwg = nM * nN; G = G_; c = c_; }
    __device__ bool next(int i, Unit& u) const {
        const long L = (long)i * G + c; if (L >= nwg) return false;
        int wgid = (int)L; { const int q = nwg / NXCD, r = nwg % NXCD, xcd = wgid % NXCD, off = wgid / NXCD; wgid = (xcd < r ? xcd * (q + 1) : r * (q + 1) + (xcd - r) * q) + off; }
        const int nig = WGM * nN, gid = wgid / nig, fm = gid * WGM, gsz = (nM - fm) < WGM ? (nM - fm) : WGM;
        u.pm = fm + ((wgid % nig) % gsz); u.pn = (wgid % nig) / gsz; return true;
    }
};
struct SingleOrder { Unit u; int n; __device__ bool next(int i, Unit& o) const { if (i >= n) return false; o = u; return true; } };

template <class Epi, class Sched, bool ALIGN_EPI>
__device__ __forceinline__ void gemm_phase(LAS unsigned char* lds, const Gemm g, const Sched& S, const Epi& E) {
    const int tid = opaque_tid(), wid = __builtin_amdgcn_readfirstlane(tid >> 6), lane = tid & 63, wr = wid >> 2, wc = wid & 3, fr = lane & 15, fq = lane >> 4;
    const int K = g.K, nt = K / BK, lda = g.lda;
    unsigned voffA[2], voffB[2];
#pragma unroll
    for (int i = 0; i < 2; ++i) { int R, C; stage_rc(tid * 16 + i * 8192, R, C); const int Rb = (R & ~31) + perm32(R & 31);
        voffA[i] = (unsigned)(R * lda + C) * 2u; voffB[i] = (unsigned)(Rb * K + C) * 2u; }
    const size_t kstep = (size_t)(BK * 2);
    const size_t hstepA = (size_t)HALF * lda * 2, tstepA = 2 * hstepA;
    const size_t hstepB = (size_t)HALF * K * 2, tstepB = 2 * hstepB;
    const unsigned ldsw = (unsigned)wid * 1024u;
    const int aoff = lds_byte(wr * 64 + fr, fq * 8), boff = lds_byte(wc * 32 + fr, fq * 8);
#define PG8_SA(b, h) (((b) * 2 + (h)) * HTB)
#define PG8_SB(b, h) ((4 + (b) * 2 + (h)) * HTB)
#define PG8_STAGE(bufoff, gbase, voff) do { _Pragma("unroll") for (int _i = 0; _i < 2; ++_i) \
        __builtin_amdgcn_global_load_lds((const unsigned*)((const char*)(gbase) + (voff)[_i]), (LAS unsigned*)(lds + (bufoff) + ldsw + _i * 8192), 16, 0, 0); } while (0)
#define PG8_LDA(dst, b, h) do { _Pragma("unroll") for (int m = 0; m < 4; ++m) _Pragma("unroll") for (int k = 0; k < 2; ++k) dst[m][k] = *(const LAS h8*)(lds + PG8_SA(b, h) + aoff + m * 2048 + k * 1024); } while (0)
#define PG8_LDB(dst, b, h) do { _Pragma("unroll") for (int n = 0; n < 2; ++n) _Pragma("unroll") for (int k = 0; k < 2; ++k) dst[n][k] = *(const LAS h8*)(lds + PG8_SB(b, h) + boff + n * 2048 + k * 1024); } while (0)
#define PG8_MMA(ai, bj, At, Bt) do { __builtin_amdgcn_s_setprio(1); _Pragma("unroll") for (int m = 0; m < 4; ++m) _Pragma("unroll") for (int n = 0; n < 2; ++n) _Pragma("unroll") for (int k = 0; k < 2; ++k) \
        acc[ai][bj][m][n] = MFMA16(Bt[n][k], At[m][k], acc[ai][bj][m][n]); __builtin_amdgcn_s_setprio(0); } while (0)
#define PG8_WAIT_V(n) asm volatile("s_waitcnt vmcnt(" #n ")" ::: "memory")
#define PG8_WAIT_L(n) asm volatile("s_waitcnt lgkmcnt(" #n ")" ::: "memory")
#define PG8_BAR __builtin_amdgcn_s_barrier()
#define PG8_SCHED __builtin_amdgcn_sched_barrier(0)
    Unit cur, nxt; int ui = 0;
    if (!S.next(0, cur)) return;
    f32x4 acc[2][2][4][2];
#pragma unroll
    for (int a = 0; a < 2; ++a)
#pragma unroll
        for (int b = 0; b < 2; ++b)
#pragma unroll
            for (int m = 0; m < 4; ++m)
#pragma unroll
                for (int n = 0; n < 2; ++n) acc[a][b][m][n] = (f32x4){0.f, 0.f, 0.f, 0.f};
    h8 At[4][2], B0[2][2], B1[2][2];
    const char* cA = (const char*)g.A + (size_t)cur.pm * tstepA; const char* cB = (const char*)g.Bt + (size_t)cur.pn * tstepB;
    PG8_STAGE(PG8_SB(0, 0), cB, voffB); PG8_STAGE(PG8_SB(0, 1), cB + hstepB, voffB); PG8_STAGE(PG8_SA(0, 0), cA, voffA); PG8_STAGE(PG8_SA(0, 1), cA + hstepA, voffA);
    if (wr == 1) PG8_BAR;
    PG8_WAIT_V(2); PG8_BAR;
    PG8_STAGE(PG8_SB(1, 0), cB + kstep, voffB); PG8_STAGE(PG8_SA(1, 0), cA + kstep, voffA); PG8_STAGE(PG8_SB(1, 1), cB + hstepB + kstep, voffB);
    PG8_WAIT_V(6); PG8_BAR;
    for (;;) {
        const bool has_next = S.next(ui + 1, nxt);
        const char* nA = has_next ? (const char*)g.A + (size_t)nxt.pm * tstepA : cA; const char* nB = has_next ? (const char*)g.Bt + (size_t)nxt.pn * tstepB : cB;
#pragma unroll 1
        for (int t = 0; t < nt; t += 2) {
            const bool last = (t == nt - 2);
            const char* a1 = cA + (size_t)(t + 1) * kstep;
            const char* a2 = last ? nA : cA + (size_t)(t + 2) * kstep; const char* b2 = last ? nB : cB + (size_t)(t + 2) * kstep;
            const char* a3 = a2 + kstep; const char* b3 = b2 + kstep;
            PG8_LDB(B0, 0, 0); PG8_LDB(B1, 0, 1); PG8_SCHED; PG8_LDA(At, 0, 0); PG8_STAGE(PG8_SA(1, 1), a1 + hstepA, voffA);
            PG8_WAIT_V(8); PG8_WAIT_L(0); PG8_BAR; PG8_MMA(0, 0, At, B0); PG8_MMA(0, 1, At, B1); PG8_BAR; PG8_SCHED;
            PG8_LDA(At, 0, 1); PG8_STAGE(PG8_SB(0, 0), b2, voffB); PG8_STAGE(PG8_SB(0, 1), b2 + hstepB, voffB); PG8_STAGE(PG8_SA(0, 0), a2, voffA);
            PG8_WAIT_V(8); PG8_WAIT_L(0); PG8_BAR; PG8_MMA(1, 0, At, B0); PG8_MMA(1, 1, At, B1); PG8_BAR; PG8_SCHED;
            PG8_LDB(B0, 1, 0); PG8_LDB(B1, 1, 1); PG8_SCHED; PG8_LDA(At, 1, 0); PG8_STAGE(PG8_SA(0, 1), a2 + hstepA, voffA);
            PG8_WAIT_V(8); PG8_WAIT_L(0); PG8_BAR; PG8_MMA(0, 0, At, B0); PG8_MMA(0, 1, At, B1); PG8_BAR; PG8_SCHED;
            PG8_LDA(At, 1, 1); PG8_STAGE(PG8_SB(1, 0), b3, voffB); PG8_STAGE(PG8_SB(1, 1), b3 + hstepB, voffB); PG8_STAGE(PG8_SA(1, 0), a3, voffA);
            PG8_WAIT_V(8); PG8_WAIT_L(0); PG8_BAR; PG8_MMA(1, 0, At, B0); PG8_MMA(1, 1, At, B1); PG8_BAR; PG8_SCHED;
        }
        if constexpr (ALIGN_EPI) { if (wr == 0) PG8_BAR; }
        E(acc, cur, wr, wc, fr, fq);
        if (!has_next) break;
#pragma unroll
        for (int a = 0; a < 2; ++a)
#pragma unroll
            for (int b = 0; b < 2; ++b)
#pragma unroll
                for (int m = 0; m < 4; ++m)
#pragma unroll
                    for (int n = 0; n < 2; ++n) acc[a][b][m][n] = (f32x4){0.f, 0.f, 0.f, 0.f};
        cur = nxt; cA = nA; cB = nB; ++ui;
        if constexpr (ALIGN_EPI) { if (wr == 1) PG8_BAR; }
    }
    PG8_WAIT_V(0);
    if constexpr (!ALIGN_EPI) { if (wr == 0) PG8_BAR; }
    PG8_BAR;
#undef PG8_SA
#undef PG8_SB
#undef PG8_STAGE
#undef PG8_LDA
#undef PG8_LDB
#undef PG8_MMA
#undef PG8_WAIT_V
#undef PG8_WAIT_L
#undef PG8_BAR
#undef PG8_SCHED
}
typedef f32x4 Acc[2][2][4][2];

struct EpiF32 {
    float* Y; int ldc;
    __device__ __forceinline__ void operator()(const Acc& acc, const Unit& u, int wr, int wc, int fr, int fq) const {
        const int row0 = u.pm * BM + wr * 64 + fr, col0 = u.pn * BM + wc * 32 + 8 * fq;
#pragma unroll
        for (int ai = 0; ai < 2; ++ai)
#pragma unroll
            for (int m = 0; m < 4; ++m) { float* rowp = Y + (size_t)(row0 + ai * HALF + m * 16) * ldc + col0;
#pragma unroll
                for (int bj = 0; bj < 2; ++bj) { *(f32x4*)(rowp + bj * HALF) = acc[ai][bj][m][0]; *(f32x4*)(rowp + bj * HALF + 4) = acc[ai][bj][m][1]; } }
    }
};
struct EpiF16 {
    f16* Y; int ldc;
    __device__ __forceinline__ void operator()(const Acc& acc, const Unit& u, int wr, int wc, int fr, int fq) const {
        const int row0 = u.pm * BM + wr * 64 + fr, col0 = u.pn * BM + wc * 32 + 8 * fq;
#pragma unroll
        for (int ai = 0; ai < 2; ++ai)
#pragma unroll
            for (int m = 0; m < 4; ++m) { f16* rowp = Y + (size_t)(row0 + ai * HALF + m * 16) * ldc + col0;
#pragma unroll
                for (int bj = 0; bj < 2; ++bj) { const f32x4 a = acc[ai][bj][m][0], b = acc[ai][bj][m][1];
                    u32x4 w; w.x = pkh(a[0], a[1]); w.y = pkh(a[2], a[3]); w.z = pkh(b[0], b[1]); w.w = pkh(b[2], b[3]); *(u32x4*)(rowp + bj * HALF) = w; } }
    }
};
struct EpiSwiGLU {
    f16* Hd;
    __device__ __forceinline__ void operator()(const Acc& acc, const Unit& u, int wr, int wc, int fr, int fq) const {
        const int row0 = u.pm * BM + wr * 64 + fr, col0 = u.pn * HALF + wc * 32 + 8 * fq;
#pragma unroll
        for (int ai = 0; ai < 2; ++ai)
#pragma unroll
            for (int m = 0; m < 4; ++m) {
                float o[8];
#pragma unroll
                for (int n = 0; n < 2; ++n)
#pragma unroll
                    for (int j = 0; j < 4; ++j) { const float gt = acc[ai][0][m][n][j], up = acc[ai][1][m][n][j]; o[4 * n + j] = gt * up * __builtin_amdgcn_rcpf(1.f + __expf(-gt)); }
                u32x4 w; w.x = pkh(o[0], o[1]); w.y = pkh(o[2], o[3]); w.z = pkh(o[4], o[5]); w.w = pkh(o[6], o[7]);
                *(u32x4*)(Hd + (size_t)(row0 + ai * HALF + m * 16) * FF + col0) = w; }
    }
};
__device__ __forceinline__ float gelu_tanh(float x) { const float u = 0.7978845608028654f * (x + 0.044715f * x * x * x); const float e = __expf(2.f * u); return 0.5f * x * (2.f - 2.f * __builtin_amdgcn_rcpf(e + 1.f)); }
struct EpiCmp1 {
    f16* Hd; const float* bias;
    __device__ __forceinline__ void operator()(const Acc& acc, const Unit& u, int wr, int wc, int fr, int fq) const {
        const int row0 = u.pm * BM + wr * 64 + fr, col0 = wc * 32 + 8 * fq;
        f32x4 bv[2][2];
#pragma unroll
        for (int bj = 0; bj < 2; ++bj)
#pragma unroll
            for (int n = 0; n < 2; ++n) { f32x4 a = *(const f32x4*)(bias + col0 + bj * HALF + 4 * n);
#pragma unroll
                for (int p = 1; p < 8; ++p) a = a + *(const f32x4*)(bias + p * 512 + col0 + bj * HALF + 4 * n);
                bv[bj][n] = a; }
#pragma unroll
        for (int ai = 0; ai < 2; ++ai)
#pragma unroll
            for (int m = 0; m < 4; ++m) {
#pragma unroll
                for (int bj = 0; bj < 2; ++bj) {
                    float o[8];
#pragma unroll
                    for (int n = 0; n < 2; ++n)
#pragma unroll
                        for (int j = 0; j < 4; ++j) o[4 * n + j] = gelu_tanh(acc[ai][bj][m][n][j] + bv[bj][n][j]);
                    u32x4 w; w.x = pkh(o[0], o[1]); w.y = pkh(o[2], o[3]); w.z = pkh(o[4], o[5]); w.w = pkh(o[6], o[7]);
                    *(u32x4*)(Hd + (size_t)(row0 + ai * HALF + m * 16) * 256 + col0 + bj * HALF) = w; }
                __builtin_amdgcn_sched_barrier(0); }
    }
};
struct EpiCmp2 {
    f16* Out;
    __device__ __forceinline__ void operator()(const Acc& acc, const Unit& u, int wr, int wc, int fr, int fq) const {
        if (wc >= 2) return;
        const int row0 = u.pm * BM + wr * 64 + fr, col0 = wc * 32 + 8 * fq;
#pragma unroll
        for (int ai = 0; ai < 2; ++ai)
#pragma unroll
            for (int m = 0; m < 4; ++m) {
                u32x4 w; w.x = pkh(acc[ai][0][m][0][0], acc[ai][0][m][0][1]); w.y = pkh(acc[ai][0][m][0][2], acc[ai][0][m][0][3]);
                w.z = pkh(acc[ai][0][m][1][0], acc[ai][0][m][1][1]); w.w = pkh(acc[ai][0][m][1][2], acc[ai][0][m][1][3]);
                *(u32x4*)(Out + (size_t)(row0 + ai * HALF + m * 16) * 64 + col0) = w; }
    }
};
struct EpiInProj {
    f16* proj; const float* cosT; const float* sinT; float* logf; float* gates; const float* b_f; int layer;
    __device__ __forceinline__ void operator()(const Acc& acc, const Unit& u, int wr, int wc, int fr, int fq) const {
        const int hs = u.pn * 4 + wc;
        int kind, dst;
        if (layer == 0) {
            if (hs < 8) { kind = 2; dst = hs; } else if (hs < 24) { kind = 0; dst = hs; } else if (hs < 32) { kind = 3; dst = hs; }
            else if (hs < 38) { kind = 1; dst = hs; } else if (hs == 38) { kind = 4; dst = 0; } else if (hs == 39) { kind = 5; dst = 0; }
            else if (hs < 46) { kind = 0; dst = hs - 2; } else { kind = 5; dst = 0; }
        } else { dst = hs; kind = hs < 16 ? 3 : (hs < 32 ? 1 : 0); }
        if (kind == 5) return;
        const int row0 = u.pm * BM + wr * 64 + fr;
        if (kind == 4) {
            const float bf0 = b_f[(8 * fq) & 7], bf1 = b_f[(8 * fq + 1) & 7], bf2 = b_f[(8 * fq + 2) & 7], bf3 = b_f[(8 * fq + 3) & 7], bf4 = b_f[(8 * fq + 4) & 7], bf5 = b_f[(8 * fq + 5) & 7], bf6 = b_f[(8 * fq + 6) & 7], bf7 = b_f[(8 * fq + 7) & 7];
            const float bfv[8] = {bf0, bf1, bf2, bf3, bf4, bf5, bf6, bf7};
#pragma unroll
            for (int ai = 0; ai < 2; ++ai)
#pragma unroll
                for (int m = 0; m < 4; ++m) { const int row = row0 + ai * HALF + m * 16; const int b = row / SEQ, s = row % SEQ;
#pragma unroll
                    for (int n = 0; n < 2; ++n)
#pragma unroll
                        for (int j = 0; j < 4; ++j) { const int d = 8 * fq + 4 * n + j; const float v = acc[ai][0][m][n][j];
                            if (fq == 0) { const float x = v + bfv[4 * n + j]; const float e = __expf(-fabsf(x));
                                const float l1p = e < 0.03f ? e * (1.f - e * (0.5f - e * (0.33333333f - 0.25f * e))) : __logf(1.f + e);
                                logf[((size_t)b * 8 + d) * SEQ + s] = fminf(x, 0.f) - l1p; }
                            else gates[(size_t)row * 24 + (d - 8)] = 1.f / (1.f + __expf(-v)); }
                    __builtin_amdgcn_sched_barrier(0); }
            return;
        }
        const float sc = (kind >= 2) ? QSCALE : 1.f; const bool rope = (kind == 1 || kind == 3);
        f16* base = proj + (size_t)dst * (NB * SEQ * HD);
#pragma unroll
        for (int ai = 0; ai < 2; ++ai)
#pragma unroll
            for (int m = 0; m < 4; ++m) { const int row = row0 + ai * HALF + m * 16; const int s = row % SEQ;
                f32x4 x1[2] = {acc[ai][0][m][0], acc[ai][0][m][1]}, x2[2] = {acc[ai][1][m][0], acc[ai][1][m][1]};
                if (rope) {
#pragma unroll
                    for (int n = 0; n < 2; ++n) { const f32x4 c = *(const f32x4*)(cosT + (size_t)s * 32 + 8 * fq + 4 * n), sn = *(const f32x4*)(sinT + (size_t)s * 32 + 8 * fq + 4 * n);
                        const f32x4 a = x1[n], bb = x2[n]; x1[n] = a * c - bb * sn; x2[n] = bb * c + a * sn; }
                }
                u32x4 w1, w2;
                w1.x = pkh(x1[0][0] * sc, x1[0][1] * sc); w1.y = pkh(x1[0][2] * sc, x1[0][3] * sc); w1.z = pkh(x1[1][0] * sc, x1[1][1] * sc); w1.w = pkh(x1[1][2] * sc, x1[1][3] * sc);
                w2.x = pkh(x2[0][0] * sc, x2[0][1] * sc); w2.y = pkh(x2[0][2] * sc, x2[0][3] * sc); w2.z = pkh(x2[1][0] * sc, x2[1][1] * sc); w2.w = pkh(x2[1][2] * sc, x2[1][3] * sc);
                f16* rp = base + (size_t)row * HD + 8 * fq;
                *(u32x4*)rp = w1; *(u32x4*)(rp + 32) = w2;
                __builtin_amdgcn_sched_barrier(0); }
    }
};
}

__device__ __forceinline__ int crow(int r, int hi) { return (r & 3) + 8 * (r >> 2) + 4 * hi; }
__device__ __forceinline__ float swapmax(float m) { auto rr = __builtin_amdgcn_permlane32_swap(__float_as_uint(m), __float_as_uint(m), false, false); return fmaxf(__uint_as_float(rr[0]), __uint_as_float(rr[1])); }
__device__ __forceinline__ float swapsum(float m) { auto rr = __builtin_amdgcn_permlane32_swap(__float_as_uint(m), __float_as_uint(m), false, false); return __uint_as_float(rr[0]) + __uint_as_float(rr[1]); }
struct KVStage { u32x4 k, v; };
__device__ __forceinline__ void kv_issue(KVStage& st, const char* kt, const char* vt, int wid, int lane) {
    st.k = *(const u32x4*)(kt + lane * 128 + wid * 16);
    st.v = *(const u32x4*)(vt + (16 * (wid & 3) + (lane >> 2)) * 128 + (wid >> 2) * 64 + (lane & 3) * 16);
}
__device__ __forceinline__ void kv_write(const KVStage& st, LAS unsigned char* buf, int wid, int lane) {
    *(LAS u32x4*)(buf + wid * 1024 + lane * 16) = st.k;
    *(LAS u32x4*)(buf + 8192 + wid * 1024 + lane * 16) = st.v;
}
__device__ __forceinline__ void qk_tile(f32x16& p0, f32x16& p1, const LAS unsigned char* kb, const h8 (&qr)[4], int r32, int hi) {
    const LAS unsigned char* kp = kb + hi * 1024 + r32 * 16;
#pragma unroll
    for (int r = 0; r < 16; ++r) { p0[r] = 0.f; p1[r] = 0.f; }
#pragma unroll
    for (int d0 = 0; d0 < 4; ++d0) {
        const h8 b0 = *(const LAS h8*)(kp + d0 * 2048), b1 = *(const LAS h8*)(kp + d0 * 2048 + 512);
        p0 = MFMA32(b0, qr[d0], p0); p1 = MFMA32(b1, qr[d0], p1);
    }
}
typedef short v4i16_t __attribute__((ext_vector_type(4)));
typedef short s16x8 __attribute__((ext_vector_type(8)));
__device__ __forceinline__ s16x4 vtr(const LAS unsigned char* p) { return __builtin_bit_cast(s16x4, __builtin_amdgcn_ds_read_tr16_b64_v4i16((LAS v4i16_t*)p)); }
__device__ __forceinline__ void pv_tile(f32x16 (&o)[2], const LAS unsigned char* vb, const u32x4 (&pw)[4], int lane, int hi) {
    const LAS unsigned char* vp = vb + ((lane >> 4) & 1) * 32 + (lane & 3) * 8 + (4 * hi + ((lane & 15) >> 2)) * 64;
#pragma unroll
    for (int d0 = 0; d0 < 2; ++d0)
#pragma unroll
        for (int ks = 0; ks < 4; ++ks) {
            const s16x4 lo = vtr(vp + d0 * 4096 + ks * 1024), hh = vtr(vp + d0 * 4096 + ks * 1024 + 512);
            const s16x8 vv = {lo[0], lo[1], lo[2], lo[3], hh[0], hh[1], hh[2], hh[3]};
            o[d0] = MFMA32(__builtin_bit_cast(h8, pw[ks]), __builtin_bit_cast(h8, vv), o[d0]);
        }
}
__device__ __forceinline__ void pack_p(u32x4 (&pw)[4], const f32x16& p0, const f32x16& p1) {
    pw[0] = (u32x4){pkh(p0[0], p0[1]), pkh(p0[2], p0[3]), pkh(p0[4], p0[5]), pkh(p0[6], p0[7])};
    pw[1] = (u32x4){pkh(p0[8], p0[9]), pkh(p0[10], p0[11]), pkh(p0[12], p0[13]), pkh(p0[14], p0[15])};
    pw[2] = (u32x4){pkh(p1[0], p1[1]), pkh(p1[2], p1[3]), pkh(p1[4], p1[5]), pkh(p1[6], p1[7])};
    pw[3] = (u32x4){pkh(p1[8], p1[9]), pkh(p1[10], p1[11]), pkh(p1[12], p1[13]), pkh(p1[14], p1[15])};
}
__device__ __forceinline__ float rowmax32(const f32x16& p0, const f32x16& p1) {
    float a = fmaxf(p0[0], p1[0]);
#pragma unroll
    for (int r = 1; r < 16; ++r) a = fmaxf(a, fmaxf(p0[r], p1[r]));
    return swapmax(a);
}
__device__ __forceinline__ void softmax_step(f32x16& p0, f32x16& p1, float& m, float& l, f32x16 (&o)[2], LAS float* wsf, int r32, int hi) {
    const float rm = rowmax32(p0, p1);
    const float mn = fmaxf(m, rm);
    const float alpha = fexp2(m - mn);
    m = mn;
    float s = 0.f;
#pragma unroll
    for (int r = 0; r < 16; ++r) { p0[r] = fexp2(p0[r] - mn); p1[r] = fexp2(p1[r] - mn); s += p0[r] + p1[r]; }
    l = l * alpha + s;
    if (__any(alpha != 1.f)) {
        if (hi == 0) wsf[r32] = alpha;
        LDS_WAIT();
#pragma unroll
        for (int r = 0; r < 16; ++r) { const float a = wsf[crow(r, hi)]; o[0][r] *= a; o[1][r] *= a; }
        LDS_WAIT();
    }
}
__device__ __forceinline__ void stage_o(const f32x16 (&o)[2], float rinv_lane, LAS float* wsf, LAS f16* stg, int r32, int hi) {
    if (hi == 0) wsf[32 + r32] = rinv_lane;
    LDS_WAIT();
#pragma unroll
    for (int r = 0; r < 16; ++r) { const int orow = crow(r, hi); const float rl = wsf[32 + orow];
        stg[orow * 64 + r32] = (f16)(o[0][r] * rl); stg[orow * 64 + 32 + r32] = (f16)(o[1][r] * rl); }
    LDS_WAIT();
}

template <class F> __device__ __forceinline__ void attn_unit(F& f, LAS unsigned char* lds) {
    const int tid = opaque_tid(), lane = tid & 63, r32 = lane & 31, hi = lane >> 5; const int wid = __builtin_amdgcn_readfirstlane(tid >> 6);
    LAS unsigned char* kv = lds + L_KV; LAS float* wsf = (LAS float*)(lds + L_WSF) + wid * 64; LAS f16* stg = (LAS f16*)(lds + L_OST) + wid * 2048;
    LAS float* csl = (LAS float*)(lds + L_CS);
    f.init(wid, r32, hi);
    const f16* qp = f.qrow();
    h8 qr[4];
#pragma unroll
    for (int d0 = 0; d0 < 4; ++d0) qr[d0] = *(const h8*)(qp + 16 * d0 + 8 * hi);
    float m = NEG_BIG, l = 0.f; f32x16 o[2];
#pragma unroll
    for (int r = 0; r < 16; ++r) { o[0][r] = 0.f; o[1][r] = 0.f; }
    const int t0 = f.t_begin(), t1 = f.t_end();
    KVStage st; float csv = 0.f;
    __syncthreads();
    f.unit_prep(lds, tid);
    kv_issue(st, f.ktile(t0), f.vtile(t0), wid, lane);
    if constexpr (F::HAS_CS) { if (wid == 0) csv = f.cs_src(t0)[lane]; }
    kv_write(st, kv, wid, lane);
    if constexpr (F::HAS_CS) { if (wid == 0) csl[lane] = csv; }
    __syncthreads();
    for (int t = t0; t < t1; ++t) {
        const int cur = (t - t0) & 1;
        const bool more = (t + 1 < t1);
        if (more) { kv_issue(st, f.ktile(t + 1), f.vtile(t + 1), wid, lane); if constexpr (F::HAS_CS) { if (wid == 0) csv = f.cs_src(t + 1)[lane]; } }
        if (f.active(t)) {
            f32x16 p0, p1;
            qk_tile(p0, p1, kv + cur * 16384, qr, r32, hi);
            f.mask(p0, p1, t, csl + cur * 64, hi);
            softmax_step(p0, p1, m, l, o, wsf, r32, hi);
            u32x4 pw[4]; pack_p(pw, p0, p1);
            pv_tile(o, kv + cur * 16384 + 8192, pw, lane, hi);
        }
        if (more) { kv_write(st, kv + (cur ^ 1) * 16384, wid, lane); if constexpr (F::HAS_CS) { if (wid == 0) csl[(cur ^ 1) * 64 + lane] = csv; } }
        __syncthreads();
    }
    const float lt = swapsum(l);
    stage_o(o, lt > 0.f ? 1.f / lt : 0.f, wsf, stg, r32, hi);
    if (hi == 0) { wsf[r32] = m; wsf[32 + r32] = lt; }
    LDS_WAIT();
    f.store(stg, lane, wsf);
}

namespace fa {
constexpr int NW = 8, QBLK = 32, QB = 256, KVBLK = 64, NSLOT = 3, SLOTB = 8192;
constexpr int LDS_K = 0, LDS_V = NSLOT * SLOTB, LDS_WS = 2 * NSLOT * SLOTB, LDS_OST = LDS_WS + NW * 64 * 4, LDS_CS = LDS_OST + NW * 4096, LDS_END = LDS_CS + NW * 1024;
#define SBAR() __builtin_amdgcn_sched_barrier(0)
__device__ __forceinline__ void cmask(f32x16& p0, f32x16& p1, int jb, int qrel, int hi) {
    const float NEG = -INFINITY; int kb = 64 * jb + 4 * hi;
#pragma unroll
    for (int r = 0; r < 16; ++r) { int kvp = kb + (r & 3) + 8 * (r >> 2); if (kvp > qrel) p0[r] = NEG; if (kvp + 32 > qrel) p1[r] = NEG; }
}
__device__ __forceinline__ void glds16(const void* gsrc, unsigned lds_dst) { unsigned keep;
    asm volatile("s_mov_b32 %0, m0\n\ts_mov_b32 m0, %2\n\ts_nop 0\n\tglobal_load_lds_dwordx4 %1, off\n\ts_mov_b32 m0, %0" : "=&s"(keep) : "v"(gsrc), "s"(lds_dst) : "memory"); }
__device__ __forceinline__ void glds4(const void* gsrc, unsigned lds_dst) { unsigned keep;
    asm volatile("s_mov_b32 %0, m0\n\ts_mov_b32 m0, %2\n\ts_nop 0\n\tglobal_load_lds_dword %1, off\n\ts_mov_b32 m0, %0" : "=&s"(keep) : "v"(gsrc), "s"(lds_dst) : "memory"); }
__device__ __forceinline__ float max3f(float a, float b, float c) { float r; asm("v_max3_f32 %0, %1, %2, %3" : "=v"(r) : "v"(a), "v"(b), "v"(c)); return r; }
__device__ __forceinline__ float max2f(float a, float b) { float r; asm("v_max_f32_e32 %0, %1, %2" : "=v"(r) : "v"(a), "v"(b)); return r; }
__device__ __forceinline__ float fadd_s(float a, float b) { float r; asm("v_add_f32_e32 %0, %1, %2" : "=v"(r) : "v"(a), "v"(b)); return r; }
__device__ __forceinline__ float fsub_s(float a, float b) { float r; asm("v_sub_f32_e32 %0, %1, %2" : "=v"(r) : "v"(a), "v"(b)); return r; }
#define WAIT_BAR(N) asm volatile("s_waitcnt vmcnt(" #N ") lgkmcnt(0)\n\ts_barrier" ::: "memory")
typedef LAS const char* lds_cptr;
__device__ __forceinline__ void qkt(f32x16& p0, f32x16& p1, const char* Kslot, const h8* qr, const f32x16& negm, int r32, int hi) {
    const char* kb = Kslot + hi * 1024 + r32 * 16;
#pragma unroll
    for (int d0 = 0; d0 < 4; ++d0) {
        const h8 b0 = *reinterpret_cast<const h8*>(kb + d0 * 2048);
        const h8 b1 = *reinterpret_cast<const h8*>(kb + d0 * 2048 + 512);
        if (d0 == 0) { p0 = MFMA32(b0, qr[0], negm); p1 = MFMA32(b1, qr[0], negm); }
        else { p0 = MFMA32(b0, qr[d0], p0); p1 = MFMA32(b1, qr[d0], p1); } }
}
__device__ __forceinline__ void kload8(h8* kf, lds_cptr kp) {
    kf[0] = *(const LAS h8*)(kp);        kf[1] = *(const LAS h8*)(kp + 512);
    kf[2] = *(const LAS h8*)(kp + 2048); kf[3] = *(const LAS h8*)(kp + 2560);
    kf[4] = *(const LAS h8*)(kp + 4096); kf[5] = *(const LAS h8*)(kp + 4608);
    kf[6] = *(const LAS h8*)(kp + 6144); kf[7] = *(const LAS h8*)(kp + 6656);
}
__device__ __forceinline__ void kload2(h8* kf, lds_cptr kp, int j) { kf[2 * j] = *(const LAS h8*)(kp + j * 2048); kf[2 * j + 1] = *(const LAS h8*)(kp + j * 2048 + 512); }
__device__ __forceinline__ s16x4 vtr2(lds_cptr p) { return __builtin_bit_cast(s16x4, __builtin_amdgcn_ds_read_tr16_b64_v4i16((LAS v4i16_t*)p)); }
__device__ __forceinline__ float rowmax(const f32x16& p0, const f32x16& p1) {
    float a = max3f(p0[0], p0[1], p1[0]), b = max3f(p0[2], p0[3], p1[1]); a = max3f(a, p1[2], p1[3]);
#pragma unroll
    for (int r = 4; r < 16; r += 4) { a = max3f(a, p0[r], p0[r + 1]); b = max3f(b, p0[r + 2], p0[r + 3]); a = max3f(a, p1[r], p1[r + 1]); b = max3f(b, p1[r + 2], p1[r + 3]); }
    const float m = max2f(a, b);
    auto rr = __builtin_amdgcn_permlane32_swap(__float_as_uint(m), __float_as_uint(m), false, false);
    return max2f(__uint_as_float(rr[0]), __uint_as_float(rr[1]));
}
__device__ __forceinline__ h8 mk8(s16x4 lo, s16x4 hi) { const s16x8 v = {lo[0], lo[1], lo[2], lo[3], hi[0], hi[1], hi[2], hi[3]}; return __builtin_bit_cast(h8, v); }
__device__ __forceinline__ void pv(f32x16* o, int vb, h8 pa0, h8 pa1, h8 pa2, h8 pa3) {
#pragma unroll
    for (int d0 = 0; d0 < 2; ++d0) { s16x4 lo[4], hi[4];
#pragma unroll
        for (int ks = 0; ks < 4; ++ks) {
            asm volatile("ds_read_b64_tr_b16 %0,%1 offset:%c2" : "=&v"(lo[ks]) : "v"(vb), "i"(d0 * 4096 + ks * 1024) : "memory");
            asm volatile("ds_read_b64_tr_b16 %0,%1 offset:%c2" : "=&v"(hi[ks]) : "v"(vb), "i"(d0 * 4096 + ks * 1024 + 512) : "memory"); }
        asm volatile("s_waitcnt lgkmcnt(0)" ::: "memory"); SBAR();
        o[d0] = MFMA32(pa0, mk8(lo[0], hi[0]), o[d0]);
        o[d0] = MFMA32(pa1, mk8(lo[1], hi[1]), o[d0]);
        o[d0] = MFMA32(pa2, mk8(lo[2], hi[2]), o[d0]);
        o[d0] = MFMA32(pa3, mk8(lo[3], hi[3]), o[d0]);
    }
}
__device__ __forceinline__ void stage_rows(const f32x16 (&o)[2], float rinv, char* shm, int wid, int le) {
    const int r32e = le & 31, hie = le >> 5;
    float* wse = (float*)(shm + LDS_WS) + wid * 64;
    if (hie == 0) wse[32 + r32e] = rinv; asm volatile("s_waitcnt lgkmcnt(0)" ::: "memory");
    f16* stg = (f16*)(shm + LDS_OST) + wid * 2048;
#pragma unroll
    for (int r = 0; r < 16; ++r) { const int orow = crow(r, hie); const float rl = wse[32 + orow];
#pragma unroll
        for (int d0 = 0; d0 < 2; ++d0) stg[orow * 64 + d0 * 32 + r32e] = (f16)(o[d0][r] * rl); }
    asm volatile("s_waitcnt lgkmcnt(0)" ::: "memory");
}
struct EpiPlain { f16* Ow; int opitch;
    __device__ __forceinline__ void after_q() const {}
    __device__ __forceinline__ void operator()(const f32x16 (&o)[2], float, float l, char* shm, int wid) const {
        const int le = opaque_tid() & 63;
        stage_rows(o, l > 0.f ? __builtin_amdgcn_rcpf(l) : 0.f, shm, wid, le);
        const f16* stg = (const f16*)(shm + LDS_OST) + wid * 2048;
#pragma unroll
        for (int i = 0; i < 4; ++i) { const int row = i * 8 + (le >> 3), ch = le & 7; const u32x4 v = *(const u32x4*)(stg + row * 64 + ch * 8); *(u32x4*)(Ow + (long)row * opitch + ch * 8) = v; }
    } };
struct EpiPartial { f16* PO; float* PML; int dst; const f16* qs; int code_next; unsigned qst;
    __device__ __forceinline__ void after_q() const {
        asm volatile("s_waitcnt vmcnt(0) lgkmcnt(0)" ::: "memory");
        const int le = opaque_tid() & 63;
#pragma unroll
        for (int i = 0; i < 4; ++i) { const int cn = __shfl(code_next, 8 * i + (le >> 3), 64);
            glds16(qs + (size_t)((cn < 0 ? 0 : cn) & 16383) * HD + (le & 7) * 8, (unsigned)__builtin_amdgcn_readfirstlane(qst + i * 1024)); }
    }
    __device__ __forceinline__ void operator()(const f32x16 (&o)[2], float mhat, float l, char* shm, int wid) const {
        const int le = opaque_tid() & 63, r32e = le & 31, hie = le >> 5;
        int* tab = (int*)(shm + LDS_CS) + wid * 256;
        if (hie == 0) { tab[r32e] = dst; if (dst >= 0) { f32x2 ml = {mhat, l}; *(f32x2*)(PML + 2 * (size_t)dst) = ml; } }
        stage_rows(o, __builtin_amdgcn_rcpf(l), shm, wid, le);
        const f16* stg = (const f16*)(shm + LDS_OST) + wid * 2048;
#pragma unroll
        for (int i = 0; i < 4; ++i) { const int row = i * 8 + (le >> 3), ch = le & 7; const int d = tab[row];
            if (d >= 0) { const u32x4 v = *(const u32x4*)(stg + row * 64 + ch * 8); *(u32x4*)(PO + (size_t)d * 64 + ch * 8) = v; } }
    } };
struct EpiMerge { const f16* PO; const float* PML; size_t prow0; int nv; f16* Ow; int opitch;
    __device__ __forceinline__ void after_q() const {}
    __device__ __forceinline__ void operator()(const f32x16 (&o)[2], float mhat, float l, char* shm, int wid) const {
        const int le = opaque_tid() & 63, r32e = le & 31, hie = le >> 5;
        float* tab = (float*)(shm + LDS_CS) + wid * 256;
        if (hie == 0) {
            float ms[3], ls[3]; float M = mhat;
#pragma unroll
            for (int s_ = 0; s_ < 3; ++s_) { ms[s_] = -INFINITY; ls[s_] = 0.f; if (s_ < nv) { const f32x2 ml = *(const f32x2*)(PML + 2 * ((prow0 + r32e) * 3 + s_)); ms[s_] = ml[0]; ls[s_] = ml[1]; M = fmaxf(M, ml[0]); } }
            const float wo = fexp2(mhat - M) * l; float w[3], den = wo;
#pragma unroll
            for (int s_ = 0; s_ < 3; ++s_) { w[s_] = (s_ < nv) ? fexp2(ms[s_] - M) * ls[s_] : 0.f; den += w[s_]; }
            const float rd = 1.f / den;
            tab[r32e * 4] = wo * rd; tab[r32e * 4 + 1] = w[0] * rd; tab[r32e * 4 + 2] = w[1] * rd; tab[r32e * 4 + 3] = w[2] * rd;
        }
        stage_rows(o, __builtin_amdgcn_rcpf(l), shm, wid, le);
        const f16* stg = (const f16*)(shm + LDS_OST) + wid * 2048;
#pragma unroll
        for (int i = 0; i < 4; ++i) { const int row = i * 8 + (le >> 3), ch = le & 7;
            const f32x4 a = *(const f32x4*)(tab + row * 4); const h8 own = *(const h8*)(stg + row * 64 + ch * 8);
            float acc[8];
#pragma unroll
            for (int e = 0; e < 8; ++e) acc[e] = a[0] * (float)own[e];
#pragma unroll
            for (int s_ = 0; s_ < 3; ++s_) if (s_ < nv) { const h8 pv_ = *(const h8*)(PO + ((prow0 + row) * 3 + s_) * 64 + ch * 8); const float as = a[1 + s_];
#pragma unroll
                for (int e = 0; e < 8; ++e) acc[e] += as * (float)pv_[e]; }
            u32x4 v; v.x = pkh(acc[0], acc[1]); v.y = pkh(acc[2], acc[3]); v.z = pkh(acc[4], acc[5]); v.w = pkh(acc[6], acc[7]);
            *(u32x4*)(Ow + (long)row * opitch + ch * 8) = v; }
    } };
struct EpiWinGate { const float* gates; f16* O; int b, hd, q0;
    __device__ __forceinline__ void after_q() const {}
    __device__ __forceinline__ void operator()(const f32x16 (&o)[2], float, float l, char* shm, int wid) const {
        const int le = opaque_tid() & 63;
        stage_rows(o, l > 0.f ? __builtin_amdgcn_rcpf(l) : 0.f, shm, wid, le);
        const f16* stg = (const f16*)(shm + LDS_OST) + wid * 2048;
#pragma unroll
        for (int i = 0; i < 4; ++i) { const int row = i * 8 + (le >> 3), ch = le & 7; const int q = q0 + row;
            const float g2 = gates[((size_t)b * SEQ + q) * 24 + hd * 3 + 2];
            const h8 s_ = *(const h8*)(stg + row * 64 + ch * 8);
            u32x4 o4; o4.x = pkh(g2 * (float)s_[0], g2 * (float)s_[1]); o4.y = pkh(g2 * (float)s_[2], g2 * (float)s_[3]); o4.z = pkh(g2 * (float)s_[4], g2 * (float)s_[5]); o4.w = pkh(g2 * (float)s_[6], g2 * (float)s_[7]);
            *(u32x4*)(O + ((size_t)b * SEQ + q) * DM + 512 + hd * HD + ch * 8) = o4; }
    } };
__device__ __forceinline__ void o_acc8(f16* p, float gt, const h8 v) {
    const h8 c = *(const h8*)p; float r_[8];
#pragma unroll
    for (int e = 0; e < 8; ++e) r_[e] = (float)c[e] + gt * (float)v[e];
    u32x4 o4; o4.x = pkh(r_[0], r_[1]); o4.y = pkh(r_[2], r_[3]); o4.z = pkh(r_[4], r_[5]); o4.w = pkh(r_[6], r_[7]);
    *(u32x4*)p = o4;
}
constexpr int QREL_ROW = -(1 << 30);
constexpr int RES_V = 92160;
template <int THRL, bool BIAS, bool CAUSAL, class Epi, bool QLDS = false, bool RES = false> __device__ __forceinline__ void unit(const f16* qrow, const f16* __restrict__ Kh, const f16* __restrict__ Vh, const float* cq, const float* ck, const int NT, const int qrel_in, const Epi& E, char* shm) {
    const int tid = opaque_tid(), lane = tid & 63, r32 = lane & 31, hi = lane >> 5; const int wid = __builtin_amdgcn_readfirstlane(tid >> 6);
    const unsigned lds0 = (unsigned)(uintptr_t)shm;
    float* wsf = (float*)(shm + LDS_WS) + wid * 64;
    if (QLDS) ((int*)wsf)[32 + r32] = qrel_in;
    const f16* ksrc = Kh + (long)lane * 64 + wid * 8;
    const f16* vsrc = Vh + (long)(16 * (wid & 3) + (lane >> 2)) * 64 + (wid >> 2) * 32 + (lane & 3) * 8;
    const float* cssrc = ck + lane;
    const unsigned kdst = lds0 + LDS_K + wid * 1024, vdst = lds0 + LDS_V + wid * 1024, csdst = lds0 + LDS_CS + wid * 1024;
#define DMA_K(t, slot) do { if (!RES) { glds16(ksrc + (long)(t) * 4096, (unsigned)__builtin_amdgcn_readfirstlane(kdst + (slot))); \
        if (BIAS) glds4(cssrc + 64 * (t), (unsigned)__builtin_amdgcn_readfirstlane(csdst + (((t) & 3) << 8))); } } while (0)
#define DMA_V(t, slot) do { if (!RES) glds16(vsrc + (long)(t) * 4096, (unsigned)__builtin_amdgcn_readfirstlane(vdst + (slot))); } while (0)
    constexpr int VBASE = RES ? RES_V : LDS_V;
    const int vb0 = (int)(lds0 + VBASE) + ((lane >> 4) & 1) * 32 + (lane & 3) * 8 + (4 * hi + ((lane & 15) >> 2)) * 64;
    const char* Kbase = shm + LDS_K; h8 kf[8];
    const lds_cptr shm3 = (lds_cptr)shm; const lds_cptr kp0 = shm3 + LDS_K + hi * 1024 + r32 * 16; const lds_cptr vp0 = shm3 + VBASE + ((lane >> 4) & 1) * 32 + (lane & 3) * 8 + (4 * hi + ((lane & 15) >> 2)) * 64;
    const lds_cptr csp0 = shm3 + LDS_CS + wid * 1024 + hi * 16;
    DMA_K(0, 0); DMA_V(0, 0); DMA_K(1, SLOTB);
    h8 qr[4];
#pragma unroll
    for (int d0 = 0; d0 < 4; ++d0) qr[d0] = *reinterpret_cast<const h8*>(qrow + d0 * 16 + hi * 8);
    E.after_q();
    float ctv = 0.f; if (BIAS) ctv = *cq;
    float l_reg = 0.f; f32x16 o[2];
#pragma unroll
    for (int r = 0; r < 16; ++r) { o[0][r] = 0.f; o[1][r] = 0.f; }
    f32x16 negm;
#pragma unroll
    for (int r = 0; r < 16; ++r) negm[r] = ctv;
    asm volatile("" : "+v"(negm));
#define CMASK(P0, P1, t) do { if (CAUSAL) { int jb_ = (t) - (NT - 4); if (jb_ >= 0) { const int lq_ = opaque_tid() & 31; const int qrel = QLDS ? ((const int*)(shm + LDS_WS))[wid * 64 + 32 + lq_] : wid * QBLK + lq_; cmask(P0, P1, jb_, qrel, hi); } } } while (0)
#define CSUB(P0, P1, t) do { if (BIAS) { const lds_cptr cp_ = csp0 + (((t) & 3) << 8); \
        _Pragma("unroll") for (int g_ = 0; g_ < 4; ++g_) { const f32x4 c0_ = *(const LAS f32x4*)(cp_ + g_ * 32), c1_ = *(const LAS f32x4*)(cp_ + 128 + g_ * 32); \
            _Pragma("unroll") for (int j_ = 0; j_ < 4; ++j_) { P0[4 * g_ + j_] -= c0_[j_]; P1[4 * g_ + j_] -= c1_[j_]; } } } } while (0)
    bool resc = false;
#define START(P0, P1) do { const float rm = rowmax(P0, P1); resc = false; \
    { const float dl = (rm > -INFINITY) ? rm : 0.f;        \
      _Pragma("unroll") for (int r = 0; r < 16; ++r) { P0[r] = fsub_s(P0[r], dl); P1[r] = fsub_s(P1[r], dl); } \
      const float nm_ = ctv - dl; _Pragma("unroll") for (int r = 0; r < 16; ++r) negm[r] = nm_; asm volatile("" : "+v"(negm)); } \
    _Pragma("unroll") for (int r = 0; r < 16; ++r) P0[r] = __builtin_amdgcn_exp2f(P0[r]); } while (0)
#define RESC() do { if (resc) { asm volatile("s_waitcnt lgkmcnt(0)" ::: "memory"); \
      _Pragma("unroll") for (int d_ = 0; d_ < 2; ++d_) _Pragma("unroll") for (int r = 0; r < 16; ++r) o[d_][r] *= wsf[crow(r, hi)]; } } while (0)
    f32x16 pA0, pA1, pB0, pB1;
    int sl_prev = 0, sl_cur = 0, sl_next = SLOTB;
#define ROT() do { sl_prev = sl_cur; sl_cur = sl_next; sl_next = (!RES && sl_next == (NSLOT - 1) * SLOTB) ? 0 : sl_next + SLOTB; } while (0)
#define WBR(N) do { if (RES) { asm volatile("" ::: "memory"); } else { WAIT_BAR(N); } } while (0)
#define WB2() do { if (BIAS) { WBR(3); } else { WBR(2); } } while (0)
    DMA_K(2, 2 * SLOTB);
    WBR(3);
    qkt(pA0, pA1, Kbase, qr, negm, r32, hi); asm volatile("s_nop 15\n\ts_nop 7" : "+v"(pA0), "+v"(pA1)); CSUB(pA0, pA1, 0); CMASK(pA0, pA1, 0);
    START(pA0, pA1);
    _Pragma("unroll") for (int r = 0; r < 16; ++r) pA1[r] = __builtin_amdgcn_exp2f(pA1[r]);
    WBR(0);
    DMA_K(3, 0); DMA_V(1, SLOTB);
    ROT();
    kload8(kf, kp0 + sl_cur);
    WB2();
    s16x4 vlo[8], vhi[8]; u32x4 pw0, pw1, pw2, pw3;
#define PKW(P, B) pkh(P[B], P[B + 1])
#define PAF(k) __builtin_bit_cast(h8, pw##k)
#define VFR(i) mk8(vlo[i], vhi[i])
#define PIN(x) asm volatile("" : "+v"(x))
#define MX3(a, b, c) __builtin_fmaxf(__builtin_fmaxf((a), (b)), (c))
#define GAPA(MF, A0, A1, A2, A3, W0, W1, PW) do { MF; sacc += A0; sacc += A1; sacc += A2; sacc += A3; PIN(sacc); W0; W1; PIN(PW); SBAR(); } while (0)
#define EX(v) __builtin_amdgcn_exp2f(v)
#define GAPB(MF, X, B) do { MF; X[B] = EX(X[B]); X[B + 1] = EX(X[B + 1]); X[B + 2] = EX(X[B + 2]); X[B + 3] = EX(X[B + 3]); PIN(X); SBAR(); } while (0)
#define VRD(i) do { vlo[i] = vtr2(vp_ + (((i) >> 2) * 4096 + ((i) & 3) * 1024)); vhi[i] = vtr2(vp_ + (((i) >> 2) * 4096 + ((i) & 3) * 1024 + 512)); } while (0)
#define KRD(G, j) do { if (G) { kload2(kf, kp0 + sl_next, j); SBAR(); } } while (0)
#define STEP(C0, C1, P0, P1, t, GK, GV, GL) do { SBAR(); \
    const lds_cptr vp_ = vp0 + sl_prev; \
    VRD(0); SBAR(); float sacc = (P0[0] + P0[1]); \
    GAPA(C0 = MFMA32(kf[0], qr[0], negm), P0[2], P0[3], P0[4], P0[5],     pw0[0] = PKW(P0, 0), pw0[1] = PKW(P0, 2), pw0); \
    VRD(4); SBAR(); GAPA(C1 = MFMA32(kf[1], qr[0], negm), P0[6], P0[7], P0[8], P0[9],     pw0[2] = PKW(P0, 4), pw0[3] = PKW(P0, 6), pw0); \
    VRD(1); SBAR(); GAPA(C0 = MFMA32(kf[2], qr[1], C0),   P0[10], P0[11], P0[12], P0[13], pw1[0] = PKW(P0, 8), pw1[1] = PKW(P0, 10), pw1); \
    VRD(5); SBAR(); GAPA(C1 = MFMA32(kf[3], qr[1], C1),   P0[14], P0[15], P1[0], P1[1],   pw1[2] = PKW(P0, 12), pw1[3] = PKW(P0, 14), pw1); \
    VRD(2); SBAR(); GAPA(C0 = MFMA32(kf[4], qr[2], C0),   P1[2], P1[3], P1[4], P1[5],     pw2[0] = PKW(P1, 0), pw2[1] = PKW(P1, 2), pw2); \
    VRD(6); SBAR(); GAPA(C1 = MFMA32(kf[5], qr[2], C1),   P1[6], P1[7], P1[8], P1[9],     pw2[2] = PKW(P1, 4), pw2[3] = PKW(P1, 6), pw2); \
    VRD(3); SBAR(); GAPA(C0 = MFMA32(kf[6], qr[3], C0),   P1[10], P1[11], P1[12], P1[13], pw3[0] = PKW(P1, 8), pw3[1] = PKW(P1, 10), pw3); \
    VRD(7); SBAR(); GAPA(C1 = MFMA32(kf[7], qr[3], C1),   P1[14], P1[15], 0.f, 0.f,       pw3[2] = PKW(P1, 12), pw3[3] = PKW(P1, 14), pw3); \
    l_reg += sacc; \
    if (GK) { DMA_K((t) + 3, sl_cur); } if (GV) { DMA_V((t) + 1, sl_next); } \
    CSUB(C0, C1, t); \
    CMASK(C0, C1, t); \
    { float a = MX3(C0[0], C0[1], C1[0]), b = MX3(C0[2], C0[3], C1[1]); a = MX3(a, C1[2], C1[3]); \
      _Pragma("unroll") for (int r = 4; r < 16; r += 4) { a = MX3(a, C0[r], C0[r + 1]); b = MX3(b, C0[r + 2], C0[r + 3]); a = MX3(a, C1[r], C1[r + 1]); b = MX3(b, C1[r + 2], C1[r + 3]); } \
      float rm = __builtin_fmaxf(a, b); { auto rr = __builtin_amdgcn_permlane32_swap(__float_as_uint(rm), __float_as_uint(rm), false, false); rm = __builtin_fmaxf(__uint_as_float(rr[0]), __uint_as_float(rr[1])); } \
      resc = false; \
      if (__builtin_expect(__any(rm > (float)THRL), 0)) { const float dl = __builtin_fmaxf(rm, 0.f); \
        _Pragma("unroll") for (int r = 0; r < 16; ++r) { C0[r] -= dl; C1[r] -= dl; } \
        { const float nm_ = negm[0] - dl; _Pragma("unroll") for (int r = 0; r < 16; ++r) negm[r] = nm_; } asm volatile("" : "+v"(negm)); \
        const float f = __builtin_amdgcn_exp2f(-dl); l_reg *= f; { const int lr_ = opaque_tid() & 63; if (lr_ < 32) ((float*)(shm + LDS_WS))[wid * 64 + lr_] = f; } resc = true; } } \
    SBAR(); \
    GAPB(o[0] = MFMA32(PAF(0), VFR(0), o[0]), C0, 0); \
    GAPB(o[1] = MFMA32(PAF(0), VFR(4), o[1]), C0, 4); \
    KRD(GL, 0); GAPB(o[0] = MFMA32(PAF(1), VFR(1), o[0]), C0, 8); \
    KRD(GL, 1); GAPB(o[1] = MFMA32(PAF(1), VFR(5), o[1]), C0, 12); \
    KRD(GL, 2); GAPB(o[0] = MFMA32(PAF(2), VFR(2), o[0]), C1, 0); \
    KRD(GL, 3); GAPB(o[1] = MFMA32(PAF(2), VFR(6), o[1]), C1, 4); \
    GAPB(o[0] = MFMA32(PAF(3), VFR(3), o[0]), C1, 8); \
    GAPB(o[1] = MFMA32(PAF(3), VFR(7), o[1]), C1, 12); \
    } while (0)
    int t = 1;
#undef CMASK
#define CMASK(P0, P1, t) do {} while (0)
    for (; t + 5 < NT; t += 2) {
        STEP(pB0, pB1, pA0, pA1, t, true, true, true);     WB2(); RESC(); ROT();
        STEP(pA0, pA1, pB0, pB1, t + 1, true, true, true); WB2(); RESC(); ROT();
    }
#undef CMASK
#define CMASK(P0, P1, t) do { if (CAUSAL) { int jb_ = (t) - (NT - 4); if (jb_ >= 0) { const int lq_ = opaque_tid() & 31; const int qrel = QLDS ? ((const int*)(shm + LDS_WS))[wid * 64 + 32 + lq_] : wid * QBLK + lq_; cmask(P0, P1, jb_, qrel, hi); } } } while (0)
#define ENDW(tt) do { if ((tt) + 3 < NT) { WB2(); } else if ((tt) + 2 < NT) { WBR(1); } else { WBR(0); } } while (0)
    for (; t + 1 < NT; t += 2) {
        STEP(pB0, pB1, pA0, pA1, t, (t + 3 < NT), (t + 1 < NT), (t + 1 < NT));     ENDW(t);     RESC(); ROT();
        STEP(pA0, pA1, pB0, pB1, t + 1, (t + 4 < NT), (t + 2 < NT), (t + 2 < NT)); ENDW(t + 1); RESC(); ROT();
    }
    STEP(pB0, pB1, pA0, pA1, NT - 1, false, false, false); RESC();
    { float sacc = pB0[0] + pB0[1]; _Pragma("unroll") for (int r = 2; r < 16; ++r) sacc += pB0[r]; _Pragma("unroll") for (int r = 0; r < 16; ++r) sacc += pB1[r]; l_reg += sacc;
      pw0 = (u32x4){PKW(pB0, 0), PKW(pB0, 2), PKW(pB0, 4), PKW(pB0, 6)}; pw1 = (u32x4){PKW(pB0, 8), PKW(pB0, 10), PKW(pB0, 12), PKW(pB0, 14)}; pw2 = (u32x4){PKW(pB1, 0), PKW(pB1, 2), PKW(pB1, 4), PKW(pB1, 6)}; pw3 = (u32x4){PKW(pB1, 8), PKW(pB1, 10), PKW(pB1, 12), PKW(pB1, 14)};
      SBAR(); pv(o, vb0 + sl_cur, PAF(0), PAF(1), PAF(2), PAF(3)); }
    { auto rr = __builtin_amdgcn_permlane32_swap(__float_as_uint(l_reg), __float_as_uint(l_reg), false, false); l_reg = __uint_as_float(rr[0]) + __uint_as_float(rr[1]); }
    E(o, ctv - negm[0], l_reg, shm, wid);
    if (RES) { asm volatile("s_waitcnt lgkmcnt(0)" ::: "memory"); } else { asm volatile("s_waitcnt lgkmcnt(0)\n\ts_barrier" ::: "memory"); }
#undef DMA_K
#undef DMA_V
#undef CMASK
#undef CSUB
#undef START
#undef RESC
#undef ROT
#undef WB2
#undef WBR
#undef PKW
#undef PAF
#undef VFR
#undef PIN
#undef MX3
#undef GAPA
#undef GAPB
#undef EX
#undef VRD
#undef KRD
#undef STEP
#undef ENDW
}
__device__ __forceinline__ void cmask_own(f32x16& p0, f32x16& p1, int ql, int hi) {
#pragma unroll
    for (int r = 0; r < 16; ++r) { const int kvp = 4 * hi + (r & 3) + 8 * (r >> 2); if (kvp > ql) p0[r] = -INFINITY; if (kvp + 32 > ql) p1[r] = -INFINITY; }
}
template <int THRL, class Epi> __device__ __forceinline__ void unit_sel(const f16* qrow, const f16* __restrict__ Kh, const f16* __restrict__ Vh, const LAS unsigned* selw, const int qt, const int ql, const bool winl, const Epi& E, char* shm) {
    const int tid = opaque_tid(), lane = tid & 63, r32 = lane & 31, hi = lane >> 5; const int wid = __builtin_amdgcn_readfirstlane(tid >> 6);
    const unsigned lds0 = (unsigned)(uintptr_t)shm;
    float* wsf = (float*)(shm + LDS_WS) + wid * 64;
    const int NT = (qt + 2) < 4 ? 4 : ((qt + 2) & ~1);
    const f16* ksrc = Kh + (long)lane * 64 + wid * 8;
    const f16* vsrc = Vh + (long)(16 * (wid & 3) + (lane >> 2)) * 64 + (wid >> 2) * 32 + (lane & 3) * 8;
    const unsigned kdst = lds0 + LDS_K + wid * 1024, vdst = lds0 + LDS_V + wid * 1024;
#define DMA_K(t, slot) glds16(ksrc + (long)(t) * 4096, (unsigned)__builtin_amdgcn_readfirstlane(kdst + (slot)))
#define DMA_V(t, slot) glds16(vsrc + (long)(t) * 4096, (unsigned)__builtin_amdgcn_readfirstlane(vdst + (slot)))
#define SBIT(t) (((t) <= qt) ? ((selw[(t) >> 5] >> ((t) & 31)) & 1u) : 0u)
    const int vb0 = (int)(lds0 + LDS_V) + ((lane >> 4) & 1) * 32 + (lane & 3) * 8 + (4 * hi + ((lane & 15) >> 2)) * 64;
    const char* Kbase = shm + LDS_K; h8 kf[8];
    const lds_cptr shm3 = (lds_cptr)shm; const lds_cptr kp0 = shm3 + LDS_K + hi * 1024 + r32 * 16; const lds_cptr vp0 = shm3 + LDS_V + ((lane >> 4) & 1) * 32 + (lane & 3) * 8 + (4 * hi + ((lane & 15) >> 2)) * 64;
    DMA_K(0, 0); DMA_V(0, 0); DMA_K(1, SLOTB);
    h8 qr[4];
#pragma unroll
    for (int d0 = 0; d0 < 4; ++d0) qr[d0] = *reinterpret_cast<const h8*>(qrow + d0 * 16 + hi * 8);
    float mhat = 0.f, l_reg = 0.f; f32x16 o[2];
#pragma unroll
    for (int r = 0; r < 16; ++r) { o[0][r] = 0.f; o[1][r] = 0.f; }
    f32x16 negm;
#pragma unroll
    for (int r = 0; r < 16; ++r) negm[r] = 0.f;
    asm volatile("" : "+v"(negm));
    bool resc = false;
    bool fresh = false;
#define START(P0, P1) do { const float rm = rowmax(P0, P1); resc = false; fresh = !(rm > -INFINITY); \
    { const float dl = fresh ? 0.f : rm; mhat = fadd_s(mhat, dl); \
      _Pragma("unroll") for (int r = 0; r < 16; ++r) { P0[r] = fsub_s(P0[r], dl); P1[r] = fsub_s(P1[r], dl); } \
      _Pragma("unroll") for (int r = 0; r < 16; ++r) negm[r] = -mhat; asm volatile("" : "+v"(negm)); } \
    _Pragma("unroll") for (int r = 0; r < 16; ++r) P0[r] = __builtin_amdgcn_exp2f(P0[r]); } while (0)
#define RESC() do { if (resc) { asm volatile("s_waitcnt lgkmcnt(0)" ::: "memory"); \
      _Pragma("unroll") for (int d_ = 0; d_ < 2; ++d_) _Pragma("unroll") for (int r = 0; r < 16; ++r) o[d_][r] *= wsf[crow(r, hi)]; } } while (0)
    f32x16 pA0, pA1, pB0, pB1;
    int sl_prev = 0, sl_cur = 0, sl_next = SLOTB;
#define ROT() do { sl_prev = sl_cur; sl_cur = sl_next; sl_next = (sl_next == (NSLOT - 1) * SLOTB) ? 0 : sl_next + SLOTB; } while (0)
    DMA_K(2, 2 * SLOTB);
    WAIT_BAR(3);
    qkt(pA0, pA1, Kbase, qr, negm, r32, hi); asm volatile("s_nop 15\n\ts_nop 7" : "+v"(pA0), "+v"(pA1)); if (qt == 0) cmask_own(pA0, pA1, ql, hi);
    if (winl) {
#pragma unroll
        for (int r = 0; r < 16; ++r) { const int kvp = 4 * hi + (r & 3) + 8 * (r >> 2); if (kvp <= ql) pA0[r] = -INFINITY; if (kvp + 32 <= ql) pA1[r] = -INFINITY; }
    }
    START(pA0, pA1);
    _Pragma("unroll") for (int r = 0; r < 16; ++r) pA1[r] = __builtin_amdgcn_exp2f(pA1[r]);
    WAIT_BAR(0);
    DMA_K(3, 0); DMA_V(1, SLOTB);
    ROT();
    unsigned bprev = 1u;
    unsigned bcur = SBIT(1); bool acur = __any(bcur != 0u);
    if (acur) kload8(kf, kp0 + sl_cur);
    WAIT_BAR(2);
    bool aprev = true;
    s16x4 vfa0, vfa1, vfb0, vfb1; u32x4 pw0, pw1, pw2, pw3;
#define PKW(P, B) pkh(P[B], P[B + 1])
#define PAF(k) __builtin_bit_cast(h8, pw##k)
#define PIN(x) asm volatile("" : "+v"(x))
#define MX3(a, b, c) __builtin_fmaxf(__builtin_fmaxf((a), (b)), (c))
#define EX(v) __builtin_amdgcn_exp2f(v)
#define VRDP(i, LO, HI) do { LO = vtr2(vp_ + (((i) >> 2) * 4096 + ((i) & 3) * 1024)); HI = vtr2(vp_ + (((i) >> 2) * 4096 + ((i) & 3) * 1024 + 512)); } while (0)
#define KRD(G, j) do { if (G) { kload2(kf, kp0 + sl_next, j); SBAR(); } } while (0)
#define GAPA(AQ, AP, MF, A0, A1, A2, A3, W0, W1, PW) do { if (AQ) { MF; } if (AP) { sacc += A0; sacc += A1; sacc += A2; sacc += A3; PIN(sacc); W0; W1; PIN(PW); } SBAR(); } while (0)
#define GAPB(AQ, AP, MF, NEXTRD, X, B) do { if (AP) { MF; NEXTRD; } if (AQ) { X[B] = EX(X[B]); X[B + 1] = EX(X[B + 1]); X[B + 2] = EX(X[B + 2]); X[B + 3] = EX(X[B + 3]); PIN(X); } SBAR(); } while (0)
#define STEP(C0, C1, P0, P1, t, AQ, AP, GK, GV, GL) do { SBAR(); \
    const lds_cptr vp_ = vp0 + sl_prev; \
    if (!(AQ)) { asm volatile("" : "=v"(C0), "=v"(C1)); }        \
    float sacc = 0.f; \
    if (AP) { sacc = (P0[0] + P0[1]); } \
    GAPA(AQ, AP, C0 = MFMA32(kf[0], qr[0], negm), P0[2], P0[3], P0[4], P0[5],     pw0[0] = PKW(P0, 0), pw0[1] = PKW(P0, 2), pw0); \
    GAPA(AQ, AP, C1 = MFMA32(kf[1], qr[0], negm), P0[6], P0[7], P0[8], P0[9],     pw0[2] = PKW(P0, 4), pw0[3] = PKW(P0, 6), pw0); \
    GAPA(AQ, AP, C0 = MFMA32(kf[2], qr[1], C0),   P0[10], P0[11], P0[12], P0[13], pw1[0] = PKW(P0, 8), pw1[1] = PKW(P0, 10), pw1); \
    GAPA(AQ, AP, C1 = MFMA32(kf[3], qr[1], C1),   P0[14], P0[15], P1[0], P1[1],   pw1[2] = PKW(P0, 12), pw1[3] = PKW(P0, 14), pw1); \
    GAPA(AQ, AP, C0 = MFMA32(kf[4], qr[2], C0),   P1[2], P1[3], P1[4], P1[5],     pw2[0] = PKW(P1, 0), pw2[1] = PKW(P1, 2), pw2); \
    GAPA(AQ, AP, C1 = MFMA32(kf[5], qr[2], C1),   P1[6], P1[7], P1[8], P1[9],     pw2[2] = PKW(P1, 4), pw2[3] = PKW(P1, 6), pw2); \
    GAPA(AQ, AP, C0 = MFMA32(kf[6], qr[3], C0),   P1[10], P1[11], P1[12], P1[13], pw3[0] = PKW(P1, 8), pw3[1] = PKW(P1, 10), pw3); \
    GAPA(AQ, AP, C1 = MFMA32(kf[7], qr[3], C1),   P1[14], P1[15], 0.f, 0.f,       pw3[2] = PKW(P1, 12), pw3[3] = PKW(P1, 14), pw3); \
    if (AP) { const unsigned mw_ = bprev ? 0xFFFFFFFFu : 0u; l_reg += bprev ? sacc : 0.f;        \
        pw0 &= mw_; pw1 &= mw_; pw2 &= mw_; pw3 &= mw_; } \
    if (GK) { DMA_K((t) + 3, sl_cur); } if (GV) { DMA_V((t) + 1, sl_next); } \
    if (AP) { VRDP(0, vfa0, vfa1); } \
    resc = false; \
    if (AQ) { if ((t) == qt) cmask_own(C0, C1, ql, hi); \
      float a = MX3(C0[0], C0[1], C1[0]), b = MX3(C0[2], C0[3], C1[1]); a = MX3(a, C1[2], C1[3]); \
      _Pragma("unroll") for (int r = 4; r < 16; r += 4) { a = MX3(a, C0[r], C0[r + 1]); b = MX3(b, C0[r + 2], C0[r + 3]); a = MX3(a, C1[r], C1[r + 1]); b = MX3(b, C1[r + 2], C1[r + 3]); } \
      float rm = __builtin_fmaxf(a, b); { auto rr = __builtin_amdgcn_permlane32_swap(__float_as_uint(rm), __float_as_uint(rm), false, false); rm = __builtin_fmaxf(__uint_as_float(rr[0]), __uint_as_float(rr[1])); } \
      rm = bcur ? rm : -INFINITY; \
      const bool take_ = fresh && (rm > -INFINITY); \
      if (__builtin_expect(__any(rm > (float)THRL || take_), 0)) { const float dl = take_ ? rm : __builtin_fmaxf(rm, 0.f); mhat += dl; fresh = fresh && !take_; \
        _Pragma("unroll") for (int r = 0; r < 16; ++r) { C0[r] -= dl; C1[r] -= dl; } \
        _Pragma("unroll") for (int r = 0; r < 16; ++r) negm[r] = -mhat; asm volatile("" : "+v"(negm)); \
        const float f = take_ ? 1.f : __builtin_amdgcn_exp2f(-dl); l_reg *= f; { const int lr_ = opaque_tid() & 63; if (lr_ < 32) ((float*)(shm + LDS_WS))[wid * 64 + lr_] = f; } resc = true; } } \
    SBAR(); \
    GAPB(AQ, AP, o[0] = MFMA32(PAF(0), mk8(vfa0, vfa1), o[0]), VRDP(4, vfb0, vfb1), C0, 0); \
    GAPB(AQ, AP, o[1] = MFMA32(PAF(0), mk8(vfb0, vfb1), o[1]), VRDP(1, vfa0, vfa1), C0, 4); \
    KRD(GL, 0); GAPB(AQ, AP, o[0] = MFMA32(PAF(1), mk8(vfa0, vfa1), o[0]), VRDP(5, vfb0, vfb1), C0, 8); \
    KRD(GL, 1); GAPB(AQ, AP, o[1] = MFMA32(PAF(1), mk8(vfb0, vfb1), o[1]), VRDP(2, vfa0, vfa1), C0, 12); \
    KRD(GL, 2); GAPB(AQ, AP, o[0] = MFMA32(PAF(2), mk8(vfa0, vfa1), o[0]), VRDP(6, vfb0, vfb1), C1, 0); \
    KRD(GL, 3); GAPB(AQ, AP, o[1] = MFMA32(PAF(2), mk8(vfb0, vfb1), o[1]), VRDP(3, vfa0, vfa1), C1, 4); \
    GAPB(AQ, AP, o[0] = MFMA32(PAF(3), mk8(vfa0, vfa1), o[0]), VRDP(7, vfb0, vfb1), C1, 8); \
    GAPB(AQ, AP, o[1] = MFMA32(PAF(3), mk8(vfb0, vfb1), o[1]), (void)0, C1, 12); \
    } while (0)
#define STEPV(C0, C1, P0, P1, t) do { const unsigned bnext = SBIT((t) + 1); const bool anext = ((t) + 1 < NT) && __any(bnext != 0u); \
    const bool gk_ = ((t) + 3 < NT), gv_ = ((t) + 1 < NT); \
    STEP(C0, C1, P0, P1, t, acur, aprev, gk_, gv_, anext); \
    ENDW(t); RESC(); ROT(); bprev = bcur; aprev = acur; bcur = bnext; acur = anext; } while (0)
#define ENDW(tt) do { if ((tt) + 3 < NT) { WAIT_BAR(2); } else if ((tt) + 2 < NT) { WAIT_BAR(1); } else { WAIT_BAR(0); } } while (0)
    int t = 1;
    for (; t + 1 < NT; t += 2) {
        STEPV(pB0, pB1, pA0, pA1, t);
        STEPV(pA0, pA1, pB0, pB1, t + 1);
    }
    {
        const bool gk_ = false, gv_ = false;
        STEP(pB0, pB1, pA0, pA1, NT - 1, acur, aprev, gk_, gv_, false);
        RESC();
        if (acur) {
            float sacc = pB0[0] + pB0[1]; _Pragma("unroll") for (int r = 2; r < 16; ++r) sacc += pB0[r]; _Pragma("unroll") for (int r = 0; r < 16; ++r) sacc += pB1[r]; l_reg += bcur ? sacc : 0.f;
            const unsigned mw_ = bcur ? 0xFFFFFFFFu : 0u;
            pw0 = (u32x4){PKW(pB0, 0), PKW(pB0, 2), PKW(pB0, 4), PKW(pB0, 6)} & mw_; pw1 = (u32x4){PKW(pB0, 8), PKW(pB0, 10), PKW(pB0, 12), PKW(pB0, 14)} & mw_;
            pw2 = (u32x4){PKW(pB1, 0), PKW(pB1, 2), PKW(pB1, 4), PKW(pB1, 6)} & mw_; pw3 = (u32x4){PKW(pB1, 8), PKW(pB1, 10), PKW(pB1, 12), PKW(pB1, 14)} & mw_;
            SBAR(); pv(o, vb0 + sl_cur, PAF(0), PAF(1), PAF(2), PAF(3)); }
    }
    { auto rr = __builtin_amdgcn_permlane32_swap(__float_as_uint(l_reg), __float_as_uint(l_reg), false, false); l_reg = __uint_as_float(rr[0]) + __uint_as_float(rr[1]); }
    E(o, mhat, l_reg, shm, wid);
    asm volatile("s_waitcnt lgkmcnt(0)\n\ts_barrier" ::: "memory");
#undef DMA_K
#undef DMA_V
#undef SBIT
#undef START
#undef RESC
#undef ROT
#undef PKW
#undef PAF
#undef PIN
#undef MX3
#undef GAPA
#undef GAPB
#undef EX
#undef VRDP
#undef KRD
#undef STEP
#undef STEPV
#undef ENDW
}
struct EpiCmpA { const float* gates; f16* O; int b, g, q0; float& m_out; float& il_out;
    __device__ __forceinline__ void after_q() const {}
    __device__ __forceinline__ void operator()(const f32x16 (&o)[2], float mhat, float l, char* shm, int wid) const {
        const int le = opaque_tid() & 63; const float il = l > 0.f ? __builtin_amdgcn_rcpf(l) : 0.f;
        m_out = mhat; il_out = il;
        stage_rows(o, il, shm, wid, le);
        const f16* stg = (const f16*)(shm + LDS_OST) + wid * 2048;
#pragma unroll
        for (int i = 0; i < 4; ++i) { const int row = i * 8 + (le >> 3), ch = le & 7; const int q = q0 + (row >> 2), hd = 4 * g + (row & 3);
            o_acc8(O + ((size_t)b * SEQ + q) * DM + 512 + hd * HD + ch * 8, gates[((size_t)b * SEQ + q) * 24 + hd * 3], *(const h8*)(stg + row * 64 + ch * 8)); }
    } };
__device__ __forceinline__ float quad_sum2(float v) {
    v += __int_as_float(__builtin_amdgcn_mov_dpp(__float_as_int(v), 0xB1, 0xF, 0xF, true));
    v += __int_as_float(__builtin_amdgcn_mov_dpp(__float_as_int(v), 0x4E, 0xF, 0xF, true));
    return v;
}
constexpr int IMPS = 260;
__device__ __forceinline__ float swap_half(float x, int hi) { auto rr = __builtin_amdgcn_permlane32_swap(__float_as_uint(x), __float_as_uint(x), false, false); return __uint_as_float(hi ? rr[0] : rr[1]); }
__device__ __forceinline__ void unit_imp(const f16* qrow, const f16* __restrict__ Kh, const int nt, const int cmaxq, const float mhat, const float invl, LAS float* improw, char* shm) {
    const int tid = opaque_tid(), lane = tid & 63, r32 = lane & 31, hi = lane >> 5; const int wid = __builtin_amdgcn_readfirstlane(tid >> 6);
    const unsigned lds0 = (unsigned)(uintptr_t)shm;
    const f16* ksrc = Kh + (long)lane * 64 + wid * 8;
    const unsigned kdst = lds0 + LDS_K + wid * 1024;
    const lds_cptr kp0 = (lds_cptr)shm + LDS_K + hi * 1024 + r32 * 16;
#define DMA_K(t, slot) glds16(ksrc + (long)(t) * 4096, (unsigned)__builtin_amdgcn_readfirstlane(kdst + (slot)))
    DMA_K(0, 0); if (nt > 1) DMA_K(1, SLOTB); if (nt > 2) DMA_K(2, 2 * SLOTB);
    h8 qr[4];
#pragma unroll
    for (int d0 = 0; d0 < 4; ++d0) qr[d0] = *reinterpret_cast<const h8*>(qrow + d0 * 16 + hi * 8);
    f32x16 negm;
#pragma unroll
    for (int r = 0; r < 16; ++r) negm[r] = -mhat;
    const bool wr_lane = ((r32 & 3) == 0);
    int slot = 0; float carry = 0.f;
    for (int t = 0; t < nt; ++t) {
        if (t + 1 < nt) { WAIT_BAR(1); } else { WAIT_BAR(0); }
        if (t >= 1 && t + 2 < nt) { const int sp = (slot == 0) ? 2 * SLOTB : slot - SLOTB; DMA_K(t + 2, sp); }
        h8 kf[8]; kload8(kf, kp0 + slot);
        f32x16 p0 = MFMA32(kf[0], qr[0], negm), p1 = MFMA32(kf[1], qr[0], negm);
        p0 = MFMA32(kf[2], qr[1], p0); p1 = MFMA32(kf[3], qr[1], p1);
        p0 = MFMA32(kf[4], qr[2], p0); p1 = MFMA32(kf[5], qr[2], p1);
        p0 = MFMA32(kf[6], qr[3], p0); p1 = MFMA32(kf[7], qr[3], p1);
        const bool band = (64 * t + 63 > __builtin_amdgcn_readfirstlane(cmaxq) - 2);
#pragma unroll
        for (int r = 0; r < 16; ++r) { p0[r] = fexp2(p0[r]) * invl; p1[r] = fexp2(p1[r]) * invl; }
        if (band) {
#pragma unroll
            for (int r = 0; r < 16; ++r) { const int c = 64 * t + crow(r, hi); if (c > cmaxq) p0[r] = 0.f; if (c + 32 > cmaxq) p1[r] = 0.f; }
        }
        float G0[4], L0[4], G1[4], L1[4], R0[4], R1[4];
#pragma unroll
        for (int gq = 0; gq < 4; ++gq) {
            const float a0 = quad_sum2(p0[4 * gq]), a1 = quad_sum2(p0[4 * gq + 1]), a2 = quad_sum2(p0[4 * gq + 2]), a3 = quad_sum2(p0[4 * gq + 3]);
            const float b0 = quad_sum2(p1[4 * gq]), b1 = quad_sum2(p1[4 * gq + 1]), b2 = quad_sum2(p1[4 * gq + 2]), b3 = quad_sum2(p1[4 * gq + 3]);
            G0[gq] = (a0 + a1) + (a2 + a3); L0[gq] = a3; G1[gq] = (b0 + b1) + (b2 + b3); L1[gq] = b3;
        }
#pragma unroll
        for (int gq = 0; gq < 4; ++gq) { R0[gq] = swap_half(L0[gq], hi); R1[gq] = swap_half(L1[gq], hi); }
        if (wr_lane) {
            LAS float* irow = improw + 16 * t + hi;
#pragma unroll
            for (int gq = 0; gq < 4; ++gq) {
                const float prev0 = hi ? R0[gq] : (gq == 0 ? carry : R0[gq > 0 ? gq - 1 : 0]);
                const float prev1 = hi ? R1[gq] : (gq == 0 ? R0[3] : R1[gq > 0 ? gq - 1 : 0]);
                irow[2 * gq] = G0[gq] + prev0; irow[8 + 2 * gq] = G1[gq] + prev1;
            }
        }
        carry = R1[3];
        slot = (slot == 2 * SLOTB) ? 0 : slot + SLOTB;
    }
    asm volatile("s_waitcnt lgkmcnt(0)\n\ts_barrier" ::: "memory");
#undef DMA_K
}
#undef SBAR
#undef WAIT_BAR
}

__device__ __forceinline__ int sl_off(int j) { return 64 * ((j - 1) * 254 - ((j - 1) * j) / 2); }
constexpr int SL_BG = 64 * 32131;
constexpr int PIECE = 1024;
__device__ __forceinline__ void nsa_cmp_unit(const f16* proj, const f16* kcmp, const f16* vcmp, const float* gates, f16* Onsa, unsigned* slist, gu32* scnt, int b, int g, int qt, LAS unsigned char* lds, char* shm) {
    const int tid = opaque_tid(), lane = tid & 63, r32 = lane & 31; const int wid = __builtin_amdgcn_readfirstlane(tid >> 6);
    LAS float* imp = (LAS float*)(lds + fa::LDS_V);
    const int ql = 8 * wid + (r32 >> 2), hd = 4 * g + (r32 & 3), qpos = 64 * qt + ql;
    const int pair = g * 2 + b;
    const f16* kc = kcmp + (size_t)pair * 1024 * HD; const f16* vc = vcmp + (size_t)pair * 1024 * HD;
    const f16* qp = proj + (size_t)(24 + hd) * (NB * SEQ * HD) + ((size_t)b * SEQ + qpos) * HD;
    const int cmaxq = (qpos >= 31) ? ((qpos - 31) >> 4) : -1;
    const int nt = ((4 * qt + 2) >> 6) + 1;
    const int NT = nt < 4 ? 4 : ((nt + 1) & ~1);
    float mrow = 0.f, ilrow = 0.f;
    fa::unit<8, false, true, fa::EpiCmpA, true>(qp, kc, vc, nullptr, nullptr, NT, cmaxq - 64 * (NT - 4), fa::EpiCmpA{gates, Onsa, b, g, 64 * qt + 8 * wid, mrow, ilrow}, shm);
    fa::unit_imp(qp, kc, nt, cmaxq, mrow, ilrow, imp + ql * fa::IMPS, shm);
    const int nfree = qt - 2;
    int vb[8][4];
#pragma unroll
    for (int qi = 0; qi < 8; ++qi) { const LAS float* irow = imp + (8 * wid + qi) * fa::IMPS;
#pragma unroll
        for (int i = 0; i < 4; ++i) { const int j = lane + 64 * i; vb[qi][i] = ((j >= 1) && (j <= qt - 2)) ? __float_as_int(irow[j]) : -1; } }
    int T[8];
#pragma unroll
    for (int qi = 0; qi < 8; ++qi) T[qi] = 0;
    if (nfree > 13) {
        for (int bit = 30; bit >= 0; --bit) {
#pragma unroll
            for (int qi = 0; qi < 8; ++qi) { const int cand = T[qi] | (1 << bit);
                const int cnt = __popcll(__ballot(vb[qi][0] >= cand)) + __popcll(__ballot(vb[qi][1] >= cand)) + __popcll(__ballot(vb[qi][2] >= cand)) + __popcll(__ballot(vb[qi][3] >= cand));
                T[qi] = (cnt >= 13) ? cand : T[qi]; }
        }
    }
    LAS int* lcnt = (LAS int*)lds; LAS int* lbase = lcnt + 256; LAS int* npend = lcnt + 512; LAS unsigned* pendA = (LAS unsigned*)(lds + 4096); LAS unsigned* pendB = (LAS unsigned*)(lds + 8192);
    if (tid < 256) lcnt[tid] = 0; if (tid == 256) *npend = 0;
    __syncthreads();
#pragma unroll
    for (int qi = 0; qi < 8; ++qi) {
        const int q = 8 * wid + qi; bool sfree[4];
        if (nfree <= 13) {
#pragma unroll
            for (int i = 0; i < 4; ++i) sfree[i] = (vb[qi][i] >= 0);
        } else {
            int ngt = 0; unsigned long long eqm[4];
#pragma unroll
            for (int i = 0; i < 4; ++i) { ngt += __popcll(__ballot(vb[qi][i] > T[qi])); eqm[i] = __ballot(vb[qi][i] == T[qi]); }
            const int need_eq = 13 - ngt; int before = 0;
#pragma unroll
            for (int i = 0; i < 4; ++i) { const int rank = before + __builtin_amdgcn_mbcnt_hi((unsigned)(eqm[i] >> 32), __builtin_amdgcn_mbcnt_lo((unsigned)eqm[i], 0));
                sfree[i] = (vb[qi][i] > T[qi]) || ((vb[qi][i] == T[qi]) && rank < need_eq); before += __popcll(eqm[i]); }
        }
        int sbefore = 0;
#pragma unroll
        for (int i = 0; i < 4; ++i) { const int j = lane + 64 * i; const unsigned long long fm = __ballot(sfree[i]);
            if (sfree[i]) { const int slot = sbefore + __builtin_amdgcn_mbcnt_hi((unsigned)(fm >> 32), __builtin_amdgcn_mbcnt_lo((unsigned)fm, 0));
                const int lr = __hip_atomic_fetch_add(lcnt + j, 1, __ATOMIC_RELAXED, __HIP_MEMORY_SCOPE_WORKGROUP);
                const int pi = __hip_atomic_fetch_add(npend, 1, __ATOMIC_RELAXED, __HIP_MEMORY_SCOPE_WORKGROUP);
                pendA[pi] = (unsigned)j | ((unsigned)lr << 8); pendB[pi] = (unsigned)(64 * qt + q) | ((unsigned)slot << 14); }
            sbefore += __popcll(fm); }
    }
    __syncthreads();
    if (tid < 256) { const int c = lcnt[tid]; lbase[tid] = c > 0 ? (int)__hip_atomic_fetch_add(scnt + tid, (unsigned)c, __ATOMIC_RELAXED, __HIP_MEMORY_SCOPE_AGENT) : 0; }
    __syncthreads();
    { const int np = *npend;
      for (int e = tid; e < np; e += 512) { const unsigned pa = pendA[e]; const int j = pa & 255, lr = pa >> 8; slist[sl_off(j) + lbase[j] + lr] = pendB[e]; } }
}

struct SelMergeF {
    static constexpr bool HAS_CS = false;
    const f16* proj; const unsigned char* PO; const float* PML; const float* gates; f16* O; int b, g, qt, nsl;
    int wid_, qpos, hd_, ql; LAS float* wtab;
    __device__ __forceinline__ void init(int wid, int r32, int hi) { wid_ = wid; ql = 8 * wid + (r32 >> 2); hd_ = 4 * g + (r32 & 3); qpos = 64 * qt + ql; }
    __device__ __forceinline__ const f16* qrow() const { return proj + (size_t)(24 + hd_) * (NB * SEQ * HD) + ((size_t)b * SEQ + qpos) * HD; }
    __device__ __forceinline__ int t_begin() const { return 0; }
    __device__ __forceinline__ int t_end() const { return qt >= 2 ? 3 : qt + 1; }
    __device__ __forceinline__ int blk(int t) const { return qt >= 2 ? (t == 0 ? 0 : qt - 2 + t) : t; }
    __device__ __forceinline__ const char* ktile(int t) const { return (const char*)(proj + (size_t)(34 + g) * (NB * SEQ * HD) + (size_t)b * SEQ * HD) + (size_t)blk(t) * 8192; }
    __device__ __forceinline__ const char* vtile(int t) const { return (const char*)(proj + (size_t)(40 + g) * (NB * SEQ * HD) + (size_t)b * SEQ * HD) + (size_t)blk(t) * 8192; }
    __device__ __forceinline__ const float* cs_src(int) const { return nullptr; }
    __device__ __forceinline__ void unit_prep(LAS unsigned char* lds, int) { wtab = (LAS float*)(lds + L_IMP); }
    __device__ __forceinline__ bool active(int) const { return true; }
    __device__ __forceinline__ void mask(f32x16& p0, f32x16& p1, int t, const LAS float*, int hi) const {
        if (blk(t) == qt) {
#pragma unroll
            for (int r = 0; r < 16; ++r) { const int kvp = crow(r, hi); if (kvp > ql) p0[r] = -INFINITY; if (kvp + 32 > ql) p1[r] = -INFINITY; }
        }
    }
    __device__ __forceinline__ void store(const LAS f16* stg, int lane, const LAS float* wsf) const {
        LAS float* tab = wtab + wid_ * 512;
        if (lane < 32) { const int row = lane; const int q = 64 * qt + 8 * wid_ + (row >> 2), hdl = row & 3;
            const float mF = wsf[row], lF = wsf[32 + row]; float M = mF; float ms[13], ls[13];
#pragma unroll
            for (int s_ = 0; s_ < 13; ++s_) { ms[s_] = -INFINITY; ls[s_] = 0.f; if (s_ < nsl) { const f32x2 ml = *(const f32x2*)(PML + 2 * (((size_t)q * 13 + s_) * 4 + hdl)); ms[s_] = ml[0]; ls[s_] = ml[1]; M = fmaxf(M, ml[0]); } }
            const float wF = fexp2(mF - M) * lF; float den = wF; float w[13];
#pragma unroll
            for (int s_ = 0; s_ < 13; ++s_) { w[s_] = (s_ < nsl) ? fexp2(ms[s_] - M) * ls[s_] : 0.f; den += w[s_]; }
            const float rd = 1.f / den; tab[row * 16] = wF * rd;
#pragma unroll
            for (int s_ = 0; s_ < 13; ++s_) tab[row * 16 + 1 + s_] = w[s_] * rd;
        }
        LDS_WAIT();
#pragma unroll
        for (int i = 0; i < 4; ++i) { const int row = i * 8 + (lane >> 3), ch = lane & 7; const int q = 64 * qt + 8 * wid_ + (row >> 2), hdl = row & 3;
            const LAS float* a = tab + row * 16; const h8 own = *(const LAS h8*)(stg + row * 64 + ch * 8);
            float acc[8];
#pragma unroll
            for (int e = 0; e < 8; ++e) acc[e] = a[0] * (float)own[e];
            u32x2 pvs[13];
#pragma unroll
            for (int s_ = 0; s_ < 13; ++s_) pvs[s_] = *(const u32x2*)(PO + (((size_t)q * 13 + (s_ < nsl ? s_ : 0)) * 4 + hdl) * 64 + ch * 8);
#pragma unroll
            for (int s_ = 0; s_ < 13; ++s_) if (s_ < nsl) { const float as = a[1 + s_];
                acc[0] += as * __builtin_amdgcn_cvt_f32_fp8(pvs[s_].x, 0); acc[1] += as * __builtin_amdgcn_cvt_f32_fp8(pvs[s_].x, 1); acc[2] += as * __builtin_amdgcn_cvt_f32_fp8(pvs[s_].x, 2); acc[3] += as * __builtin_amdgcn_cvt_f32_fp8(pvs[s_].x, 3);
                acc[4] += as * __builtin_amdgcn_cvt_f32_fp8(pvs[s_].y, 0); acc[5] += as * __builtin_amdgcn_cvt_f32_fp8(pvs[s_].y, 1); acc[6] += as * __builtin_amdgcn_cvt_f32_fp8(pvs[s_].y, 2); acc[7] += as * __builtin_amdgcn_cvt_f32_fp8(pvs[s_].y, 3); }
            const float g1 = gates[((size_t)b * SEQ + q) * 24 + (4 * g + hdl) * 3 + 1];
            f16* op = O + ((size_t)b * SEQ + q) * DM + 512 + (4 * g + hdl) * HD + ch * 8;
            const h8 c = *(const h8*)op; float r_[8];
#pragma unroll
            for (int e = 0; e < 8; ++e) r_[e] = (float)c[e] + g1 * acc[e];
            u32x4 o4; o4.x = pkh(r_[0], r_[1]); o4.y = pkh(r_[2], r_[3]); o4.z = pkh(r_[4], r_[5]); o4.w = pkh(r_[6], r_[7]);
            *(u32x4*)op = o4; }
        LDS_WAIT();
    }
};
__device__ __forceinline__ void sel_gather_unit(const f16* proj, int b, int g, int j, const unsigned* ent, int cnt, unsigned char* PO, float* PML, LAS unsigned char* lds) {
    const int tid = opaque_tid(), lane = tid & 63, r32 = lane & 31, hi = lane >> 5; const int wid = __builtin_amdgcn_readfirstlane(tid >> 6);
    __syncthreads();
    { KVStage st; kv_issue(st, (const char*)(proj + (size_t)(34 + g) * (NB * SEQ * HD) + (size_t)b * SEQ * HD) + (size_t)j * 8192, (const char*)(proj + (size_t)(40 + g) * (NB * SEQ * HD) + (size_t)b * SEQ * HD) + (size_t)j * 8192, wid, lane); kv_write(st, lds, wid, lane); }
    __syncthreads();
    LAS float* wsf = (LAS float*)(lds + L_WSF) + wid * 64; LAS f16* stg = (LAS f16*)(lds + 32768) + wid * 4096; LAS int* tab = (LAS int*)(lds + L_SEL) + wid * 64;
    LAS float* rinv = (LAS float*)(lds + 98304) + wid * 64;
    const f16* qbase = proj + (size_t)(24 + 4 * g + (r32 & 3)) * (NB * SEQ * HD) + (size_t)b * SEQ * HD;
    const int nch = (cnt + 7) >> 3, el = r32 >> 2;
    int codeN[2]; h8 qn[2][4];
#pragma unroll
    for (int k = 0; k < 2; ++k) { const int c = 2 * wid + k; codeN[k] = (c < nch && 8 * c + el < cnt) ? (int)ent[8 * c + el] : -1;
        const f16* qp = qbase + (size_t)((codeN[k] < 0 ? 0 : codeN[k]) & 16383) * HD;
#pragma unroll
        for (int d0 = 0; d0 < 4; ++d0) qn[k][d0] = *(const h8*)(qp + 16 * d0 + 8 * hi); }
    for (int c0 = 2 * wid; c0 < nch; c0 += 16) {
        int code[2]; h8 qr[2][4];
#pragma unroll
        for (int k = 0; k < 2; ++k) { code[k] = codeN[k];
#pragma unroll
            for (int d0 = 0; d0 < 4; ++d0) qr[k][d0] = qn[k][d0]; }
#pragma unroll
        for (int k = 0; k < 2; ++k) { const int c = c0 + 16 + k; codeN[k] = (c < nch && 8 * c + el < cnt) ? (int)ent[8 * c + el] : -1;
            const f16* qp = qbase + (size_t)((codeN[k] < 0 ? 0 : codeN[k]) & 16383) * HD;
#pragma unroll
            for (int d0 = 0; d0 < 4; ++d0) qn[k][d0] = *(const h8*)(qp + 16 * d0 + 8 * hi); }
        f32x16 p0[2], p1[2], o[2][2]; float m[2], l[2];
#pragma unroll
        for (int k = 0; k < 2; ++k) qk_tile(p0[k], p1[k], lds, qr[k], r32, hi);
#pragma unroll
        for (int k = 0; k < 2; ++k) { m[k] = rowmax32(p0[k], p1[k]); l[k] = 0.f;
#pragma unroll
            for (int r = 0; r < 16; ++r) { p0[k][r] = fexp2(p0[k][r] - m[k]); p1[k][r] = fexp2(p1[k][r] - m[k]); l[k] += p0[k][r] + p1[k][r]; } }
#pragma unroll
        for (int k = 0; k < 2; ++k) {
#pragma unroll
            for (int r = 0; r < 16; ++r) { o[k][0][r] = 0.f; o[k][1][r] = 0.f; }
            u32x4 pw[4]; pack_p(pw, p0[k], p1[k]); pv_tile(o[k], lds + 8192, pw, lane, hi); l[k] = swapsum(l[k]); }
#pragma unroll
        for (int k = 0; k < 2; ++k) { const bool valid = code[k] >= 0; const int dst = valid ? (((code[k] & 16383) * 13 + (code[k] >> 14)) * 4 + (r32 & 3)) : -1;
            if (hi == 0) { tab[32 * k + r32] = dst; rinv[32 * k + r32] = 1.f / l[k]; if (valid) { f32x2 ml = {m[k], l[k]}; *(f32x2*)(PML + 2 * (size_t)dst) = ml; } } }
        LDS_WAIT();
#pragma unroll
        for (int k = 0; k < 2; ++k)
#pragma unroll
            for (int r = 0; r < 16; ++r) { const int orow = crow(r, hi); const float rl = rinv[32 * k + orow];
                stg[(32 * k + orow) * 64 + r32] = (f16)(o[k][0][r] * rl); stg[(32 * k + orow) * 64 + 32 + r32] = (f16)(o[k][1][r] * rl); }
        LDS_WAIT();
#pragma unroll
        for (int i = 0; i < 8; ++i) { const int row = i * 8 + (lane >> 3), ch = lane & 7; const int d = tab[row];
            if (d >= 0) { const h8 v = *(const LAS h8*)(stg + row * 64 + ch * 8); u32x2 w = {0u, 0u};
                w.x = __builtin_amdgcn_cvt_pk_fp8_f32((float)v[0], (float)v[1], w.x, false); w.x = __builtin_amdgcn_cvt_pk_fp8_f32((float)v[2], (float)v[3], w.x, true);
                w.y = __builtin_amdgcn_cvt_pk_fp8_f32((float)v[4], (float)v[5], w.y, false); w.y = __builtin_amdgcn_cvt_pk_fp8_f32((float)v[6], (float)v[7], w.y, true);
                *(u32x2*)(PO + (size_t)d * 64 + ch * 8) = w; } }
        LDS_WAIT();
    }
    (void)wsf;
}
constexpr int LIST_BH = 256 * 2016;
__device__ __forceinline__ int list_off(int j) { return 256 * (63 * j - (j * (j - 1)) / 2); }
__device__ __forceinline__ void top3_ins(float s, int n, float& v0, float& v1, float& v2, int& i0, int& i1, int& i2) {
    const bool g0 = s > v0, g1 = s > v1, g2 = s > v2;
    v2 = g1 ? v1 : (g2 ? s : v2); i2 = g1 ? i1 : (g2 ? n : i2);
    v1 = g0 ? v0 : (g1 ? s : v1); i1 = g0 ? i0 : (g1 ? n : i1);
    v0 = g0 ? s : v0; i0 = g0 ? n : i0;
}
__device__ __forceinline__ void top3_ins_tie(float s, int n, float& v0, float& v1, float& v2, int& i0, int& i1, int& i2) {
    const bool g0 = s > v0 || (s == v0 && n < i0), g1 = s > v1 || (s == v1 && n < i1), g2 = s > v2 || (s == v2 && n < i2);
    v2 = g1 ? v1 : (g2 ? s : v2); i2 = g1 ? i1 : (g2 ? n : i2);
    v1 = g0 ? v0 : (g1 ? s : v1); i1 = g0 ? i0 : (g1 ? n : i1);
    v0 = g0 ? s : v0; i0 = g0 ? n : i0;
}
__device__ __forceinline__ float swapf(float x) { auto rr = __builtin_amdgcn_permlane32_swap(__float_as_uint(x), __float_as_uint(x), false, false); const int hi = (opaque_tid() >> 5) & 1; return __uint_as_float(hi ? rr[0] : rr[1]); }
__device__ __forceinline__ void moba_gate_unit(const f16* qslot, const f16* kimg, unsigned short* lists, gu32* cnt, int unit, LAS unsigned char* lds) {
    const int tid = opaque_tid(), lane = tid & 63, r32 = lane & 31, hi = lane >> 5; const int wid = __builtin_amdgcn_readfirstlane(tid >> 6);
    const int bh = unit >> 6, blk = unit & 63;
    LAS int* lcnt = (LAS int*)(lds + 16384); LAS int* lbase = lcnt + 64;
    __syncthreads();
    { const u32x4* src = (const u32x4*)(kimg + (size_t)bh * 8192); LAS u32x4* dst = (LAS u32x4*)lds; dst[tid] = src[tid]; dst[tid + 512] = src[tid + 512]; }
    if (tid < 64) lcnt[tid] = 0;
    __syncthreads();
    const int qpos = 256 * blk + 32 * wid + r32;
    const f16* qp = qslot + ((size_t)bh * SEQ + qpos) * HD;
    h8 qr[4];
#pragma unroll
    for (int d0 = 0; d0 < 4; ++d0) qr[d0] = *(const h8*)(qp + 16 * d0 + 8 * hi);
    float v0 = -INFINITY, v1 = -INFINITY, v2 = -INFINITY; int i0 = -1, i1 = -1, i2 = -1;
    if (blk > 0) {
        f32x16 ph0, ph1, pl0, pl1;
        qk_tile(ph0, ph1, lds, qr, r32, hi); qk_tile(pl0, pl1, lds + 8192, qr, r32, hi);
#pragma unroll
        for (int r = 0; r < 16; ++r) { const int n = crow(r, hi); const float g = ph0[r] + pl0[r] * (1.f / 4096.f); if (n < blk) top3_ins(g, n, v0, v1, v2, i0, i1, i2); }
#pragma unroll
        for (int r = 0; r < 16; ++r) { const int n = 32 + crow(r, hi); const float g = ph1[r] + pl1[r] * (1.f / 4096.f); if (n < blk) top3_ins(g, n, v0, v1, v2, i0, i1, i2); }
        const float w0 = swapf(v0), w1 = swapf(v1), w2 = swapf(v2); const int j0 = __float_as_int(swapf(__int_as_float(i0))), j1 = __float_as_int(swapf(__int_as_float(i1))), j2 = __float_as_int(swapf(__int_as_float(i2)));
        if (j0 >= 0) top3_ins_tie(w0, j0, v0, v1, v2, i0, i1, i2);
        if (j1 >= 0) top3_ins_tie(w1, j1, v0, v1, v2, i0, i1, i2);
        if (j2 >= 0) top3_ins_tie(w2, j2, v0, v1, v2, i0, i1, i2);
    }
    const bool own = (hi == 0);
    int r0 = 0, r1 = 0, r2 = 0;
    if (own && i0 >= 0) r0 = __hip_atomic_fetch_add(lcnt + i0, 1, __ATOMIC_RELAXED, __HIP_MEMORY_SCOPE_WORKGROUP);
    if (own && i1 >= 0) r1 = __hip_atomic_fetch_add(lcnt + i1, 1, __ATOMIC_RELAXED, __HIP_MEMORY_SCOPE_WORKGROUP);
    if (own && i2 >= 0) r2 = __hip_atomic_fetch_add(lcnt + i2, 1, __ATOMIC_RELAXED, __HIP_MEMORY_SCOPE_WORKGROUP);
    __syncthreads();
    if (tid < 64) { const int c = lcnt[tid]; lbase[tid] = c > 0 ? (int)__hip_atomic_fetch_add(cnt + bh * 64 + tid, (unsigned)c, __ATOMIC_RELAXED, __HIP_MEMORY_SCOPE_AGENT) : 0; }
    __syncthreads();
    unsigned short* lb = lists + (size_t)bh * LIST_BH;
    if (own && i0 >= 0) lb[list_off(i0) + lbase[i0] + r0] = (unsigned short)(qpos);
    if (own && i1 >= 0) lb[list_off(i1) + lbase[i1] + r1] = (unsigned short)(qpos | (1 << 14));
    if (own && i2 >= 0) lb[list_off(i2) + lbase[i2] + r2] = (unsigned short)(qpos | (2 << 14));
}
__device__ __forceinline__ void moba_gather_unit3(const f16* qs, const f16* kblk, const f16* vblk, const unsigned short* ent, int n, int hh, f16* PO, float* PML, LAS unsigned char* lds, char* shm) {
    const int tid = opaque_tid(), lane = tid & 63; const int wid = __builtin_amdgcn_readfirstlane(tid >> 6);
    __syncthreads();
#pragma unroll
    for (int t = 0; t < 4; ++t) { KVStage st; kv_issue(st, (const char*)kblk + t * 8192, (const char*)vblk + t * 8192, wid, lane);
        *(LAS u32x4*)(lds + t * 8192 + wid * 1024 + lane * 16) = st.k; *(LAS u32x4*)(lds + fa::RES_V + t * 8192 + wid * 1024 + lane * 16) = st.v; }
    __syncthreads();
    const int qoff = wid < 4 ? 32768 + wid * 4096 : fa::RES_V + 32768 + (wid - 4) * 4096;
    const unsigned qst = (unsigned)(uintptr_t)shm + (unsigned)qoff;
    int codeN = (wid * 32 + (lane & 31) < n) ? (int)ent[wid * 32 + (lane & 31)] : -1;
    { fa::EpiPartial pre{PO, PML, -1, qs, codeN, qst}; pre.after_q(); }
    for (int c = wid; c * 32 < n; c += 8) {
        const int code = codeN;
        { const int e2 = (c + 8) * 32 + (opaque_tid() & 31); codeN = (e2 < n) ? (int)ent[e2] : -1; }
        const int dst = code >= 0 ? (hh * SEQ + (code & 16383)) * 3 + (code >> 14) : -1;
        asm volatile("s_waitcnt vmcnt(0)" ::: "memory");
        fa::unit<8, false, false, fa::EpiPartial, false, true>((const f16*)(shm + qoff) + (opaque_tid() & 31) * HD, nullptr, nullptr, nullptr, nullptr, 4, fa::QREL_ROW, fa::EpiPartial{PO, PML, dst, qs, codeN, qst}, shm);
    }
}
__device__ __forceinline__ void fox_norm_unit(const f16* qb_, const f16* kb_, float* qn2, float* qdmin, gu32* kn2, LAS unsigned char* lds) {
    const int tid = opaque_tid(); const int t = tid & 255; const bool isq = tid < 256;
    const f16* rp = (isq ? qb_ : kb_) + (size_t)t * HD; const f16* kp = kb_ + (size_t)t * HD;
    float s = 0.f, d = 0.f;
#pragma unroll
    for (int c = 0; c < 8; ++c) { const h8 x = *(const h8*)(rp + 8 * c); const h8 y = *(const h8*)(kp + 8 * c);
#pragma unroll
        for (int e = 0; e < 8; ++e) { s += (float)x[e] * (float)x[e]; d += (float)x[e] * (float)y[e]; } }
#pragma unroll
    for (int o = 1; o < 64; o <<= 1) { s = fmaxf(s, __shfl_xor(s, o)); d = fminf(d, __shfl_xor(d, o)); }
    LAS float* red = (LAS float*)lds;
    __syncthreads();
    if ((tid & 63) == 0) { red[tid >> 6] = s; red[8 + (tid >> 6)] = d; }
    __syncthreads();
    if (tid == 0) { *qn2 = fmaxf(fmaxf(red[0], red[1]), fmaxf(red[2], red[3])); *qdmin = fminf(fminf(red[8], red[9]), fminf(red[10], red[11])); }
    if (tid == 256) (void)__hip_atomic_fetch_max(kn2, __float_as_uint(fmaxf(fmaxf(red[4], red[5]), fmaxf(red[6], red[7]))), __ATOMIC_RELAXED, __HIP_MEMORY_SCOPE_AGENT);
}
__device__ __forceinline__ void kbar_block(const f16* kslot, f16* kimg, int unit, int lane) {
    const int kg = lane >> 3, dc = lane & 7;
    const f16* kp = kslot + ((size_t)(unit >> 6) * SEQ + 256 * (unit & 63)) * HD + dc * 8;
    float a[8];
#pragma unroll
    for (int e = 0; e < 8; ++e) a[e] = 0.f;
#pragma unroll 1
    for (int i0 = 0; i0 < 32; i0 += 8) {
        h8 x[8];
#pragma unroll
        for (int i = 0; i < 8; ++i) x[i] = *(const h8*)(kp + (size_t)(kg + 8 * (i0 + i)) * HD);
#pragma unroll
        for (int i = 0; i < 8; ++i)
#pragma unroll
            for (int e = 0; e < 8; ++e) a[e] += (float)x[i][e]; }
#pragma unroll
    for (int e = 0; e < 8; ++e) { a[e] += __shfl_xor(a[e], 8); a[e] += __shfl_xor(a[e], 16); a[e] += __shfl_xor(a[e], 32); }
    if (kg == 0) {
        h8 hi8, lo8;
#pragma unroll
        for (int e = 0; e < 8; ++e) { const float mval = a[e] * (1.f / 256.f); const f16 hh = (f16)mval; hi8[e] = hh; lo8[e] = (f16)((mval - (float)hh) * 4096.f); }
        f16* ib = kimg + (size_t)(unit >> 6) * 8192 + dc * 512 + (unit & 63) * 8;
        *(h8*)ib = hi8; *(h8*)(ib + 4096) = lo8;
    }
}
__device__ __forceinline__ void scan_bh(const float* logf, float* c, LAS unsigned char* lds) {
    const int tid = opaque_tid(), lane = tid & 63, wid = tid >> 6;
    LAS double* wsum = (LAS double*)lds;
    float x[32]; double run = 0.0;
#pragma unroll
    for (int i = 0; i < 8; ++i) { const f32x4 v = *(const f32x4*)(logf + tid * 32 + 4 * i); x[4 * i] = v[0]; x[4 * i + 1] = v[1]; x[4 * i + 2] = v[2]; x[4 * i + 3] = v[3]; }
#pragma unroll
    for (int i = 0; i < 32; ++i) run += (double)x[i];
    double inc = run;
#pragma unroll
    for (int o = 1; o < 64; o <<= 1) { const double y = __shfl_up(inc, o); if (lane >= o) inc += y; }
    __syncthreads();
    if (lane == 63) wsum[wid] = inc;
    __syncthreads();
    double base = inc - run;
    for (int w = 0; w < wid; ++w) base += wsum[w];
    double acc = base;
#pragma unroll
    for (int i = 0; i < 8; ++i) { f32x4 o;
#pragma unroll
        for (int j = 0; j < 4; ++j) { acc += (double)x[4 * i + j]; o[j] = (float)(acc * (double)LOG2E); }
        *(f32x4*)(c + tid * 32 + 4 * i) = o; }
    __syncthreads();
}

#ifndef YF16
#define YF16 1
#endif
#if YF16
typedef f16 ytype;
#else
typedef float ytype;
#endif
template <int NR> __device__ __forceinline__ void norm_rows(const float* xin, const ytype* y, float* xout, f16* h, const float* gpost, const float* gpre, size_t rstride, int lane) {
#if YF16
    f32x4 xv[NR][4]; h4 yw[NR][4];
#else
    f32x4 xv[NR][4]; f32x4 yw[NR][4];
#endif
#pragma unroll
    for (int k = 0; k < NR; ++k)
#pragma unroll
        for (int j = 0; j < 4; ++j) { xv[k][j] = *(const f32x4*)(xin + k * rstride + 4 * lane + 256 * j);
#if YF16
            yw[k][j] = *(const h4*)(y + k * rstride + 4 * lane + 256 * j); }
#else
            yw[k][j] = *(const f32x4*)(y + k * rstride + 4 * lane + 256 * j); }
#endif
    f32x4 gp[4];
#pragma unroll
    for (int j = 0; j < 4; ++j) gp[j] = *(const f32x4*)(gpost + 4 * lane + 256 * j);
#pragma unroll
    for (int k = 0; k < NR; ++k) {
        f32x4 yv[4]; float ss = 0.f;
#pragma unroll
        for (int j = 0; j < 4; ++j) {
#if YF16
            yv[j] = (f32x4){(float)yw[k][j][0], (float)yw[k][j][1], (float)yw[k][j][2], (float)yw[k][j][3]};
#else
            yv[j] = yw[k][j];
#endif
            ss += (yv[j][0] * yv[j][0] + yv[j][1] * yv[j][1]) + (yv[j][2] * yv[j][2] + yv[j][3] * yv[j][3]); }
        const float rs = 1.f / sqrtf(wave_sum(ss) * (1.f / DM) + RMS_EPS);
        float s2 = 0.f;
#pragma unroll
        for (int j = 0; j < 4; ++j) { xv[k][j] = xv[k][j] + yv[j] * rs * gp[j]; *(f32x4*)(xout + k * rstride + 4 * lane + 256 * j) = xv[k][j];
            s2 += (xv[k][j][0] * xv[k][j][0] + xv[k][j][1] * xv[k][j][1]) + (xv[k][j][2] * xv[k][j][2] + xv[k][j][3] * xv[k][j][3]); }
        if (gpre) {
            const float r2 = 1.f / sqrtf(wave_sum(s2) * (1.f / DM) + RMS_EPS);
#pragma unroll
            for (int j = 0; j < 4; ++j) { const f32x4 gq = *(const f32x4*)(gpre + 4 * lane + 256 * j); const f32x4 hv = xv[k][j] * r2 * gq;
                u32x2 w; w.x = pkh(hv[0], hv[1]); w.y = pkh(hv[2], hv[3]); *(u32x2*)(h + k * rstride + 4 * lane + 256 * j) = w; }
        }
    }
}
__device__ __forceinline__ void norm0_row(const float* xin, f16* h, const float* gpre, int lane) {
    f32x4 xv[4]; float s2 = 0.f;
#pragma unroll
    for (int j = 0; j < 4; ++j) { xv[j] = *(const f32x4*)(xin + 4 * lane + 256 * j); s2 += (xv[j][0] * xv[j][0] + xv[j][1] * xv[j][1]) + (xv[j][2] * xv[j][2] + xv[j][3] * xv[j][3]); }
    const float r2 = 1.f / sqrtf(wave_sum(s2) * (1.f / DM) + RMS_EPS);
#pragma unroll
    for (int j = 0; j < 4; ++j) { const f32x4 gq = *(const f32x4*)(gpre + 4 * lane + 256 * j); const f32x4 hv = xv[j] * r2 * gq;
        u32x2 w; w.x = pkh(hv[0], hv[1]); w.y = pkh(hv[2], hv[3]); *(u32x2*)(h + 4 * lane + 256 * j) = w; }
}

struct RmId { __device__ __forceinline__ int operator()(int n) const { return n; } };
struct RmGate { int off; __device__ __forceinline__ int operator()(int n) const { return (n >> 7) * 256 + off + (n & 127); } };
__device__ __forceinline__ int slot_row(int hs, int d) { return (hs >> 2) * 256 + (d >> 5) * 128 + (hs & 3) * 32 + (d & 31); }
struct RmIn0 { __device__ __forceinline__ int operator()(int n) const {
    int hs, d;
    if (n < 1536) { hs = n >> 6; d = n & 63; }
    else if (n < 1544) { hs = 38; d = n - 1536; }
    else if (n < 2056) { hs = 24 + ((n - 1544) >> 6); d = (n - 1544) & 63; }
    else if (n < 2184) { hs = 32 + ((n - 2056) >> 6); d = (n - 2056) & 63; }
    else if (n < 2312) { hs = 40 + ((n - 2184) >> 6); d = (n - 2184) & 63; }
    else if (n < 2440) { hs = 34 + ((n - 2312) >> 6); d = (n - 2312) & 63; }
    else if (n < 2568) { hs = 42 + ((n - 2440) >> 6); d = (n - 2440) & 63; }
    else if (n < 2696) { hs = 36 + ((n - 2568) >> 6); d = (n - 2568) & 63; }
    else if (n < 2824) { hs = 44 + ((n - 2696) >> 6); d = (n - 2696) & 63; }
    else { hs = 38; d = 8 + (n - 2824); }
    return slot_row(hs, d); } };
struct RmIn1 { __device__ __forceinline__ int operator()(int n) const { return slot_row(n >> 6, n & 63); } };
template <class RM> __device__ __forceinline__ void transpose_item(const float* W, int K, int N, f16* WT, const RM rm, LAS float* scr, int item, int lane) {
    const int nblk = N / 32, kb = item / nblk, nb = item % nblk, k0 = 64 * kb, n0 = 32 * nb;
    float wv[32];
#pragma unroll
    for (int i = 0; i < 32; ++i) { const int kk = 2 * i + (lane >> 5); wv[i] = W[(size_t)(k0 + kk) * N + n0 + (lane & 31)]; }
#pragma unroll
    for (int i = 0; i < 32; ++i) { const int kk = 2 * i + (lane >> 5); scr[kk * 33 + (lane & 31)] = wv[i]; }
    LDS_WAIT(); asm volatile("" ::: "memory");
    const int c = lane & 7;
#pragma unroll
    for (int j = 0; j < 4; ++j) { const int n = (lane >> 3) + 8 * j; const LAS float* s = scr + (8 * c) * 33 + n;
        u32x4 o; o.x = pkh(s[0 * 33], s[1 * 33]); o.y = pkh(s[2 * 33], s[3 * 33]); o.z = pkh(s[4 * 33], s[5 * 33]); o.w = pkh(s[6 * 33], s[7 * 33]);
        *(u32x4*)(WT + (size_t)rm(n0 + n) * K + k0 + 8 * c) = o; }
    LDS_WAIT(); asm volatile("" ::: "memory");
}

constexpr int N_PHASES = 27;
struct Args { const float* in[19]; float* out; unsigned char* ws; int ph_lo, ph_hi, rep, pad; };
static_assert(sizeof(Args) == 184 && offsetof(Args, out) == 152 && offsetof(Args, ws) == 160 && offsetof(Args, ph_lo) == 168, "kernarg offsets used by arg_in()");
__device__ __forceinline__ int q_next(gu32* ctr, volatile LAS int* slot, int) {
    __syncthreads();
    if (threadIdx.x == 0) *slot = (int)__hip_atomic_fetch_add(ctr, 1u, __ATOMIC_RELAXED, __HIP_MEMORY_SCOPE_AGENT);
    __syncthreads();
    return *slot;
}
__device__ __forceinline__ const float* arg_in(int k) { const CAS char* kp = (const CAS char*)__builtin_amdgcn_kernarg_segment_ptr(); asm volatile("" : "+s"(kp)); return *(const float* const CAS*)(kp + 8 * k); }
__device__ __forceinline__ f16* slot_ptr(unsigned char* ws, int slot, int b) { return (f16*)(ws + WS_PROJ) + ((size_t)slot * NB + b) * SEQ * HD; }

__global__ void __launch_bounds__(512, 2) trunk_fwd(Args args) {
    extern __shared__ __attribute__((aligned(16))) unsigned char lds_raw[];
    LAS unsigned char* lds = (LAS unsigned char*)lds_raw;
    volatile LAS unsigned* MISC = (volatile LAS unsigned*)(lds + L_MISC);
    volatile LAS int* qslot = (volatile LAS int*)(lds + L_MISC);
    const int G = gridDim.x, bid = blockIdx.x, NGW = G * 8;
    const int qrep = 8 * ((const CAS int*)__builtin_amdgcn_kernarg_segment_ptr())[44];
    unsigned char* ws_ = (unsigned char*)arg_in(20);
    gu32* ctl = (gu32*)(ws_ + WS_CTL);
#define PH_LOCALS unsigned char* ws = ws_; asm volatile("" : "+s"(ws)); const int tid = opaque_tid(), lane = tid & 63; const int wave = __builtin_amdgcn_readfirstlane(tid >> 6); const int gw = bid * 8 + wave; \
    f16* Hb = (f16*)(ws + WS_H); f16* Ob = (f16*)(ws + WS_O); ytype* Yh = (ytype*)(ws + WS_Y); f16* PROJ = (f16*)(ws + WS_PROJ); f16* HID = (f16*)(ws + WS_PROJ); \
    (void)tid; (void)lane; (void)wave; (void)gw; (void)Hb; (void)Ob; (void)Yh; (void)PROJ; (void)HID
    if (threadIdx.x < 64) MISC[threadIdx.x] = 0u;
    __syncthreads();
    XcdBarrier bar; bar.bar = (unsigned*)(ctl + CW_BAR); bar.x = 0; bar.st = nullptr;
    if (N_LAUNCH_MODE) bar = xcd_barrier_post((unsigned*)(ctl + CW_BAR), MISC + 8);
    const int lo = ((const CAS int*)__builtin_amdgcn_kernarg_segment_ptr())[42], hi_ = ((const CAS int*)__builtin_amdgcn_kernarg_segment_ptr())[43];
#ifndef PH_MASK
#define PH_MASK 0x3FFu
#endif
#define IN(k) (lo <= (k) && (k) < hi_)
#define INR(r) (IN(pb + (r)))
#define SNAKE(i) ((i) * G + (((i) & 1) ? (G - 1 - bid) : bid))
#define SEAM(k) do { if (IN(k) && IN((k) + 1)) xcd_barrier(bar); } while (0)

    (void)args;

    if (IN(0)) {
        PH_LOCALS;
        LAS float* scr = (LAS float*)(lds + wave * 16384);
        constexpr int I_IN0 = 16 * 89, I_OUT = 16 * 32, I_IN1 = 16 * 96, I_GU = 16 * 88, I_DN = 44 * 32, I_C1 = 32 * 8, I_C2 = 4 * 2;
        constexpr int E0 = I_IN0, E1 = E0 + I_OUT, E2 = E1 + I_IN1, E3 = E2 + I_OUT, E4 = E3 + 4 * I_GU, E5 = E4 + 2 * I_DN, E6 = E5 + 2 * I_C1, E7 = E6 + 2 * I_C2;
        constexpr int Z0 = E7 + 224, Z1 = Z0 + 384, R0 = Z1 + (SEQ * 32) / 64, NBI = 64, CB = R0 + NBI;
        constexpr int SC = CB - E7;
        for (int itr = gw; itr < CB; itr += NGW) {
            const int it = itr < NBI ? R0 + itr : (itr < NBI + (R0 - Z1) ? Z1 + (itr - NBI) : (itr < SC ? E7 + (itr - NBI - (R0 - Z1)) : itr - SC));
            if (it < E0) { transpose_item(arg_in(1), 1024, EVEN_IN, (f16*)(ws + WS_W_IN0), RmIn0{}, scr, it, lane); }
            else if (it < E1) { transpose_item(arg_in(9), 1024, 1024, (f16*)(ws + WS_W_OUT0), RmId{}, scr, it - E0, lane); }
            else if (it < E2) { transpose_item(arg_in(10), 1024, 3072, (f16*)(ws + WS_W_IN1), RmIn1{}, scr, it - E1, lane); }
            else if (it < E3) { transpose_item(arg_in(11), 1024, 1024, (f16*)(ws + WS_W_OUT1), RmId{}, scr, it - E2, lane); }
            else if (it < E4) { const int r = it - E3, w = r / I_GU, i = r % I_GU; const int layer = w >> 1, up = w & 1;
                transpose_item(arg_in(up ? 17 : 16) + (size_t)layer * 1024 * FF, 1024, FF, (f16*)(ws + (layer ? WS_W_GU1 : WS_W_GU0)), RmGate{up * 128}, scr, i, lane); }
            else if (it < E5) { const int r = it - E4, layer = r / I_DN, i = r % I_DN;
                transpose_item(arg_in(18) + (size_t)layer * FF * 1024, FF, 1024, (f16*)(ws + (layer ? WS_W_DN1 : WS_W_DN0)), RmId{}, scr, i, lane); }
            else if (it < E6) { const int r = it - E5, w = r / I_C1, i = r % I_C1;
                transpose_item(arg_in(w ? 7 : 4), 2048, 256, (f16*)(ws + (w ? WS_W_C1V : WS_W_C1K)), RmId{}, scr, i, lane); }
            else if (it < E7) { const int r = it - E6, w = r / I_C2, i = r % I_C2;
                transpose_item(arg_in(w ? 8 : 5), 256, 64, (f16*)(ws + (w ? WS_W_C2V : WS_W_C2K)), RmId{}, scr, i, lane); }
            else if (it < Z0) { const int r = it - E7; int row;
                if (r < 32) row = slot_row(38, 32 + r); else if (r < 96) row = slot_row(39, r - 32); else if (r < 160) row = slot_row(46, r - 96); else row = slot_row(47, r - 160);
                u32x4 z = {0u, 0u, 0u, 0u}; u32x4* p = (u32x4*)((f16*)(ws + WS_W_IN0) + (size_t)row * 1024); p[lane] = z; p[lane + 64] = z; }
            else if (it < Z1) { const int r = it - Z0, w = r / 192, row = 64 + r % 192;
                if (lane < 32) ((u32x4*)((f16*)(ws + (w ? WS_W_C2V : WS_W_C2K)) + (size_t)row * 256))[lane] = (u32x4){0u, 0u, 0u, 0u}; }
            else if (it < R0) { const int e = (it - Z1) * 64 + lane; const int pos = e >> 5, i = e & 31;
                constexpr float INVF[32] = {1.000000000e+00f, 7.498942018e-01f, 5.623413324e-01f, 4.216965139e-01f, 3.162277639e-01f, 2.371373773e-01f, 1.778279394e-01f, 1.333521456e-01f, 1.000000015e-01f, 7.498942316e-02f, 5.623413250e-02f, 4.216964915e-02f, 3.162277490e-02f, 2.371373773e-02f, 1.778279431e-02f, 1.333521400e-02f, 9.999999776e-03f, 7.498942316e-03f, 5.623413250e-03f, 4.216964822e-03f, 3.162277630e-03f, 2.371373819e-03f, 1.778279431e-03f, 1.333521446e-03f, 1.000000047e-03f, 7.498941850e-04f, 5.623413017e-04f, 4.216965172e-04f, 3.162277571e-04f, 2.371373703e-04f, 1.778279402e-04f, 1.333521504e-04f};
                const float ang = (float)pos * INVF[i];
                const double a_ = (double)ang, kk_ = rint(a_ * 0.15915494309189535); double r_ = fma(-kk_, 6.283185307179586, a_); r_ = fma(-kk_, 2.4492935982947064e-16, r_);
                const float rf_ = (float)r_;
                ((float*)(ws + WS_COS))[e] = cosf(rf_); ((float*)(ws + WS_SIN))[e] = sinf(rf_); }
            else { const int r = it - R0, part = r >> 3, w = (r >> 2) & 1, n = (r & 3) * 64 + lane;
                const float* pe = arg_in(w ? 6 : 3) + 256 * part; const float* w1 = arg_in(w ? 7 : 4) + (size_t)256 * part * 256; float sa[8];
#pragma unroll
                for (int i = 0; i < 8; ++i) sa[i] = 0.f;
                for (int k = 0; k < 256; k += 8) {
#pragma unroll
                    for (int i = 0; i < 8; ++i) sa[i] += pe[k + i] * w1[(size_t)(k + i) * 256 + n]; }
                ((float*)(ws + WS_CBIAS))[part * 512 + w * 256 + n] = ((sa[0] + sa[1]) + (sa[2] + sa[3])) + ((sa[4] + sa[5]) + (sa[6] + sa[7])); }
        }
        const float* xin0 = arg_in(0); const float* g0p = arg_in(12);
        for (int m = gw; m < MROWS / 2; m += NGW) { norm0_row(xin0 + (size_t)m * DM, Hb + (size_t)m * DM, g0p, lane); norm0_row(xin0 + (size_t)(m + MROWS / 2) * DM, Hb + (size_t)(m + MROWS / 2) * DM, g0p, lane); }
    }
    SEAM(0);

    for (int layer = 0; layer < 2; ++layer) {
        const int pb = 1 + 14 * layer;
        const int ro = layer == 0 ? 9 : 7;
        if (INR(0)) {
            PH_LOCALS;
            pg8::Gemm g{Hb, (const f16*)(ws + (layer ? WS_W_IN1 : WS_W_IN0)), 1024, 1024}; pg8::StaticOrder S; S.init(MROWS, NIN, G, bid);
            pg8::EpiInProj E{PROJ, (const float*)(ws + WS_COS), (const float*)(ws + WS_SIN), (float*)(ws + WS_LOGF), (float*)(ws + WS_GATES), arg_in(2), layer};
            pg8::gemm_phase<pg8::EpiInProj, pg8::StaticOrder, true>(lds, g, S, E);
        }
        SEAM(pb);
        if (layer == 0) {
            if (INR(1)) {
                PH_LOCALS;
                if (bid < 16) scan_bh((const float*)(ws + WS_LOGF) + (size_t)bid * SEQ, (float*)(ws + WS_C) + (size_t)bid * SEQ, lds);
                for (int u = bid; u < 1024; u += G) { const int bh = u >> 6, blk = u & 63, b = bh >> 3, h = bh & 7;
                    fox_norm_unit(slot_ptr(ws, h, b) + (size_t)256 * blk * HD, slot_ptr(ws, 8 + h, b) + (size_t)256 * blk * HD, (float*)(ws + WS_QN2) + u, (float*)(ws + WS_QN2) + 1024 + u, ctl + CW_KN2 + bh, lds); }
            }
            SEAM(pb + 1);
            if (INR(2)) {
                PH_LOCALS;
                if (bid < 32) {
                    const int which = bid >> 4, pm = bid & 15;
                    int c1k = 2048, c1lda = 1024, c2k = 256; asm volatile("" : "+s"(c1k), "+s"(c1lda), "+s"(c2k));
                    f16* hid = (f16*)(ws + (which ? WS_HIDV : WS_HIDK));
                    { pg8::Gemm g{slot_ptr(ws, which ? 38 : 32, 0), (const f16*)(ws + (which ? WS_W_C1V : WS_W_C1K)), c1lda, c1k}; pg8::SingleOrder S{{pm, 0}, G > 0 ? 1 : 0};
                      pg8::EpiCmp1 E{hid, (const float*)(ws + WS_CBIAS) + which * 256};
                      pg8::gemm_phase<pg8::EpiCmp1, pg8::SingleOrder, false>(lds, g, S, E); }
                    VM_WAIT(); __syncthreads(); __builtin_amdgcn_fence(__ATOMIC_ACQUIRE, "agent"); VM_WAIT(); __syncthreads();
                    { pg8::Gemm g{hid, (const f16*)(ws + (which ? WS_W_C2V : WS_W_C2K)), c2k, c2k}; pg8::SingleOrder S{{pm, 0}, G > 0 ? 1 : 0};
                      pg8::EpiCmp2 E{(f16*)(ws + (which ? WS_VCMP : WS_KCMP))};
                      pg8::gemm_phase<pg8::EpiCmp2, pg8::SingleOrder, false>(lds, g, S, E); }
                }
                ((LAS unsigned*)(lds + L_SEL))[opaque_tid() & 7] = 0xFFFFFFFFu;
                for (int u = q_next(ctl + CW_Q + qrep, qslot, tid); u < 1024; u = q_next(ctl + CW_Q + qrep, qslot, tid)) {
                    const int qt = 255 - (u >> 2), b = (u & 3) >> 1, g = u & 1; const int tq = opaque_tid(); const int wv = __builtin_amdgcn_readfirstlane(tq >> 6);
                    const int hd = 4 * g + (wv >> 1), ql = 32 * (wv & 1) + (tq & 31);
                    const int t0 = qt >= 8 ? qt - 8 : 0;
                    fa::unit_sel<8, fa::EpiWinGate>(slot_ptr(ws, 24 + hd, b) + (size_t)(64 * qt + ql) * HD, slot_ptr(ws, 36 + g, b) + (size_t)t0 * 64 * HD, slot_ptr(ws, 42 + g, b) + (size_t)t0 * 64 * HD,
                        (const LAS unsigned*)(lds + L_SEL), qt - t0, ql, qt >= 8,
                        fa::EpiWinGate{(const float*)(ws + WS_GATES), Ob, b, hd, 64 * qt + 32 * (wv & 1)}, (char*)lds_raw);
                }
                for (int u = q_next(ctl + CW_Q + 64 + qrep, qslot, tid); u < 1024; u = q_next(ctl + CW_Q + 64 + qrep, qslot, tid)) {
                    const int qb = 63 - (u >> 4), b = (u & 15) >> 3, h = u & 7; const int tq = opaque_tid(); const int wv = __builtin_amdgcn_readfirstlane(tq >> 6); const int row = 256 * qb + 32 * wv + (tq & 31);
                    const float* cbh = (const float*)(ws + WS_C) + ((size_t)b * 8 + h) * SEQ;
                    int t0 = 0;
                    { const float bnd = sqrtf(((const float*)(ws + WS_QN2))[((b * 8 + h) << 6) + qb] * __uint_as_float(__hip_atomic_load(ctl + CW_KN2 + b * 8 + h, __ATOMIC_RELAXED, __HIP_MEMORY_SCOPE_AGENT)))
                                        - ((const float*)(ws + WS_QN2))[1024 + ((b * 8 + h) << 6) + qb] + 1.f;
                      const float cq0 = cbh[256 * qb]; const int ln = tq & 63; int cntv = 0;
#pragma unroll
                      for (int i = 0; i < 4; ++i) { const int tt = ln + 64 * i; const bool sk = (tt < 4 * qb) && (bnd + cq0 - cbh[64 * tt + 63] < -40.f); cntv += __popcll(__ballot(sk)); }
                      t0 = __builtin_amdgcn_readfirstlane(cntv) & ~1; }
                    fa::unit<8, true, true, fa::EpiPlain>(slot_ptr(ws, h, b) + (size_t)row * HD, slot_ptr(ws, 8 + h, b) + (size_t)t0 * 64 * HD, slot_ptr(ws, 16 + h, b) + (size_t)t0 * 64 * HD, cbh + row, cbh + 64 * t0, 4 * qb + 4 - t0, fa::QREL_ROW,
                                      fa::EpiPlain{Ob + ((size_t)b * SEQ + 256 * qb + 32 * wv) * DM + h * HD, DM}, (char*)lds_raw);
                }
            }
            SEAM(pb + 2);
            if (INR(3)) {
                PH_LOCALS;
                for (int i = 0, u; (u = SNAKE(i)) < 1024; ++i) {
                    __syncthreads();
                    nsa_cmp_unit(PROJ, (const f16*)(ws + WS_KCMP), (const f16*)(ws + WS_VCMP), (const float*)(ws + WS_GATES), Ob, (unsigned*)(ws + WS_SLIST) + (size_t)((u & 3)) * SL_BG, ctl + CW_SCNT + 256 * (u & 3), (u & 3) >> 1, u & 1, 255 - (u >> 2), lds, (char*)lds_raw);
                }
            }
            SEAM(pb + 3);
            for (int stp = 0; stp < 5; ++stp) {
                if (INR(4 + stp)) {
                    PH_LOCALS;
                    if (stp >= 1) { const int mr = stp - 1;
                    for (int u = bid; u < 256; u += G) {
                            SelMergeF f; f.proj = PROJ; f.PO = (const unsigned char*)(ws + WS_SPO) + (size_t)(mr & 1) * SPO_STRIDE; f.PML = (const float*)(ws + WS_SPML + (size_t)(mr & 1) * SPML_STRIDE); f.gates = (const float*)(ws + WS_GATES); f.O = Ob;
                            f.b = mr >> 1; f.g = mr & 1; f.qt = 255 - u; f.nsl = f.qt - 2 < 0 ? 0 : (f.qt - 2 > 13 ? 13 : f.qt - 2);
                            attn_unit(f, lds);
                        }
                        }
                    if (stp <= 3) { const int rnd = stp; const int b = rnd >> 1, g = rnd & 1;
                        LAS int* pref = (LAS int*)(lds + 102400);
                        __syncthreads();
                        if (tid < 256) { const int n = (tid >= 1 && tid <= 253) ? (int)__hip_atomic_load(ctl + CW_SCNT + 256 * rnd + tid, __ATOMIC_RELAXED, __HIP_MEMORY_SCOPE_AGENT) : 0; pref[tid + 1] = (n + PIECE - 1) / PIECE; }
                        if (tid == 0) pref[0] = 0;
                        __syncthreads();
                        for (int st = 1; st < 256; st <<= 1) { int v = 0; if (tid < 256 && tid + 1 > st) v = pref[tid + 1 - st]; __syncthreads(); if (tid < 256 && tid + 1 > st) pref[tid + 1] += v; __syncthreads(); }
                        const int nunits = pref[256];
                        for (int u = q_next(ctl + CW_Q + 512 + 64 * rnd + qrep, qslot, tid); u < nunits; u = q_next(ctl + CW_Q + 512 + 64 * rnd + qrep, qslot, tid)) {
                            int lo_ = 0, hi2 = 255;
                            while (lo_ < hi2) { const int mid = (lo_ + hi2 + 1) >> 1; if (pref[mid] <= u) lo_ = mid; else hi2 = mid - 1; }
                            const int j = lo_, piece = u - pref[j];
                            const int n = (int)__hip_atomic_load(ctl + CW_SCNT + 256 * rnd + j, __ATOMIC_RELAXED, __HIP_MEMORY_SCOPE_AGENT);
                            const int cnt = (n - PIECE * piece) < PIECE ? (n - PIECE * piece) : PIECE;
                            sel_gather_unit(PROJ, b, g, j, (const unsigned*)(ws + WS_SLIST) + (size_t)rnd * SL_BG + sl_off(j) + PIECE * piece, cnt, (unsigned char*)(ws + WS_SPO) + (size_t)(rnd & 1) * SPO_STRIDE, (float*)(ws + WS_SPML + (size_t)(rnd & 1) * SPML_STRIDE), lds);
                        }
                        }
                }
                SEAM(pb + 4 + stp);
            }
        } else {
            if (INR(1)) { PH_LOCALS; for (int u = gw; u < 2048; u += NGW) kbar_block(slot_ptr(ws, 16, 0), (f16*)(ws + WS_KBAR), u, lane); }
            SEAM(pb + 1);
            if (INR(2)) { PH_LOCALS; for (int u = bid; u < 2048; u += G) moba_gate_unit(slot_ptr(ws, 0, 0), (const f16*)(ws + WS_KBAR), (unsigned short*)(ws + WS_LISTS), ctl + CW_LCNT, u, lds); }
            SEAM(pb + 2);
            for (int half = 0; half < 2; ++half) {
                if (INR(3 + 2 * half)) {
                    PH_LOCALS;
                    for (int u = q_next(ctl + CW_Q + 256 + 64 * half + qrep, qslot, tid); u < 63 * 16; u = q_next(ctl + CW_Q + 256 + 64 * half + qrep, qslot, tid)) {
                        const int j = u >> 4, hh = u & 15, bh = hh * 2 + half;
                        const int n = (int)__hip_atomic_load(ctl + CW_LCNT + bh * 64 + j, __ATOMIC_RELAXED, __HIP_MEMORY_SCOPE_AGENT);
                        const unsigned short* ent = (const unsigned short*)(ws + WS_LISTS) + (size_t)bh * LIST_BH + list_off(j);
                        const f16* qs = slot_ptr(ws, 0, 0) + (size_t)bh * SEQ * HD; const f16* ks = slot_ptr(ws, 16, 0) + ((size_t)bh * SEQ + 256 * j) * HD; const f16* vs = slot_ptr(ws, 32, 0) + ((size_t)bh * SEQ + 256 * j) * HD;
                        moba_gather_unit3(qs, ks, vs, ent, n, hh, (f16*)(ws + WS_PO), (float*)(ws + WS_PML), lds, (char*)lds_raw);
                    }
                }
                SEAM(pb + 3 + 2 * half);
                if (INR(4 + 2 * half)) {
                    PH_LOCALS;
                    for (int i = 0, u; (u = SNAKE(i)) < 1024; ++i) {
                        __syncthreads();
                        const int qb = u >> 4, hh = u & 15, bh = hh * 2 + half; const int tq = opaque_tid(); const int wv = __builtin_amdgcn_readfirstlane(tq >> 6); const int row = 256 * qb + 32 * wv + (tq & 31);
                        const f16* ks = slot_ptr(ws, 16, 0) + ((size_t)bh * SEQ + 256 * qb) * HD; const f16* vs = slot_ptr(ws, 32, 0) + ((size_t)bh * SEQ + 256 * qb) * HD;
                        fa::unit<8, false, true, fa::EpiMerge>(slot_ptr(ws, 0, 0) + ((size_t)bh * SEQ + row) * HD, ks, vs, nullptr, nullptr, 4, fa::QREL_ROW,
                            fa::EpiMerge{(const f16*)(ws + WS_PO), (const float*)(ws + WS_PML), (size_t)hh * SEQ + 256 * qb + 32 * wv, qb < 3 ? qb : 3, Ob + ((size_t)half * SEQ + 256 * qb + 32 * wv) * DM + hh * HD, DM}, (char*)lds_raw);
                    }
                }
                SEAM(pb + 4 + 2 * half);
            }
        }
        if (INR(ro)) {
            PH_LOCALS;
            pg8::Gemm g{Ob, (const f16*)(ws + (layer ? WS_W_OUT1 : WS_W_OUT0)), 1024, 1024}; pg8::StaticOrder S; S.init(MROWS, DM, G, bid);

#if YF16
            pg8::EpiF16 E{Yh, DM};
            pg8::gemm_phase<pg8::EpiF16, pg8::StaticOrder, true>(lds, g, S, E);
#else
            pg8::EpiF32 E{Yh, DM};
            pg8::gemm_phase<pg8::EpiF32, pg8::StaticOrder, true>(lds, g, S, E);
#endif
        }
        SEAM(pb + ro);
        if (INR(ro + 1)) {
            PH_LOCALS;
            float* xres = (float*)arg_in(19); const float* xsrc = layer == 0 ? arg_in(0) : xres;
            for (int m = gw; m < MROWS / 2; m += NGW) norm_rows<2>(xsrc + (size_t)m * DM, Yh + (size_t)m * DM, xres + (size_t)m * DM, Hb + (size_t)m * DM, arg_in(13) + layer * DM, arg_in(14) + layer * DM, (size_t)(MROWS / 2) * DM, lane);
        }
        SEAM(pb + ro + 1);
        if (INR(ro + 2)) {
            PH_LOCALS;
            pg8::Gemm g{Hb, (const f16*)(ws + (layer ? WS_W_GU1 : WS_W_GU0)), 1024, 1024}; pg8::StaticOrder S; S.init(MROWS, 2 * FF, G, bid);
            pg8::EpiSwiGLU E{HID};
            pg8::gemm_phase<pg8::EpiSwiGLU, pg8::StaticOrder, true>(lds, g, S, E);
        }
        SEAM(pb + ro + 2);
        if (INR(ro + 3)) {
            PH_LOCALS;
            pg8::Gemm g{HID, (const f16*)(ws + (layer ? WS_W_DN1 : WS_W_DN0)), FF, FF}; pg8::StaticOrder S; S.init(MROWS, DM, G, bid);

#if YF16
            pg8::EpiF16 E{Yh, DM};
            pg8::gemm_phase<pg8::EpiF16, pg8::StaticOrder, true>(lds, g, S, E);
#else
            pg8::EpiF32 E{Yh, DM};
            pg8::gemm_phase<pg8::EpiF32, pg8::StaticOrder, true>(lds, g, S, E);
#endif
        }
        SEAM(pb + ro + 3);
        if (INR(ro + 4)) {
            PH_LOCALS;
            float* xres = (float*)arg_in(19);
            for (int m = gw; m < MROWS / 2; m += NGW) norm_rows<2>(xres + (size_t)m * DM, Yh + (size_t)m * DM, xres + (size_t)m * DM, Hb + (size_t)m * DM, arg_in(15) + layer * DM, layer == 0 ? arg_in(12) + DM : nullptr, (size_t)(MROWS / 2) * DM, lane);
        }
        SEAM(pb + ro + 4);
    }
#undef IN
#undef SEAM
}

extern "C" void kernel_launch(void* const* d_in, const int* in_sizes, int n_in, void* d_out, int out_size, void* d_ws, size_t ws_size, hipStream_t stream) {
    static int grid = 0;
    if (grid == 0) {
        if (n_in != 19 || out_size != MROWS * DM || ws_size < WS_END) { fprintf(stderr, "kernel_launch: unexpected problem (n_in %d, out %d, ws %zu)\n", n_in, out_size, ws_size); grid = -1; return; }
        int dev = 0, cus = 0, per_cu = 0;
        if (hipGetDevice(&dev) != hipSuccess || hipDeviceGetAttribute(&cus, hipDeviceAttributeMultiprocessorCount, dev) != hipSuccess) { grid = -1; return; }
        if (hipFuncSetAttribute((const void*)trunk_fwd, hipFuncAttributeMaxDynamicSharedMemorySize, LDS_BYTES) != hipSuccess) { fprintf(stderr, "kernel_launch: hipFuncSetAttribute failed\n"); grid = -1; return; }
        if (hipOccupancyMaxActiveBlocksPerMultiprocessor(&per_cu, (const void*)trunk_fwd, 512, LDS_BYTES) != hipSuccess || per_cu < 1) fprintf(stderr, "kernel_launch: occupancy query says %d\n", per_cu);
        (void)hipGetLastError();
        grid = cus;
    }
    if (grid < 0) return;
    (void)hipMemsetAsync((char*)d_ws + WS_CTL, 0, CTL_ZERO_BYTES, stream);
    Args a{};
    for (int i = 0; i < 19; ++i) a.in[i] = (const float*)d_in[i];
    a.out = (float*)d_out; a.ws = (unsigned char*)d_ws;
#if N_LAUNCH_MODE
    a.ph_lo = 0; a.ph_hi = N_PHASES;
    hipLaunchKernelGGL(trunk_fwd, dim3(grid), dim3(512), LDS_BYTES, stream, a);
#else
    for (int p = 0; p < N_PHASES; ++p) { a.ph_lo = p; a.ph_hi = p + 1; a.rep = 0; hipLaunchKernelGGL(trunk_fwd, dim3(grid), dim3(512), LDS_BYTES, stream, a);
#ifdef REPEAT_PHASES
        if ((REPEAT_PHASES >> p) & 1) for (int r = 1; r <= 2; ++r) { a.rep = r; hipLaunchKernelGGL(trunk_fwd, dim3(grid), dim3(512), LDS_BYTES, stream, a); }
#endif
    }
#endif
}
```

```cpp
#include <hip/hip_runtime.h>
#include <cstdio>
#include <cstdint>
#include <cstddef>

#ifndef N_LAUNCH_MODE
#define N_LAUNCH_MODE 1

#endif

#define LAS __attribute__((address_space(3)))
#define GAS __attribute__((address_space(1)))
#define CAS __attribute__((address_space(4)))
typedef _Float16 f16;
typedef _Float16 h8 __attribute__((ext_vector_type(8)));
typedef _Float16 h2 __attribute__((ext_vector_type(2)));
typedef _Float16 h4 __attribute__((ext_vector_type(4)));
typedef short s16x4 __attribute__((ext_vector_type(4)));
typedef float f32x2 __attribute__((ext_vector_type(2)));
typedef float f32x4 __attribute__((ext_vector_type(4)));
typedef float f32x16 __attribute__((ext_vector_type(16)));
typedef unsigned u32x4 __attribute__((ext_vector_type(4)));
typedef unsigned u32x2 __attribute__((ext_vector_type(2)));
typedef GAS unsigned gu32;

constexpr int NB = 2, SEQ = 16384, DM = 1024, MROWS = NB * SEQ, HD = 64, FF = 2816;
constexpr int NIN = 3072;
constexpr int EVEN_IN = 2848;
constexpr float RMS_EPS = 1e-6f;
constexpr float LOG2E = 1.4426950408889634f;
constexpr float QSCALE = 0.125f * LOG2E;
constexpr float NEG_BIG = -1e30f;

constexpr size_t MiB = 1u << 20;
constexpr size_t WS_CTL = 0, CTL_ZERO_BYTES = 1 * MiB;
constexpr size_t WS_COS = 1 * MiB, WS_SIN = 3 * MiB;
constexpr size_t WS_CBIAS = 5 * MiB;
constexpr size_t WS_KBAR = 5 * MiB + 65536;
constexpr size_t WS_C = 6 * MiB;
constexpr size_t WS_LOGF = 7 * MiB;
constexpr size_t WS_W_IN0 = 8 * MiB, WS_W_OUT0 = 14 * MiB, WS_W_IN1 = 16 * MiB, WS_W_OUT1 = 22 * MiB;
constexpr size_t WS_W_GU0 = 24 * MiB, WS_W_GU1 = 35 * MiB, WS_W_DN0 = 46 * MiB, WS_W_DN1 = 46 * MiB + 5632 * 1024, WS_W_C1K = 57 * MiB, WS_W_C1V = 58 * MiB;
constexpr size_t WS_W_C2K = 59 * MiB, WS_W_C2V = 59 * MiB + 131072;
constexpr size_t WS_GATES = 60 * MiB;
constexpr size_t WS_H = 64 * MiB;
constexpr size_t WS_HIDK = WS_H, WS_HIDV = WS_H + 2 * MiB;
constexpr size_t WS_KCMP = WS_H + 4 * MiB, WS_VCMP = WS_H + 4 * MiB + 524288;
constexpr size_t WS_NSEL = WS_H + 5 * MiB;
constexpr size_t WS_LISTS = WS_H + 8 * MiB;
constexpr size_t WS_O = 128 * MiB;
constexpr size_t WS_PROJ = 192 * MiB;
constexpr size_t WS_Y = 384 * MiB;
constexpr size_t WS_OC = WS_Y, WS_OW = WS_Y + 32 * MiB;
constexpr size_t WS_PO = WS_Y, WS_PML = WS_Y + 96 * MiB;
constexpr size_t WS_SLIST = WS_H + 8 * MiB;
constexpr size_t WS_SPML = WS_H + 40 * MiB;
constexpr size_t WS_SPO = WS_Y;
constexpr size_t WS_RS = 5 * MiB + 640 * 1024;
constexpr size_t WS_END = 512 * MiB;
constexpr size_t SLOT_BYTES = (size_t)NB * SEQ * HD * 2;

constexpr int CW_BAR = 4096;
constexpr int CW_Q = 16384;
constexpr int CW_LCNT = 32768;
constexpr int CW_SCNT = 40960;
constexpr int CW_KN2 = 36864;
constexpr size_t WS_QN2 = WS_CBIAS + 32768;

constexpr int LDS_BYTES = 147456;
constexpr int L_KV = 0;
constexpr int L_OST = 32768;
constexpr int L_IMP = 65536;
constexpr int L_WSF = 131072;
constexpr int L_CS = 133120;
constexpr int L_SEL = 133632;
constexpr int L_MISC = 147456 - 256;

__device__ __forceinline__ unsigned pkh(float lo, float hi) { f32x2 v = {lo, hi}; h2 b = __builtin_convertvector(v, h2); return __builtin_bit_cast(unsigned, b); }
__device__ __forceinline__ float wave_sum(float v) {
#pragma unroll
    for (int o = 1; o < 64; o <<= 1) v += __shfl_xor(v, o);
    return v;
}
__device__ __forceinline__ int opaque_tid() { int t = threadIdx.x; asm volatile("" : "+v"(t)); return t; }
__device__ __forceinline__ float fexp2(float x) { return __builtin_amdgcn_exp2f(x); }
#define MFMA32(a, b, c) __builtin_amdgcn_mfma_f32_32x32x16_f16(a, b, c, 0, 0, 0)
#define MFMA16(a, b, c) __builtin_amdgcn_mfma_f32_16x16x32_f16(a, b, c, 0, 0, 0)
#define LDS_WAIT() asm volatile("s_waitcnt lgkmcnt(0)" ::: "memory")
#define VM_WAIT() asm volatile("s_waitcnt vmcnt(0)" ::: "memory")

#define XB_TMO      128
#define XB_XCNT(j)  (256  + 64 * (j))
#define XB_XSUB(j)  (1280 + 64 * (j))
#define XB_XGEN(j)  (2304 + 64 * (j))
#define XB_TOP      3328
#define XB_TOPGEN   3392
#define XCD_BAR_WORDS 3456
#define XB_SPIN_CAP (1u << 20)
__device__ __forceinline__ unsigned xb_ld(unsigned* p)              { return __hip_atomic_load(p, __ATOMIC_RELAXED, __HIP_MEMORY_SCOPE_AGENT); }
__device__ __forceinline__ unsigned xb_add(unsigned* p, unsigned v) { return __hip_atomic_fetch_add(p, v, __ATOMIC_RELAXED, __HIP_MEMORY_SCOPE_AGENT); }
__device__ __forceinline__ unsigned xb_xcc_id() { return (unsigned)__builtin_amdgcn_s_getreg((3 << 11) | 20) & 0xFu; }
#define XB_SPIN(cond, bar) do { unsigned _sp = 0; while (cond) { __builtin_amdgcn_s_sleep(1); \
    if ((++_sp & 255u) == 0u) { if (xb_ld(&(bar)[XB_TMO])) break; if (_sp > XB_SPIN_CAP) { atomicAdd(&(bar)[XB_TMO], 1u); break; } } } } while (0)
struct XcdBarrier { unsigned* bar; unsigned x; volatile LAS unsigned* st; };
__device__ __forceinline__ XcdBarrier xcd_barrier_post(unsigned* bar, volatile LAS unsigned* st) {
    XcdBarrier b; b.bar = bar; b.x = xb_xcc_id(); b.st = st;
    if (threadIdx.x == 0) (void)xb_add(&bar[XB_XCNT(b.x)], 1u);
    return b;
}
__device__ __forceinline__ void xcd_barrier_complete(unsigned* bar, unsigned x, unsigned& nloc, unsigned& nx) {
    const unsigned G = gridDim.x * gridDim.y * gridDim.z;
    unsigned sum, cnt, mine, sp = 0u;
    for (;;) {
        sum = 0u; cnt = 0u; mine = 0u;
#pragma unroll
        for (unsigned j = 0; j < 16; ++j) { const unsigned c = xb_ld(&bar[XB_XCNT(j)]); sum += c; cnt += (c > 0u) ? 1u : 0u; mine = (j == x) ? c : mine; }
        if (sum == G) break;
        __builtin_amdgcn_s_sleep(1);
        if ((++sp & 255u) == 0u) { if (xb_ld(&bar[XB_TMO])) break; if (sp > XB_SPIN_CAP) { atomicAdd(&bar[XB_TMO], 1u); break; } }
    }
    nloc = mine > 0u ? mine : 1u; nx = cnt > 0u ? cnt : 1u;
}
__device__ __forceinline__ void xcd_barrier(const XcdBarrier& b) {
    asm volatile("s_waitcnt vmcnt(0)" ::: "memory");
    __syncthreads();
    if (threadIdx.x == 0) {
        unsigned* bar = b.bar;
        __builtin_amdgcn_s_waitcnt(0);
        unsigned nloc = b.st[0], nx = b.st[1];
        if (nloc == 0u) { xcd_barrier_complete(bar, b.x, nloc, nx); b.st[0] = nloc; b.st[1] = nx; }
        const unsigned old = xb_add(&bar[XB_XSUB(b.x)], 1u);
        const unsigned gen = old / nloc;
        if (old + 1u == (gen + 1u) * nloc) {
            __builtin_amdgcn_fence(__ATOMIC_RELEASE, "agent");
            asm volatile("s_waitcnt vmcnt(0)" ::: "memory");
            const unsigned og = xb_add(&bar[XB_TOP], 1u);
            const unsigned tg = og / nx;
            if (og + 1u == (tg + 1u) * nx) xb_add(&bar[XB_TOPGEN], 1u);
            else XB_SPIN(xb_ld(&bar[XB_TOPGEN]) == tg, bar);
            __builtin_amdgcn_fence(__ATOMIC_ACQUIRE, "agent");
            xb_add(&bar[XB_XGEN(b.x)], 1u);
            asm volatile("s_waitcnt vmcnt(0)" ::: "memory");
        } else {
            XB_SPIN(xb_ld(&bar[XB_XGEN(b.x)]) == gen, bar);
            __builtin_amdgcn_fence(__ATOMIC_ACQUIRE, "agent");
            asm volatile("s_waitcnt vmcnt(0)" ::: "memory");
        }
    }
    __syncthreads();
}

namespace pg8 {
constexpr int BM = 256, BK = 64, HALF = 128, HTB = HALF * BK * 2, NXCD = 8, WGM = 8;
__host__ __device__ __forceinline__ int lds_byte(int r, int c) { const int st = (r >> 4) * 2 + (c >> 5), rr = r & 15, cc = c & 31, ob = rr * 64 + cc * 2; return st * 1024 + (ob ^ (((ob >> 9) & 1) << 5)); }
__host__ __device__ __forceinline__ void stage_rc(int b, int& R, int& C) { const int st = b / 1024, sb = b % 1024, swz = sb ^ (((sb >> 9) & 1) << 5); R = (st >> 1) * 16 + swz / 64; C = (st & 1) * 32 + (swz % 64) / 2; }
__host__ __device__ __forceinline__ int perm32(int rho) { const int n = rho >> 4, i = rho & 15; return 8 * (i >> 2) + 4 * n + (i & 3); }
struct Unit { int pm, pn; };
struct Gemm { const f16* A; const f16* Bt; int lda, K; };
struct StaticOrder {
    int nM, nN, nwg, G, c;
    __device__ void init(int M, int N, int G_, int c_) { nM = M / BM; nN = N / BM; nwg = nM * nN; G = G_; c = c_; }
    __device__ bool next(int i, Unit& u) const {
        const long L = (long)i * G + c; if (L >= nwg) return false;
        int wgid = (int)L; { const int q = nwg / NXCD, r = nwg % NXCD, xcd = wgid % NXCD, off = wgid / NXCD; wgid = (xcd < r ? xcd * (q + 1) : r * (q + 1) + (xcd - r) * q) + off; }
        const int nig = WGM * nN, gid = wgid / nig, fm = gid * WGM, gsz = (nM - fm) < WGM ? (nM - fm) : WGM;
        u.pm = fm + ((wgid % nig) % gsz); u.pn = (wgid % nig) / gsz; return true;
    }
};
struct SingleOrder { Unit u; int n; __device__ bool next(int i, Unit& o) const { if (i >= n) return false; o = u; return true; } };

template <class Epi, class Sched, bool ALIGN_EPI>
__device__ __forceinline__ void gemm_phase(LAS unsigned char* lds, const Gemm g, const Sched& S, const Epi& E) {
    const int tid = opaque_tid(), wid = __builtin_amdgcn_readfirstlane(tid >> 6), lane = tid & 63, wr = wid >> 2, wc = wid & 3, fr = lane & 15, fq = lane >> 4;
    const int K = g.K, nt = K / BK, lda = g.lda;
    unsigned voffA[2], voffB[2];
#pragma unroll
    for (int i = 0; i < 2; ++i) { int R, C; stage_rc(tid * 16 + i * 8192, R, C); const int Rb = (R & ~31) + perm32(R & 31);
        voffA[i] = (unsigned)(R * lda + C) * 2u; voffB[i] = (unsigned)(Rb * K + C) * 2u; }
    const size_t kstep = (size_t)(BK * 2);
    const size_t hstepA = (size_t)HALF * lda * 2, tstepA = 2 * hstepA;
    const size_t hstepB = (size_t)HALF * K * 2, tstepB = 2 * hstepB;
    const unsigned ldsw = (unsigned)wid * 1024u;
    const int aoff = lds_byte(wr * 64 + fr, fq * 8), boff = lds_byte(wc * 32 + fr, fq * 8);
#define PG8_SA(b, h) (((b) * 2 + (h)) * HTB)
#define PG8_SB(b, h) ((4 + (b) * 2 + (h)) * HTB)
#define PG8_STAGE(bufoff, gbase, voff) do { _Pragma("unroll") for (int _i = 0; _i < 2; ++_i) \
        __builtin_amdgcn_global_load_lds((const unsigned*)((const char*)(gbase) + (voff)[_i]), (LAS unsigned*)(lds + (bufoff) + ldsw + _i * 8192), 16, 0, 0); } while (0)
#define PG8_LDA(dst, b, h) do { _Pragma("unroll") for (int m = 0; m < 4; ++m) _Pragma("unroll") for (int k = 0; k < 2; ++k) dst[m][k] = *(const LAS h8*)(lds + PG8_SA(b, h) + aoff + m * 2048 + k * 1024); } while (0)
#define PG8_LDB(dst, b, h) do { _Pragma("unroll") for (int n = 0; n < 2; ++n) _Pragma("unroll") for (int k = 0; k < 2; ++k) dst[n][k] = *(const LAS h8*)(lds + PG8_SB(b, h) + boff + n * 2048 + k * 1024); } while (0)
#define PG8_MMA(ai, bj, At, Bt) do { __builtin_amdgcn_s_setprio(1); _Pragma("unroll") for (int m = 0; m < 4; ++m) _Pragma("unroll") for (int n = 0; n < 2; ++n) _Pragma("unroll") for (int k = 0; k < 2; ++k) \
        acc[ai][bj][m][n] = MFMA16(Bt[n][k], At[m][k], acc[ai][bj][m][n]); __builtin_amdgcn_s_setprio(0); } while (0)
#define PG8_WAIT_V(n) asm volatile("s_waitcnt vmcnt(" #n ")" ::: "memory")
#define PG8_WAIT_L(n) asm volatile("s_waitcnt lgkmcnt(" #n ")" ::: "memory")
#define PG8_BAR __builtin_amdgcn_s_barrier()
#define PG8_SCHED __builtin_amdgcn_sched_barrier(0)
    Unit cur, nxt; int ui = 0;
    if (!S.next(0, cur)) return;
    f32x4 acc[2][2][4][2];
#pragma unroll
    for (int a = 0; a < 2; ++a)
#pragma unroll
        for (int b = 0; b < 2; ++b)
#pragma unroll
            for (int m = 0; m < 4; ++m)
#pragma unroll
                for (int n = 0; n < 2; ++n) acc[a][b][m][n] = (f32x4){0.f, 0.f, 0.f, 0.f};
    h8 At[4][2], B0[2][2], B1[2][2];
    const char* cA = (const char*)g.A + (size_t)cur.pm * tstepA; const char* cB = (const char*)g.Bt + (size_t)cur.pn * tstepB;
    PG8_STAGE(PG8_SB(0, 0), cB, voffB); PG8_STAGE(PG8_SB(0, 1), cB + hstepB, voffB); PG8_STAGE(PG8_SA(0, 0), cA, voffA); PG8_STAGE(PG8_SA(0, 1), cA + hstepA, voffA);
    if (wr == 1) PG8_BAR;
    PG8_WAIT_V(2); PG8_BAR;
    PG8_STAGE(PG8_SB(1, 0), cB + kstep, voffB); PG8_STAGE(PG8_SA(1, 0), cA + kstep, voffA); PG8_STAGE(PG8_SB(1, 1), cB + hstepB + kstep, voffB);
    PG8_WAIT_V(6); PG8_BAR;
    for (;;) {
        const bool has_next = S.next(ui + 1, nxt);
        const char* nA = has_next ? (const char*)g.A + (size_t)nxt.pm * tstepA : cA; const char* nB = has_next ? (const char*)g.Bt + (size_t)nxt.pn * tstepB : cB;
#pragma unroll 1
        for (int t = 0; t < nt; t += 2) {
            const bool last = (t == nt - 2);
            const char* a1 = cA + (size_t)(t + 1) * kstep;
            const char* a2 = last ? nA : cA + (size_t)(t + 2) * kstep; const char* b2 = last ? nB : cB + (size_t)(t + 2) * kstep;
            const char* a3 = a2 + kstep; const char* b3 = b2 + kstep;
            PG8_LDB(B0, 0, 0); PG8_LDB(B1, 0, 1); PG8_SCHED; PG8_LDA(At, 0, 0); PG8_STAGE(PG8_SA(1, 1), a1 + hstepA, voffA);
            PG8_WAIT_V(8); PG8_WAIT_L(0); PG8_BAR; PG8_MMA(0, 0, At, B0); PG8_MMA(0, 1, At, B1); PG8_BAR; PG8_SCHED;
            PG8_LDA(At, 0, 1); PG8_STAGE(PG8_SB(0, 0), b2, voffB); PG8_STAGE(PG8_SB(0, 1), b2 + hstepB, voffB); PG8_STAGE(PG8_SA(0, 0), a2, voffA);
            PG8_WAIT_V(8); PG8_WAIT_L(0); PG8_BAR; PG8_MMA(1, 0, At, B0); PG8_MMA(1, 1, At, B1); PG8_BAR; PG8_SCHED;
            PG8_LDB(B0, 1, 0); PG8_LDB(B1, 1, 1); PG8_SCHED; PG8_LDA(At, 1, 0); PG8_STAGE(PG8_SA(0, 1), a2 + hstepA, voffA);
            PG8_WAIT_V(8); PG8_WAIT_L(0); PG8_BAR; PG8_MMA(0, 0, At, B0); PG8_MMA(0, 1, At, B1); PG8_BAR; PG8_SCHED;
            PG8_LDA(At, 1, 1); PG8_STAGE(PG8_SB(1, 0), b3, voffB); PG8_STAGE(PG8_SB(1, 1), b3 + hstepB, voffB); PG8_STAGE(PG8_SA(1, 0), a3, voffA);
            PG8_WAIT_V(8); PG8_WAIT_L(0); PG8_BAR; PG8_MMA(1, 0, At, B0); PG8_MMA(1, 1, At, B1); PG8_BAR; PG8_SCHED;
        }
        if constexpr (ALIGN_EPI) { if (wr == 0) PG8_BAR; }
        E(acc, cur, wr, wc, fr, fq);
        if (!has_next) break;
#pragma unroll
        for (int a = 0; a < 2; ++a)
#pragma unroll
            for (int b = 0; b < 2; ++b)
#pragma unroll
                for (int m = 0; m < 4; ++m)
#pragma unroll
                    for (int n = 0; n < 2; ++n) acc[a][b][m][n] = (f32x4){0.f, 0.f, 0.f, 0.f};
        cur = nxt; cA = nA; cB = nB; ++ui;
        if constexpr (ALIGN_EPI) { if (wr == 1) PG8_BAR; }
    }
    PG8_WAIT_V(0);
    if constexpr (!ALIGN_EPI) { if (wr == 0) PG8_BAR; }
    PG8_BAR;
#undef PG8_SA
#undef PG8_SB
#undef PG8_STAGE
#undef PG8_LDA
#undef PG8_LDB
#undef PG8_MMA
#undef PG8_WAIT_V
#undef PG8_WAIT_L
#undef PG8_BAR
#undef PG8_SCHED
}
typedef f32x4 Acc[2][2][4][2];

struct EpiF32 {
    float* Y; int ldc;
    __device__ __forceinline__ void operator()(const Acc& acc, const Unit& u, int wr, int wc, int fr, int fq) const {
        const int row0 = u.pm * BM + wr * 64 + fr, col0 = u.pn * BM + wc * 32 + 8 * fq;
#pragma unroll
        for (int ai = 0; ai < 2; ++ai)
#pragma unroll
            for (int m = 0; m < 4; ++m) { float* rowp = Y + (size_t)(row0 + ai * HALF + m * 16) * ldc + col0;
#pragma unroll
                for (int bj = 0; bj < 2; ++bj) { *(f32x4*)(rowp + bj * HALF) = acc[ai][bj][m][0]; *(f32x4*)(rowp + bj * HALF + 4) = acc[ai][bj][m][1]; } }
    }
};
struct EpiF16 {
    f16* Y; int ldc;
    __device__ __forceinline__ void operator()(const Acc& acc, const Unit& u, int wr, int wc, int fr, int fq) const {
        const int row0 = u.pm * BM + wr * 64 + fr, col0 = u.pn * BM + wc * 32 + 8 * fq;
#pragma unroll
        for (int ai = 0; ai < 2; ++ai)
#pragma unroll
            for (int m = 0; m < 4; ++m) { f16* rowp = Y + (size_t)(row0 + ai * HALF + m * 16) * ldc + col0;
#pragma unroll
                for (int bj = 0; bj < 2; ++bj) { const f32x4 a = acc[ai][bj][m][0], b = acc[ai][bj][m][1];
                    u32x4 w; w.x = pkh(a[0], a[1]); w.y = pkh(a[2], a[3]); w.z = pkh(b[0], b[1]); w.w = pkh(b[2], b[3]); *(u32x4*)(rowp + bj * HALF) = w; } }
    }
};
struct EpiSwiGLU {
    f16* Hd; const float* rs;
    __device__ __forceinline__ void operator()(const Acc& acc, const Unit& u, int wr, int wc, int fr, int fq) const {
        const int row0 = u.pm * BM + wr * 64 + fr, col0 = u.pn * HALF + wc * 32 + 8 * fq;
#pragma unroll
        for (int ai = 0; ai < 2; ++ai)
#pragma unroll
            for (int m = 0; m < 4; ++m) {
                float o[8]; const float r = rs[row0 + ai * HALF + m * 16];
#pragma unroll
                for (int n = 0; n < 2; ++n)
#pragma unroll
                    for (int j = 0; j < 4; ++j) { const float gt = acc[ai][0][m][n][j] * r, up = acc[ai][1][m][n][j] * r; o[4 * n + j] = gt * up * __builtin_amdgcn_rcpf(1.f + __expf(-gt)); }
                u32x4 w; w.x = pkh(o[0], o[1]); w.y = pkh(o[2], o[3]); w.z = pkh(o[4], o[5]); w.w = pkh(o[6], o[7]);
                *(u32x4*)(Hd + (size_t)(row0 + ai * HALF + m * 16) * FF + col0) = w; }
    }
};
__device__ __forceinline__ float gelu_tanh(float x) { const float u = 0.7978845608028654f * (x + 0.044715f * x * x * x); const float e = __expf(2.f * u); return 0.5f * x * (2.f - 2.f * __builtin_amdgcn_rcpf(e + 1.f)); }
struct EpiCmp1 {
    f16* Hd; const float* bias;
    __device__ __forceinline__ void operator()(const Acc& acc, const Unit& u, int wr, int wc, int fr, int fq) const {
        const int row0 = u.pm * BM + wr * 64 + fr, col0 = wc * 32 + 8 * fq;
        f32x4 bv[2][2];
#pragma unroll
        for (int bj = 0; bj < 2; ++bj)
#pragma unroll
            for (int n = 0; n < 2; ++n) { f32x4 a = *(const f32x4*)(bias + col0 + bj * HALF + 4 * n);
#pragma unroll
                for (int p = 1; p < 8; ++p) a = a + *(const f32x4*)(bias + p * 512 + col0 + bj * HALF + 4 * n);
                bv[bj][n] = a; }
#pragma unroll
        for (int ai = 0; ai < 2; ++ai)
#pragma unroll
            for (int m = 0; m < 4; ++m) {
#pragma unroll
                for (int bj = 0; bj < 2; ++bj) {
                    float o[8];
#pragma unroll
                    for (int n = 0; n < 2; ++n)
#pragma unroll
                        for (int j = 0; j < 4; ++j) o[4 * n + j] = gelu_tanh(acc[ai][bj][m][n][j] + bv[bj][n][j]);
                    u32x4 w; w.x = pkh(o[0], o[1]); w.y = pkh(o[2], o[3]); w.z = pkh(o[4], o[5]); w.w = pkh(o[6], o[7]);
                    *(u32x4*)(Hd + (size_t)(row0 + ai * HALF + m * 16) * 256 + col0 + bj * HALF) = w; }
                __builtin_amdgcn_sched_barrier(0); }
    }
};
struct EpiCmp2 {
    f16* Out;
    __device__ __forceinline__ void operator()(const Acc& acc, const Unit& u, int wr, int wc, int fr, int fq) const {
        if (wc >= 2) return;
        const int row0 = u.pm * BM + wr * 64 + fr, col0 = wc * 32 + 8 * fq;
#pragma unroll
        for (int ai = 0; ai < 2; ++ai)
#pragma unroll
            for (int m = 0; m < 4; ++m) {
                u32x4 w; w.x = pkh(acc[ai][0][m][0][0], acc[ai][0][m][0][1]); w.y = pkh(acc[ai][0][m][0][2], acc[ai][0][m][0][3]);
                w.z = pkh(acc[ai][0][m][1][0], acc[ai][0][m][1][1]); w.w = pkh(acc[ai][0][m][1][2], acc[ai][0][m][1][3]);
                *(u32x4*)(Out + (size_t)(row0 + ai * HALF + m * 16) * 64 + col0) = w; }
    }
};
struct EpiInProj {
    f16* proj; const float* cosT; const float* sinT; float* logf; float* gates; const float* b_f; int layer; const float* rs;
    __device__ __forceinline__ void operator()(const Acc& acc, const Unit& u, int wr, int wc, int fr, int fq) const {
        const int hs = u.pn * 4 + wc;
        int kind, dst;
        if (layer == 0) {
            if (hs < 8) { kind = 2; dst = hs; } else if (hs < 24) { kind = 0; dst = hs; } else if (hs < 32) { kind = 3; dst = hs; }
            else if (hs < 38) { kind = 1; dst = hs; } else if (hs == 38) { kind = 4; dst = 0; } else if (hs == 39) { kind = 5; dst = 0; }
            else if (hs < 46) { kind = 0; dst = hs - 2; } else { kind = 5; dst = 0; }
        } else { dst = hs; kind = hs < 16 ? 3 : (hs < 32 ? 1 : 0); }
        if (kind == 5) return;
        const int row0 = u.pm * BM + wr * 64 + fr;
        if (kind == 4) {
            const float bf0 = b_f[(8 * fq) & 7], bf1 = b_f[(8 * fq + 1) & 7], bf2 = b_f[(8 * fq + 2) & 7], bf3 = b_f[(8 * fq + 3) & 7], bf4 = b_f[(8 * fq + 4) & 7], bf5 = b_f[(8 * fq + 5) & 7], bf6 = b_f[(8 * fq + 6) & 7], bf7 = b_f[(8 * fq + 7) & 7];
            const float bfv[8] = {bf0, bf1, bf2, bf3, bf4, bf5, bf6, bf7};
#pragma unroll
            for (int ai = 0; ai < 2; ++ai)
#pragma unroll
                for (int m = 0; m < 4; ++m) { const int row = row0 + ai * HALF + m * 16; const int b = row / SEQ, s = row % SEQ; const float rw = rs[row];
#pragma unroll
                    for (int n = 0; n < 2; ++n)
#pragma unroll
                        for (int j = 0; j < 4; ++j) { const int d = 8 * fq + 4 * n + j; const float v = acc[ai][0][m][n][j] * rw;
                            if (fq == 0) { const float x = v + bfv[4 * n + j]; const float e = __expf(-fabsf(x));
                                const float l1p = e < 0.03f ? e * (1.f - e * (0.5f - e * (0.33333333f - 0.25f * e))) : __logf(1.f + e);
                                logf[((size_t)b * 8 + d) * SEQ + s] = fminf(x, 0.f) - l1p; }
                            else gates[(size_t)row * 24 + (d - 8)] = 1.f / (1.f + __expf(-v)); }
                    __builtin_amdgcn_sched_barrier(0); }
            return;
        }
        const float sc = (kind >= 2) ? QSCALE : 1.f; const bool rope = (kind == 1 || kind == 3);
        f16* base = proj + (size_t)dst * (NB * SEQ * HD);
#pragma unroll
        for (int ai = 0; ai < 2; ++ai)
#pragma unroll
            for (int m = 0; m < 4; ++m) { const int row = row0 + ai * HALF + m * 16; const int s = row % SEQ; const float rw = rs[row] * sc;
                f32x4 x1[2] = {acc[ai][0][m][0] * rw, acc[ai][0][m][1] * rw}, x2[2] = {acc[ai][1][m][0] * rw, acc[ai][1][m][1] * rw};
                if (rope) {
#pragma unroll
                    for (int n = 0; n < 2; ++n) { const f32x4 c = *(const f32x4*)(cosT + (size_t)s * 32 + 8 * fq + 4 * n), sn = *(const f32x4*)(sinT + (size_t)s * 32 + 8 * fq + 4 * n);
                        const f32x4 a = x1[n], bb = x2[n]; x1[n] = a * c - bb * sn; x2[n] = bb * c + a * sn; }
                }
                u32x4 w1, w2;
                w1.x = pkh(x1[0][0], x1[0][1]); w1.y = pkh(x1[0][2], x1[0][3]); w1.z = pkh(x1[1][0], x1[1][1]); w1.w = pkh(x1[1][2], x1[1][3]);
                w2.x = pkh(x2[0][0], x2[0][1]); w2.y = pkh(x2[0][2], x2[0][3]); w2.z = pkh(x2[1][0], x2[1][1]); w2.w = pkh(x2[1][2], x2[1][3]);
                f16* rp = base + (size_t)row * HD + 8 * fq;
                *(u32x4*)rp = w1; *(u32x4*)(rp + 32) = w2;
                __builtin_amdgcn_sched_barrier(0); }
    }
};
}

__device__ __forceinline__ int crow(int r, int hi) { return (r & 3) + 8 * (r >> 2) + 4 * hi; }
__device__ __forceinline__ float swapmax(float m) { auto rr = __builtin_amdgcn_permlane32_swap(__float_as_uint(m), __float_as_uint(m), false, false); return fmaxf(__uint_as_float(rr[0]), __uint_as_float(rr[1])); }
__device__ __forceinline__ float swapsum(float m) { auto rr = __builtin_amdgcn_permlane32_swap(__float_as_uint(m), __float_as_uint(m), false, false); return __uint_as_float(rr[0]) + __uint_as_float(rr[1]); }
struct KVStage { u32x4 k, v; };
__device__ __forceinline__ void kv_issue(KVStage& st, const char* kt, const char* vt, int wid, int lane) {
    st.k = *(const u32x4*)(kt + lane * 128 + wid * 16);
    st.v = *(const u32x4*)(vt + (16 * (wid & 3) + (lane >> 2)) * 128 + (wid >> 2) * 64 + (lane & 3) * 16);
}
__device__ __forceinline__ void kv_write(const KVStage& st, LAS unsigned char* buf, int wid, int lane) {
    *(LAS u32x4*)(buf + wid * 1024 + lane * 16) = st.k;
    *(LAS u32x4*)(buf + 8192 + wid * 1024 + lane * 16) = st.v;
}
__device__ __forceinline__ void qk_tile(f32x16& p0, f32x16& p1, const LAS unsigned char* kb, const h8 (&qr)[4], int r32, int hi) {
    const LAS unsigned char* kp = kb + hi * 1024 + r32 * 16;
#pragma unroll
    for (int r = 0; r < 16; ++r) { p0[r] = 0.f; p1[r] = 0.f; }
#pragma unroll
    for (int d0 = 0; d0 < 4; ++d0) {
        const h8 b0 = *(const LAS h8*)(kp + d0 * 2048), b1 = *(const LAS h8*)(kp + d0 * 2048 + 512);
        p0 = MFMA32(b0, qr[d0], p0); p1 = MFMA32(b1, qr[d0], p1);
    }
}
typedef short v4i16_t __attribute__((ext_vector_type(4)));
typedef short s16x8 __attribute__((ext_vector_type(8)));
__device__ __forceinline__ s16x4 vtr(const LAS unsigned char* p) { return __builtin_bit_cast(s16x4, __builtin_amdgcn_ds_read_tr16_b64_v4i16((LAS v4i16_t*)p)); }
__device__ __forceinline__ void pv_tile(f32x16 (&o)[2], const LAS unsigned char* vb, const u32x4 (&pw)[4], int lane, int hi) {
    const LAS unsigned char* vp = vb + ((lane >> 4) & 1) * 32 + (lane & 3) * 8 + (4 * hi + ((lane & 15) >> 2)) * 64;
#pragma unroll
    for (int d0 = 0; d0 < 2; ++d0)
#pragma unroll
        for (int ks = 0; ks < 4; ++ks) {
            const s16x4 lo = vtr(vp + d0 * 4096 + ks * 1024), hh = vtr(vp + d0 * 4096 + ks * 1024 + 512);
            const s16x8 vv = {lo[0], lo[1], lo[2], lo[3], hh[0], hh[1], hh[2], hh[3]};
            o[d0] = MFMA32(__builtin_bit_cast(h8, pw[ks]), __builtin_bit_cast(h8, vv), o[d0]);
        }
}
__device__ __forceinline__ void pack_p(u32x4 (&pw)[4], const f32x16& p0, const f32x16& p1) {
    pw[0] = (u32x4){pkh(p0[0], p0[1]), pkh(p0[2], p0[3]), pkh(p0[4], p0[5]), pkh(p0[6], p0[7])};
    pw[1] = (u32x4){pkh(p0[8], p0[9]), pkh(p0[10], p0[11]), pkh(p0[12], p0[13]), pkh(p0[14], p0[15])};
    pw[2] = (u32x4){pkh(p1[0], p1[1]), pkh(p1[2], p1[3]), pkh(p1[4], p1[5]), pkh(p1[6], p1[7])};
    pw[3] = (u32x4){pkh(p1[8], p1[9]), pkh(p1[10], p1[11]), pkh(p1[12], p1[13]), pkh(p1[14], p1[15])};
}
__device__ __forceinline__ float rowmax32(const f32x16& p0, const f32x16& p1) {
    float a = fmaxf(p0[0], p1[0]);
#pragma unroll
    for (int r = 1; r < 16; ++r) a = fmaxf(a, fmaxf(p0[r], p1[r]));
    return swapmax(a);
}
__device__ __forceinline__ void softmax_step(f32x16& p0, f32x16& p1, float& m, float& l, f32x16 (&o)[2], LAS float* wsf, int r32, int hi) {
    const float rm = rowmax32(p0, p1);
    const float mn = fmaxf(m, rm);
    const float alpha = fexp2(m - mn);
    m = mn;
    float s = 0.f;
#pragma unroll
    for (int r = 0; r < 16; ++r) { p0[r] = fexp2(p0[r] - mn); p1[r] = fexp2(p1[r] - mn); s += p0[r] + p1[r]; }
    l = l * alpha + s;
    if (__any(alpha != 1.f)) {
        if (hi == 0) wsf[r32] = alpha;
        LDS_WAIT();
#pragma unroll
        for (int r = 0; r < 16; ++r) { const float a = wsf[crow(r, hi)]; o[0][r] *= a; o[1][r] *= a; }
        LDS_WAIT();
    }
}
__device__ __forceinline__ void stage_o(const f32x16 (&o)[2], float rinv_lane, LAS float* wsf, LAS f16* stg, int r32, int hi) {
    if (hi == 0) wsf[32 + r32] = rinv_lane;
    LDS_WAIT();
#pragma unroll
    for (int r = 0; r < 16; ++r) { const int orow = crow(r, hi); const float rl = wsf[32 + orow];
        stg[orow * 64 + r32] = (f16)(o[0][r] * rl); stg[orow * 64 + 32 + r32] = (f16)(o[1][r] * rl); }
    LDS_WAIT();
}

template <class F> __device__ __forceinline__ void attn_unit(F& f, LAS unsigned char* lds) {
    const int tid = opaque_tid(), lane = tid & 63, r32 = lane & 31, hi = lane >> 5; const int wid = __builtin_amdgcn_readfirstlane(tid >> 6);
    LAS unsigned char* kv = lds + L_KV; LAS float* wsf = (LAS float*)(lds + L_WSF) + wid * 64; LAS f16* stg = (LAS f16*)(lds + L_OST) + wid * 2048;
    LAS float* csl = (LAS float*)(lds + L_CS);
    f.init(wid, r32, hi);
    const f16* qp = f.qrow();
    h8 qr[4];
#pragma unroll
    for (int d0 = 0; d0 < 4; ++d0) qr[d0] = *(const h8*)(qp + 16 * d0 + 8 * hi);
    float m = NEG_BIG, l = 0.f; f32x16 o[2];
#pragma unroll
    for (int r = 0; r < 16; ++r) { o[0][r] = 0.f; o[1][r] = 0.f; }
    const int t0 = f.t_begin(), t1 = f.t_end();
    KVStage st; float csv = 0.f;
    __syncthreads();
    f.unit_prep(lds, tid);
    kv_issue(st, f.ktile(t0), f.vtile(t0), wid, lane);
    if constexpr (F::HAS_CS) { if (wid == 0) csv = f.cs_src(t0)[lane]; }
    kv_write(st, kv, wid, lane);
    if constexpr (F::HAS_CS) { if (wid == 0) csl[lane] = csv; }
    __syncthreads();
    for (int t = t0; t < t1; ++t) {
        const int cur = (t - t0) & 1;
        const bool more = (t + 1 < t1);
        if (more) { kv_issue(st, f.ktile(t + 1), f.vtile(t + 1), wid, lane); if constexpr (F::HAS_CS) { if (wid == 0) csv = f.cs_src(t + 1)[lane]; } }
        if (f.active(t)) {
            f32x16 p0, p1;
            qk_tile(p0, p1, kv + cur * 16384, qr, r32, hi);
            f.mask(p0, p1, t, csl + cur * 64, hi);
            softmax_step(p0, p1, m, l, o, wsf, r32, hi);
            u32x4 pw[4]; pack_p(pw, p0, p1);
            pv_tile(o, kv + cur * 16384 + 8192, pw, lane, hi);
        }
        if (more) { kv_write(st, kv + (cur ^ 1) * 16384, wid, lane); if constexpr (F::HAS_CS) { if (wid == 0) csl[(cur ^ 1) * 64 + lane] = csv; } }
        __syncthreads();
    }
    const float lt = swapsum(l);
    stage_o(o, lt > 0.f ? 1.f / lt : 0.f, wsf, stg, r32, hi);
    if (hi == 0) { wsf[r32] = m; wsf[32 + r32] = lt; }
    LDS_WAIT();
    f.store(stg, lane, wsf);
}

namespace fa {
constexpr int NW = 8, QBLK = 32, QB = 256, KVBLK = 64, NSLOT = 3, SLOTB = 8192;
constexpr int LDS_K = 0, LDS_V = NSLOT * SLOTB, LDS_WS = 2 * NSLOT * SLOTB, LDS_OST = LDS_WS + NW * 64 * 4, LDS_CS = LDS_OST + NW * 4096, LDS_END = LDS_CS + NW * 1024;
#define SBAR() __builtin_amdgcn_sched_barrier(0)
__device__ __forceinline__ void cmask(f32x16& p0, f32x16& p1, int jb, int qrel, int hi) {
    const float NEG = -INFINITY; int kb = 64 * jb + 4 * hi;
#pragma unroll
    for (int r = 0; r < 16; ++r) { int kvp = kb + (r & 3) + 8 * (r >> 2); if (kvp > qrel) p0[r] = NEG; if (kvp + 32 > qrel) p1[r] = NEG; }
}
__device__ __forceinline__ void glds16(const void* gsrc, unsigned lds_dst) { unsigned keep;
    asm volatile("s_mov_b32 %0, m0\n\ts_mov_b32 m0, %2\n\ts_nop 0\n\tglobal_load_lds_dwordx4 %1, off\n\ts_mov_b32 m0, %0" : "=&s"(keep) : "v"(gsrc), "s"(lds_dst) : "memory"); }
__device__ __forceinline__ void glds4(const void* gsrc, unsigned lds_dst) { unsigned keep;
    asm volatile("s_mov_b32 %0, m0\n\ts_mov_b32 m0, %2\n\ts_nop 0\n\tglobal_load_lds_dword %1, off\n\ts_mov_b32 m0, %0" : "=&s"(keep) : "v"(gsrc), "s"(lds_dst) : "memory"); }
__device__ __forceinline__ float max3f(float a, float b, float c) { float r; asm("v_max3_f32 %0, %1, %2, %3" : "=v"(r) : "v"(a), "v"(b), "v"(c)); return r; }
__device__ __forceinline__ float max2f(float a, float b) { float r; asm("v_max_f32_e32 %0, %1, %2" : "=v"(r) : "v"(a), "v"(b)); return r; }
__device__ __forceinline__ float fadd_s(float a, float b) { float r; asm("v_add_f32_e32 %0, %1, %2" : "=v"(r) : "v"(a), "v"(b)); return r; }
__device__ __forceinline__ float fsub_s(float a, float b) { float r; asm("v_sub_f32_e32 %0, %1, %2" : "=v"(r) : "v"(a), "v"(b)); return r; }
#define WAIT_BAR(N) asm volatile("s_waitcnt vmcnt(" #N ") lgkmcnt(0)\n\ts_barrier" ::: "memory")
typedef LAS const char* lds_cptr;
__device__ __forceinline__ void qkt(f32x16& p0, f32x16& p1, const char* Kslot, const h8* qr, const f32x16& negm, int r32, int hi) {
    const char* kb = Kslot + hi * 1024 + r32 * 16;
#pragma unroll
    for (int d0 = 0; d0 < 4; ++d0) {
        const h8 b0 = *reinterpret_cast<const h8*>(kb + d0 * 2048);
        const h8 b1 = *reinterpret_cast<const h8*>(kb + d0 * 2048 + 512);
        if (d0 == 0) { p0 = MFMA32(b0, qr[0], negm); p1 = MFMA32(b1, qr[0], negm); }
        else { p0 = MFMA32(b0, qr[d0], p0); p1 = MFMA32(b1, qr[d0], p1); } }
}
__device__ __forceinline__ void kload8(h8* kf, lds_cptr kp) {
    kf[0] = *(const LAS h8*)(kp);        kf[1] = *(const LAS h8*)(kp + 512);
    kf[2] = *(const LAS h8*)(kp + 2048); kf[3] = *(const LAS h8*)(kp + 2560);
    kf[4] = *(const LAS h8*)(kp + 4096); kf[5] = *(const LAS h8*)(kp + 4608);
    kf[6] = *(const LAS h8*)(kp + 6144); kf[7] = *(const LAS h8*)(kp + 6656);
}
__device__ __forceinline__ void kload2(h8* kf, lds_cptr kp, int j) { kf[2 * j] = *(const LAS h8*)(kp + j * 2048); kf[2 * j + 1] = *(const LAS h8*)(kp + j * 2048 + 512); }
__device__ __forceinline__ s16x4 vtr2(lds_cptr p) { return __builtin_bit_cast(s16x4, __builtin_amdgcn_ds_read_tr16_b64_v4i16((LAS v4i16_t*)p)); }
__device__ __forceinline__ float rowmax(const f32x16& p0, const f32x16& p1) {
    float a = max3f(p0[0], p0[1], p1[0]), b = max3f(p0[2], p0[3], p1[1]); a = max3f(a, p1[2], p1[3]);
#pragma unroll
    for (int r = 4; r < 16; r += 4) { a = max3f(a, p0[r], p0[r + 1]); b = max3f(b, p0[r + 2], p0[r + 3]); a = max3f(a, p1[r], p1[r + 1]); b = max3f(b, p1[r + 2], p1[r + 3]); }
    const float m = max2f(a, b);
    auto rr = __builtin_amdgcn_permlane32_swap(__float_as_uint(m), __float_as_uint(m), false, false);
    return max2f(__uint_as_float(rr[0]), __uint_as_float(rr[1]));
}
__device__ __forceinline__ h8 mk8(s16x4 lo, s16x4 hi) { const s16x8 v = {lo[0], lo[1], lo[2], lo[3], hi[0], hi[1], hi[2], hi[3]}; return __builtin_bit_cast(h8, v); }
__device__ __forceinline__ void pv(f32x16* o, int vb, h8 pa0, h8 pa1, h8 pa2, h8 pa3) {
#pragma unroll
    for (int d0 = 0; d0 < 2; ++d0) { s16x4 lo[4], hi[4];
#pragma unroll
        for (int ks = 0; ks < 4; ++ks) {
            asm volatile("ds_read_b64_tr_b16 %0,%1 offset:%c2" : "=&v"(lo[ks]) : "v"(vb), "i"(d0 * 4096 + ks * 1024) : "memory");
            asm volatile("ds_read_b64_tr_b16 %0,%1 offset:%c2" : "=&v"(hi[ks]) : "v"(vb), "i"(d0 * 4096 + ks * 1024 + 512) : "memory"); }
        asm volatile("s_waitcnt lgkmcnt(0)" ::: "memory"); SBAR();
        o[d0] = MFMA32(pa0, mk8(lo[0], hi[0]), o[d0]);
        o[d0] = MFMA32(pa1, mk8(lo[1], hi[1]), o[d0]);
        o[d0] = MFMA32(pa2, mk8(lo[2], hi[2]), o[d0]);
        o[d0] = MFMA32(pa3, mk8(lo[3], hi[3]), o[d0]);
    }
}
__device__ __forceinline__ void stage_rows(const f32x16 (&o)[2], float rinv, char* shm, int wid, int le) {
    const int r32e = le & 31, hie = le >> 5;
    float* wse = (float*)(shm + LDS_WS) + wid * 64;
    if (hie == 0) wse[32 + r32e] = rinv; asm volatile("s_waitcnt lgkmcnt(0)" ::: "memory");
    f16* stg = (f16*)(shm + LDS_OST) + wid * 2048;
#pragma unroll
    for (int r = 0; r < 16; ++r) { const int orow = crow(r, hie); const float rl = wse[32 + orow];
#pragma unroll
        for (int d0 = 0; d0 < 2; ++d0) stg[orow * 64 + d0 * 32 + r32e] = (f16)(o[d0][r] * rl); }
    asm volatile("s_waitcnt lgkmcnt(0)" ::: "memory");
}
struct EpiPlain { f16* Ow; int opitch;
    __device__ __forceinline__ void after_q() const {}
    __device__ __forceinline__ void operator()(const f32x16 (&o)[2], float, float l, char* shm, int wid) const {
        const int le = opaque_tid() & 63;
        stage_rows(o, l > 0.f ? __builtin_amdgcn_rcpf(l) : 0.f, shm, wid, le);
        const f16* stg = (const f16*)(shm + LDS_OST) + wid * 2048;
#pragma unroll
        for (int i = 0; i < 4; ++i) { const int row = i * 8 + (le >> 3), ch = le & 7; const u32x4 v = *(const u32x4*)(stg + row * 64 + ch * 8); *(u32x4*)(Ow + (long)row * opitch + ch * 8) = v; }
    } };
struct EpiPartial { f16* PO; float* PML; int dst; const f16* qs; int code_next; unsigned qst;
    __device__ __forceinline__ void after_q() const {
        asm volatile("s_waitcnt vmcnt(0) lgkmcnt(0)" ::: "memory");
        const int le = opaque_tid() & 63;
#pragma unroll
        for (int i = 0; i < 4; ++i) { const int cn = __shfl(code_next, 8 * i + (le >> 3), 64);
            glds16(qs + (size_t)((cn < 0 ? 0 : cn) & 16383) * HD + (le & 7) * 8, (unsigned)__builtin_amdgcn_readfirstlane(qst + i * 1024)); }
    }
    __device__ __forceinline__ void operator()(const f32x16 (&o)[2], float mhat, float l, char* shm, int wid) const {
        const int le = opaque_tid() & 63, r32e = le & 31, hie = le >> 5;
        int* tab = (int*)(shm + LDS_CS) + wid * 256;
        if (hie == 0) { tab[r32e] = dst; if (dst >= 0) { f32x2 ml = {mhat, l}; *(f32x2*)(PML + 2 * (size_t)dst) = ml; } }
        stage_rows(o, __builtin_amdgcn_rcpf(l), shm, wid, le);
        const f16* stg = (const f16*)(shm + LDS_OST) + wid * 2048;
#pragma unroll
        for (int i = 0; i < 4; ++i) { const int row = i * 8 + (le >> 3), ch = le & 7; const int d = tab[row];
            if (d >= 0) { const u32x4 v = *(const u32x4*)(stg + row * 64 + ch * 8); *(u32x4*)(PO + (size_t)d * 64 + ch * 8) = v; } }
    } };
struct EpiMerge { const f16* PO; const float* PML; size_t prow0; int nv; f16* Ow; int opitch;
    __device__ __forceinline__ void after_q() const {}
    __device__ __forceinline__ void operator()(const f32x16 (&o)[2], float mhat, float l, char* shm, int wid) const {
        const int le = opaque_tid() & 63, r32e = le & 31, hie = le >> 5;
        float* tab = (float*)(shm + LDS_CS) + wid * 256;
        if (hie == 0) {
            float ms[3], ls[3]; float M = mhat;
#pragma unroll
            for (int s_ = 0; s_ < 3; ++s_) { ms[s_] = -INFINITY; ls[s_] = 0.f; if (s_ < nv) { const f32x2 ml = *(const f32x2*)(PML + 2 * ((prow0 + r32e) * 3 + s_)); ms[s_] = ml[0]; ls[s_] = ml[1]; M = fmaxf(M, ml[0]); } }
            const float wo = fexp2(mhat - M) * l; float w[3], den = wo;
#pragma unroll
            for (int s_ = 0; s_ < 3; ++s_) { w[s_] = (s_ < nv) ? fexp2(ms[s_] - M) * ls[s_] : 0.f; den += w[s_]; }
            const float rd = 1.f / den;
            tab[r32e * 4] = wo * rd; tab[r32e * 4 + 1] = w[0] * rd; tab[r32e * 4 + 2] = w[1] * rd; tab[r32e * 4 + 3] = w[2] * rd;
        }
        stage_rows(o, __builtin_amdgcn_rcpf(l), shm, wid, le);
        const f16* stg = (const f16*)(shm + LDS_OST) + wid * 2048;
#pragma unroll
        for (int i = 0; i < 4; ++i) { const int row = i * 8 + (le >> 3), ch = le & 7;
            const f32x4 a = *(const f32x4*)(tab + row * 4); const h8 own = *(const h8*)(stg + row * 64 + ch * 8);
            float acc[8];
#pragma unroll
            for (int e = 0; e < 8; ++e) acc[e] = a[0] * (float)own[e];
#pragma unroll
            for (int s_ = 0; s_ < 3; ++s_) if (s_ < nv) { const h8 pv_ = *(const h8*)(PO + ((prow0 + row) * 3 + s_) * 64 + ch * 8); const float as = a[1 + s_];
#pragma unroll
                for (int e = 0; e < 8; ++e) acc[e] += as * (float)pv_[e]; }
            u32x4 v; v.x = pkh(acc[0], acc[1]); v.y = pkh(acc[2], acc[3]); v.z = pkh(acc[4], acc[5]); v.w = pkh(acc[6], acc[7]);
            *(u32x4*)(Ow + (long)row * opitch + ch * 8) = v; }
    } };
struct EpiWinGate { const float* gates; f16* O; int b, hd, q0;
    __device__ __forceinline__ void after_q() const {}
    __device__ __forceinline__ void operator()(const f32x16 (&o)[2], float, float l, char* shm, int wid) const {
        const int le = opaque_tid() & 63;
        stage_rows(o, l > 0.f ? __builtin_amdgcn_rcpf(l) : 0.f, shm, wid, le);
        const f16* stg = (const f16*)(shm + LDS_OST) + wid * 2048;
#pragma unroll
        for (int i = 0; i < 4; ++i) { const int row = i * 8 + (le >> 3), ch = le & 7; const int q = q0 + row;
            const float g2 = gates[((size_t)b * SEQ + q) * 24 + hd * 3 + 2];
            const h8 s_ = *(const h8*)(stg + row * 64 + ch * 8);
            u32x4 o4; o4.x = pkh(g2 * (float)s_[0], g2 * (float)s_[1]); o4.y = pkh(g2 * (float)s_[2], g2 * (float)s_[3]); o4.z = pkh(g2 * (float)s_[4], g2 * (float)s_[5]); o4.w = pkh(g2 * (float)s_[6], g2 * (float)s_[7]);
            *(u32x4*)(O + ((size_t)b * SEQ + q) * DM + 512 + hd * HD + ch * 8) = o4; }
    } };
__device__ __forceinline__ void o_acc8(f16* p, float gt, const h8 v) {
    const h8 c = *(const h8*)p; float r_[8];
#pragma unroll
    for (int e = 0; e < 8; ++e) r_[e] = (float)c[e] + gt * (float)v[e];
    u32x4 o4; o4.x = pkh(r_[0], r_[1]); o4.y = pkh(r_[2], r_[3]); o4.z = pkh(r_[4], r_[5]); o4.w = pkh(r_[6], r_[7]);
    *(u32x4*)p = o4;
}
constexpr int QREL_ROW = -(1 << 30);
constexpr int RES_V = 92160;
template <int THRL, bool BIAS, bool CAUSAL, class Epi, bool QLDS = false, bool RES = false> __device__ __forceinline__ void unit(const f16* qrow, const f16* __restrict__ Kh, const f16* __restrict__ Vh, const float* cq, const float* ck, const int NT, const int qrel_in, const Epi& E, char* shm) {
    const int tid = opaque_tid(), lane = tid & 63, r32 = lane & 31, hi = lane >> 5; const int wid = __builtin_amdgcn_readfirstlane(tid >> 6);
    const unsigned lds0 = (unsigned)(uintptr_t)shm;
    float* wsf = (float*)(shm + LDS_WS) + wid * 64;
    if (QLDS) ((int*)wsf)[32 + r32] = qrel_in;
    const f16* ksrc = Kh + (long)lane * 64 + wid * 8;
    const f16* vsrc = Vh + (long)(16 * (wid & 3) + (lane >> 2)) * 64 + (wid >> 2) * 32 + (lane & 3) * 8;
    const float* cssrc = ck + lane;
    const unsigned kdst = lds0 + LDS_K + wid * 1024, vdst = lds0 + LDS_V + wid * 1024, csdst = lds0 + LDS_CS + wid * 1024;
#define DMA_K(t, slot) do { if (!RES) { glds16(ksrc + (long)(t) * 4096, (unsigned)__builtin_amdgcn_readfirstlane(kdst + (slot))); \
        if (BIAS) glds4(cssrc + 64 * (t), (unsigned)__builtin_amdgcn_readfirstlane(csdst + (((t) & 3) << 8))); } } while (0)
#define DMA_V(t, slot) do { if (!RES) glds16(vsrc + (long)(t) * 4096, (unsigned)__builtin_amdgcn_readfirstlane(vdst + (slot))); } while (0)
    constexpr int VBASE = RES ? RES_V : LDS_V;
    const int vb0 = (int)(lds0 + VBASE) + ((lane >> 4) & 1) * 32 + (lane & 3) * 8 + (4 * hi + ((lane & 15) >> 2)) * 64;
    const char* Kbase = shm + LDS_K; h8 kf[8];
    const lds_cptr shm3 = (lds_cptr)shm; const lds_cptr kp0 = shm3 + LDS_K + hi * 1024 + r32 * 16; const lds_cptr vp0 = shm3 + VBASE + ((lane >> 4) & 1) * 32 + (lane & 3) * 8 + (4 * hi + ((lane & 15) >> 2)) * 64;
    const lds_cptr csp0 = shm3 + LDS_CS + wid * 1024 + hi * 16;
    DMA_K(0, 0); DMA_V(0, 0); DMA_K(1, SLOTB);
    h8 qr[4];
#pragma unroll
    for (int d0 = 0; d0 < 4; ++d0) qr[d0] = *reinterpret_cast<const h8*>(qrow + d0 * 16 + hi * 8);
    E.after_q();
    float ctv = 0.f; if (BIAS) ctv = *cq;
    float l_reg = 0.f; f32x16 o[2];
#pragma unroll
    for (int r = 0; r < 16; ++r) { o[0][r] = 0.f; o[1][r] = 0.f; }
    f32x16 negm;
#pragma unroll
    for (int r = 0; r < 16; ++r) negm[r] = ctv;
    asm volatile("" : "+v"(negm));
#define CMASK(P0, P1, t) do { if (CAUSAL) { int jb_ = (t) - (NT - 4); if (jb_ >= 0) { const int lq_ = opaque_tid() & 31; const int qrel = QLDS ? ((const int*)(shm + LDS_WS))[wid * 64 + 32 + lq_] : wid * QBLK + lq_; cmask(P0, P1, jb_, qrel, hi); } } } while (0)
#define CSUB(P0, P1, t) do { if (BIAS) { const lds_cptr cp_ = csp0 + (((t) & 3) << 8); \
        _Pragma("unroll") for (int g_ = 0; g_ < 4; ++g_) { const f32x4 c0_ = *(const LAS f32x4*)(cp_ + g_ * 32), c1_ = *(const LAS f32x4*)(cp_ + 128 + g_ * 32); \
            _Pragma("unroll") for (int j_ = 0; j_ < 4; ++j_) { P0[4 * g_ + j_] -= c0_[j_]; P1[4 * g_ + j_] -= c1_[j_]; } } } } while (0)
    bool resc = false;
#define START(P0, P1) do { const float rm = rowmax(P0, P1); resc = false; \
    { const float dl = (rm > -INFINITY) ? rm : 0.f;        \
      _Pragma("unroll") for (int r = 0; r < 16; ++r) { P0[r] = fsub_s(P0[r], dl); P1[r] = fsub_s(P1[r], dl); } \
      const float nm_ = ctv - dl; _Pragma("unroll") for (int r = 0; r < 16; ++r) negm[r] = nm_; asm volatile("" : "+v"(negm)); } \
    _Pragma("unroll") for (int r = 0; r < 16; ++r) P0[r] = __builtin_amdgcn_exp2f(P0[r]); } while (0)
#define RESC() do { if (resc) { asm volatile("s_waitcnt lgkmcnt(0)" ::: "memory"); \
      _Pragma("unroll") for (int d_ = 0; d_ < 2; ++d_) _Pragma("unroll") for (int r = 0; r < 16; ++r) o[d_][r] *= wsf[crow(r, hi)]; } } while (0)
    f32x16 pA0, pA1, pB0, pB1;
    int sl_prev = 0, sl_cur = 0, sl_next = SLOTB;
#define ROT() do { sl_prev = sl_cur; sl_cur = sl_next; sl_next = (!RES && sl_next == (NSLOT - 1) * SLOTB) ? 0 : sl_next + SLOTB; } while (0)
#define WBR(N) do { if (RES) { asm volatile("" ::: "memory"); } else { WAIT_BAR(N); } } while (0)
#define WB2() do { if (BIAS) { WBR(3); } else { WBR(2); } } while (0)
    DMA_K(2, 2 * SLOTB);
    WBR(3);
    qkt(pA0, pA1, Kbase, qr, negm, r32, hi); asm volatile("s_nop 15\n\ts_nop 7" : "+v"(pA0), "+v"(pA1)); CSUB(pA0, pA1, 0); CMASK(pA0, pA1, 0);
    START(pA0, pA1);
    _Pragma("unroll") for (int r = 0; r < 16; ++r) pA1[r] = __builtin_amdgcn_exp2f(pA1[r]);
    WBR(0);
    DMA_K(3, 0); DMA_V(1, SLOTB);
    ROT();
    kload8(kf, kp0 + sl_cur);
    WB2();
    s16x4 vlo[8], vhi[8]; u32x4 pw0, pw1, pw2, pw3;
#define PKW(P, B) pkh(P[B], P[B + 1])
#define PAF(k) __builtin_bit_cast(h8, pw##k)
#define VFR(i) mk8(vlo[i], vhi[i])
#define PIN(x) asm volatile("" : "+v"(x))
#define MX3(a, b, c) __builtin_fmaxf(__builtin_fmaxf((a), (b)), (c))
#define GAPA(MF, A0, A1, A2, A3, W0, W1, PW) do { MF; sacc += A0; sacc += A1; sacc += A2; sacc += A3; PIN(sacc); W0; W1; PIN(PW); SBAR(); } while (0)
#define EX(v) __builtin_amdgcn_exp2f(v)
#define GAPB(MF, X, B) do { MF; X[B] = EX(X[B]); X[B + 1] = EX(X[B + 1]); X[B + 2] = EX(X[B + 2]); X[B + 3] = EX(X[B + 3]); PIN(X); SBAR(); } while (0)
#define VRD(i) do { vlo[i] = vtr2(vp_ + (((i) >> 2) * 4096 + ((i) & 3) * 1024)); vhi[i] = vtr2(vp_ + (((i) >> 2) * 4096 + ((i) & 3) * 1024 + 512)); } while (0)
#define KRD(G, j) do { if (G) { kload2(kf, kp0 + sl_next, j); SBAR(); } } while (0)
#define STEP(C0, C1, P0, P1, t, GK, GV, GL) do { SBAR(); \
    const lds_cptr vp_ = vp0 + sl_prev; \
    VRD(0); SBAR(); float sacc = (P0[0] + P0[1]); \
    GAPA(C0 = MFMA32(kf[0], qr[0], negm), P0[2], P0[3], P0[4], P0[5],     pw0[0] = PKW(P0, 0), pw0[1] = PKW(P0, 2), pw0); \
    VRD(4); SBAR(); GAPA(C1 = MFMA32(kf[1], qr[0], negm), P0[6], P0[7], P0[8], P0[9],     pw0[2] = PKW(P0, 4), pw0[3] = PKW(P0, 6), pw0); \
    VRD(1); SBAR(); GAPA(C0 = MFMA32(kf[2], qr[1], C0),   P0[10], P0[11], P0[12], P0[13], pw1[0] = PKW(P0, 8), pw1[1] = PKW(P0, 10), pw1); \
    VRD(5); SBAR(); GAPA(C1 = MFMA32(kf[3], qr[1], C1),   P0[14], P0[15], P1[0], P1[1],   pw1[2] = PKW(P0, 12), pw1[3] = PKW(P0, 14), pw1); \
    VRD(2); SBAR(); GAPA(C0 = MFMA32(kf[4], qr[2], C0),   P1[2], P1[3], P1[4], P1[5],     pw2[0] = PKW(P1, 0), pw2[1] = PKW(P1, 2), pw2); \
    VRD(6); SBAR(); GAPA(C1 = MFMA32(kf[5], qr[2], C1),   P1[6], P1[7], P1[8], P1[9],     pw2[2] = PKW(P1, 4), pw2[3] = PKW(P1, 6), pw2); \
    VRD(3); SBAR(); GAPA(C0 = MFMA32(kf[6], qr[3], C0),   P1[10], P1[11], P1[12], P1[13], pw3[0] = PKW(P1, 8), pw3[1] = PKW(P1, 10), pw3); \
    VRD(7); SBAR(); GAPA(C1 = MFMA32(kf[7], qr[3], C1),   P1[14], P1[15], 0.f, 0.f,       pw3[2] = PKW(P1, 12), pw3[3] = PKW(P1, 14), pw3); \
    l_reg += sacc; \
    if (GK) { DMA_K((t) + 3, sl_cur); } if (GV) { DMA_V((t) + 1, sl_next); } \
    CSUB(C0, C1, t); \
    CMASK(C0, C1, t); \
    { float a = MX3(C0[0], C0[1], C1[0]), b = MX3(C0[2], C0[3], C1[1]); a = MX3(a, C1[2], C1[3]); \
      _Pragma("unroll") for (int r = 4; r < 16; r += 4) { a = MX3(a, C0[r], C0[r + 1]); b = MX3(b, C0[r + 2], C0[r + 3]); a = MX3(a, C1[r], C1[r + 1]); b = MX3(b, C1[r + 2], C1[r + 3]); } \
      float rm = __builtin_fmaxf(a, b); { auto rr = __builtin_amdgcn_permlane32_swap(__float_as_uint(rm), __float_as_uint(rm), false, false); rm = __builtin_fmaxf(__uint_as_float(rr[0]), __uint_as_float(rr[1])); } \
      resc = false; \
      if (__builtin_expect(__any(rm > (float)THRL), 0)) { const float dl = __builtin_fmaxf(rm, 0.f); \
        _Pragma("unroll") for (int r = 0; r < 16; ++r) { C0[r] -= dl; C1[r] -= dl; } \
        { const float nm_ = negm[0] - dl; _Pragma("unroll") for (int r = 0; r < 16; ++r) negm[r] = nm_; } asm volatile("" : "+v"(negm)); \
        const float f = __builtin_amdgcn_exp2f(-dl); l_reg *= f; { const int lr_ = opaque_tid() & 63; if (lr_ < 32) ((float*)(shm + LDS_WS))[wid * 64 + lr_] = f; } resc = true; } } \
    SBAR(); \
    GAPB(o[0] = MFMA32(PAF(0), VFR(0), o[0]), C0, 0); \
    GAPB(o[1] = MFMA32(PAF(0), VFR(4), o[1]), C0, 4); \
    KRD(GL, 0); GAPB(o[0] = MFMA32(PAF(1), VFR(1), o[0]), C0, 8); \
    KRD(GL, 1); GAPB(o[1] = MFMA32(PAF(1), VFR(5), o[1]), C0, 12); \
    KRD(GL, 2); GAPB(o[0] = MFMA32(PAF(2), VFR(2), o[0]), C1, 0); \
    KRD(GL, 3); GAPB(o[1] = MFMA32(PAF(2), VFR(6), o[1]), C1, 4); \
    GAPB(o[0] = MFMA32(PAF(3), VFR(3), o[0]), C1, 8); \
    GAPB(o[1] = MFMA32(PAF(3), VFR(7), o[1]), C1, 12); \
    } while (0)
    int t = 1;
#undef CMASK
#define CMASK(P0, P1, t) do {} while (0)
    for (; t + 5 < NT; t += 2) {
        STEP(pB0, pB1, pA0, pA1, t, true, true, true);     WB2(); RESC(); ROT();
        STEP(pA0, pA1, pB0, pB1, t + 1, true, true, true); WB2(); RESC(); ROT();
    }
#undef CMASK
#define CMASK(P0, P1, t) do { if (CAUSAL) { int jb_ = (t) - (NT - 4); if (jb_ >= 0) { const int lq_ = opaque_tid() & 31; const int qrel = QLDS ? ((const int*)(shm + LDS_WS))[wid * 64 + 32 + lq_] : wid * QBLK + lq_; cmask(P0, P1, jb_, qrel, hi); } } } while (0)
#define ENDW(tt) do { if ((tt) + 3 < NT) { WB2(); } else if ((tt) + 2 < NT) { WBR(1); } else { WBR(0); } } while (0)
    for (; t + 1 < NT; t += 2) {
        STEP(pB0, pB1, pA0, pA1, t, (t + 3 < NT), (t + 1 < NT), (t + 1 < NT));     ENDW(t);     RESC(); ROT();
        STEP(pA0, pA1, pB0, pB1, t + 1, (t + 4 < NT), (t + 2 < NT), (t + 2 < NT)); ENDW(t + 1); RESC(); ROT();
    }
    STEP(pB0, pB1, pA0, pA1, NT - 1, false, false, false); RESC();
    { float sacc = pB0[0] + pB0[1]; _Pragma("unroll") for (int r = 2; r < 16; ++r) sacc += pB0[r]; _Pragma("unroll") for (int r = 0; r < 16; ++r) sacc += pB1[r]; l_reg += sacc;
      pw0 = (u32x4){PKW(pB0, 0), PKW(pB0, 2), PKW(pB0, 4), PKW(pB0, 6)}; pw1 = (u32x4){PKW(pB0, 8), PKW(pB0, 10), PKW(pB0, 12), PKW(pB0, 14)}; pw2 = (u32x4){PKW(pB1, 0), PKW(pB1, 2), PKW(pB1, 4), PKW(pB1, 6)}; pw3 = (u32x4){PKW(pB1, 8), PKW(pB1, 10), PKW(pB1, 12), PKW(pB1, 14)};
      SBAR(); pv(o, vb0 + sl_cur, PAF(0), PAF(1), PAF(2), PAF(3)); }
    { auto rr = __builtin_amdgcn_permlane32_swap(__float_as_uint(l_reg), __float_as_uint(l_reg), false, false); l_reg = __uint_as_float(rr[0]) + __uint_as_float(rr[1]); }
    E(o, ctv - negm[0], l_reg, shm, wid);
    if (RES) { asm volatile("s_waitcnt lgkmcnt(0)" ::: "memory"); } else { asm volatile("s_waitcnt lgkmcnt(0)\n\ts_barrier" ::: "memory"); }
#undef DMA_K
#undef DMA_V
#undef CMASK
#undef CSUB
#undef START
#undef RESC
#undef ROT
#undef WB2
#undef WBR
#undef PKW
#undef PAF
#undef VFR
#undef PIN
#undef MX3
#undef GAPA
#undef GAPB
#undef EX
#undef VRD
#undef KRD
#undef STEP
#undef ENDW
}
__device__ __forceinline__ void cmask_own(f32x16& p0, f32x16& p1, int ql, int hi) {
#pragma unroll
    for (int r = 0; r < 16; ++r) { const int kvp = 4 * hi + (r & 3) + 8 * (r >> 2); if (kvp > ql) p0[r] = -INFINITY; if (kvp + 32 > ql) p1[r] = -INFINITY; }
}
template <int THRL, class Epi> __device__ __forceinline__ void unit_sel(const f16* qrow, const f16* __restrict__ Kh, const f16* __restrict__ Vh, const LAS unsigned* selw, const int qt, const int ql, const bool winl, const Epi& E, char* shm) {
    const int tid = opaque_tid(), lane = tid & 63, r32 = lane & 31, hi = lane >> 5; const int wid = __builtin_amdgcn_readfirstlane(tid >> 6);
    const unsigned lds0 = (unsigned)(uintptr_t)shm;
    float* wsf = (float*)(shm + LDS_WS) + wid * 64;
    const int NT = (qt + 2) < 4 ? 4 : ((qt + 2) & ~1);
    const f16* ksrc = Kh + (long)lane * 64 + wid * 8;
    const f16* vsrc = Vh + (long)(16 * (wid & 3) + (lane >> 2)) * 64 + (wid >> 2) * 32 + (lane & 3) * 8;
    const unsigned kdst = lds0 + LDS_K + wid * 1024, vdst = lds0 + LDS_V + wid * 1024;
#define DMA_K(t, slot) glds16(ksrc + (long)(t) * 4096, (unsigned)__builtin_amdgcn_readfirstlane(kdst + (slot)))
#define DMA_V(t, slot) glds16(vsrc + (long)(t) * 4096, (unsigned)__builtin_amdgcn_readfirstlane(vdst + (slot)))
#define SBIT(t) (((t) <= qt) ? ((selw[(t) >> 5] >> ((t) & 31)) & 1u) : 0u)
    const int vb0 = (int)(lds0 + LDS_V) + ((lane >> 4) & 1) * 32 + (lane & 3) * 8 + (4 * hi + ((lane & 15) >> 2)) * 64;
    const char* Kbase = shm + LDS_K; h8 kf[8];
    const lds_cptr shm3 = (lds_cptr)shm; const lds_cptr kp0 = shm3 + LDS_K + hi * 1024 + r32 * 16; const lds_cptr vp0 = shm3 + LDS_V + ((lane >> 4) & 1) * 32 + (lane & 3) * 8 + (4 * hi + ((lane & 15) >> 2)) * 64;
    DMA_K(0, 0); DMA_V(0, 0); DMA_K(1, SLOTB);
    h8 qr[4];
#pragma unroll
    for (int d0 = 0; d0 < 4; ++d0) qr[d0] = *reinterpret_cast<const h8*>(qrow + d0 * 16 + hi * 8);
    float mhat = 0.f, l_reg = 0.f; f32x16 o[2];
#pragma unroll
    for (int r = 0; r < 16; ++r) { o[0][r] = 0.f; o[1][r] = 0.f; }
    f32x16 negm;
#pragma unroll
    for (int r = 0; r < 16; ++r) negm[r] = 0.f;
    asm volatile("" : "+v"(negm));
    bool resc = false;
    bool fresh = false;
#define START(P0, P1) do { const float rm = rowmax(P0, P1); resc = false; fresh = !(rm > -INFINITY); \
    { const float dl = fresh ? 0.f : rm; mhat = fadd_s(mhat, dl); \
      _Pragma("unroll") for (int r = 0; r < 16; ++r) { P0[r] = fsub_s(P0[r], dl); P1[r] = fsub_s(P1[r], dl); } \
      _Pragma("unroll") for (int r = 0; r < 16; ++r) negm[r] = -mhat; asm volatile("" : "+v"(negm)); } \
    _Pragma("unroll") for (int r = 0; r < 16; ++r) P0[r] = __builtin_amdgcn_exp2f(P0[r]); } while (0)
#define RESC() do { if (resc) { asm volatile("s_waitcnt lgkmcnt(0)" ::: "memory"); \
      _Pragma("unroll") for (int d_ = 0; d_ < 2; ++d_) _Pragma("unroll") for (int r = 0; r < 16; ++r) o[d_][r] *= wsf[crow(r, hi)]; } } while (0)
    f32x16 pA0, pA1, pB0, pB1;
    int sl_prev = 0, sl_cur = 0, sl_next = SLOTB;
#define ROT() do { sl_prev = sl_cur; sl_cur = sl_next; sl_next = (sl_next == (NSLOT - 1) * SLOTB) ? 0 : sl_next + SLOTB; } while (0)
    DMA_K(2, 2 * SLOTB);
    WAIT_BAR(3);
    qkt(pA0, pA1, Kbase, qr, negm, r32, hi); asm volatile("s_nop 15\n\ts_nop 7" : "+v"(pA0), "+v"(pA1)); if (qt == 0) cmask_own(pA0, pA1, ql, hi);
    if (winl) {
#pragma unroll
        for (int r = 0; r < 16; ++r) { const int kvp = 4 * hi + (r & 3) + 8 * (r >> 2); if (kvp <= ql) pA0[r] = -INFINITY; if (kvp + 32 <= ql) pA1[r] = -INFINITY; }
    }
    START(pA0, pA1);
    _Pragma("unroll") for (int r = 0; r < 16; ++r) pA1[r] = __builtin_amdgcn_exp2f(pA1[r]);
    WAIT_BAR(0);
    DMA_K(3, 0); DMA_V(1, SLOTB);
    ROT();
    unsigned bprev = 1u;
    unsigned bcur = SBIT(1); bool acur = __any(bcur != 0u);
    if (acur) kload8(kf, kp0 + sl_cur);
    WAIT_BAR(2);
    bool aprev = true;
    s16x4 vfa0, vfa1, vfb0, vfb1; u32x4 pw0, pw1, pw2, pw3;
#define PKW(P, B) pkh(P[B], P[B + 1])
#define PAF(k) __builtin_bit_cast(h8, pw##k)
#define PIN(x) asm volatile("" : "+v"(x))
#define MX3(a, b, c) __builtin_fmaxf(__builtin_fmaxf((a), (b)), (c))
#define EX(v) __builtin_amdgcn_exp2f(v)
#define VRDP(i, LO, HI) do { LO = vtr2(vp_ + (((i) >> 2) * 4096 + ((i) & 3) * 1024)); HI = vtr2(vp_ + (((i) >> 2) * 4096 + ((i) & 3) * 1024 + 512)); } while (0)
#define KRD(G, j) do { if (G) { kload2(kf, kp0 + sl_next, j); SBAR(); } } while (0)
#define GAPA(AQ, AP, MF, A0, A1, A2, A3, W0, W1, PW) do { if (AQ) { MF; } if (AP) { sacc += A0; sacc += A1; sacc += A2; sacc += A3; PIN(sacc); W0; W1; PIN(PW); } SBAR(); } while (0)
#define GAPB(AQ, AP, MF, NEXTRD, X, B) do { if (AP) { MF; NEXTRD; } if (AQ) { X[B] = EX(X[B]); X[B + 1] = EX(X[B + 1]); X[B + 2] = EX(X[B + 2]); X[B + 3] = EX(X[B + 3]); PIN(X); } SBAR(); } while (0)
#define STEP(C0, C1, P0, P1, t, AQ, AP, GK, GV, GL) do { SBAR(); \
    const lds_cptr vp_ = vp0 + sl_prev; \
    if (!(AQ)) { asm volatile("" : "=v"(C0), "=v"(C1)); }        \
    float sacc = 0.f; \
    if (AP) { sacc = (P0[0] + P0[1]); } \
    GAPA(AQ, AP, C0 = MFMA32(kf[0], qr[0], negm), P0[2], P0[3], P0[4], P0[5],     pw0[0] = PKW(P0, 0), pw0[1] = PKW(P0, 2), pw0); \
    GAPA(AQ, AP, C1 = MFMA32(kf[1], qr[0], negm), P0[6], P0[7], P0[8], P0[9],     pw0[2] = PKW(P0, 4), pw0[3] = PKW(P0, 6), pw0); \
    GAPA(AQ, AP, C0 = MFMA32(kf[2], qr[1], C0),   P0[10], P0[11], P0[12], P0[13], pw1[0] = PKW(P0, 8), pw1[1] = PKW(P0, 10), pw1); \
    GAPA(AQ, AP, C1 = MFMA32(kf[3], qr[1], C1),   P0[14], P0[15], P1[0], P1[1],   pw1[2] = PKW(P0, 12), pw1[3] = PKW(P0, 14), pw1); \
    GAPA(AQ, AP, C0 = MFMA32(kf[4], qr[2], C0),   P1[2], P1[3], P1[4], P1[5],     pw2[0] = PKW(P1, 0), pw2[1] = PKW(P1, 2), pw2); \
    GAPA(AQ, AP, C1 = MFMA32(kf[5], qr[2], C1),   P1[6], P1[7], P1[8], P1[9],     pw2[2] = PKW(P1, 4), pw2[3] = PKW(P1, 6), pw2); \
    GAPA(AQ, AP, C0 = MFMA32(kf[6], qr[3], C0),   P1[10], P1[11], P1[12], P1[13], pw3[0] = PKW(P1, 8), pw3[1] = PKW(P1, 10), pw3); \
    GAPA(AQ, AP, C1 = MFMA32(kf[7], qr[3], C1),   P1[14], P1[15], 0.f, 0.f,       pw3[2] = PKW(P1, 12), pw3[3] = PKW(P1, 14), pw3); \
    if (AP) { const unsigned mw_ = bprev ? 0xFFFFFFFFu : 0u; l_reg += bprev ? sacc : 0.f;        \
        pw0 &= mw_; pw1 &= mw_; pw2 &= mw_; pw3 &= mw_; } \
    if (GK) { DMA_K((t) + 3, sl_cur); } if (GV) { DMA_V((t) + 1, sl_next); } \
    if (AP) { VRDP(0, vfa0, vfa1); } \
    resc = false; \
    if (AQ) { if ((t) == qt) cmask_own(C0, C1, ql, hi); \
      float a = MX3(C0[0], C0[1], C1[0]), b = MX3(C0[2], C0[3], C1[1]); a = MX3(a, C1[2], C1[3]); \
      _Pragma("unroll") for (int r = 4; r < 16; r += 4) { a = MX3(a, C0[r], C0[r + 1]); b = MX3(b, C0[r + 2], C0[r + 3]); a = MX3(a, C1[r], C1[r + 1]); b = MX3(b, C1[r + 2], C1[r + 3]); } \
      float rm = __builtin_fmaxf(a, b); { auto rr = __builtin_amdgcn_permlane32_swap(__float_as_uint(rm), __float_as_uint(rm), false, false); rm = __builtin_fmaxf(__uint_as_float(rr[0]), __uint_as_float(rr[1])); } \
      rm = bcur ? rm : -INFINITY; \
      const bool take_ = fresh && (rm > -INFINITY); \
      if (__builtin_expect(__any(rm > (float)THRL || take_), 0)) { const float dl = take_ ? rm : __builtin_fmaxf(rm, 0.f); mhat += dl; fresh = fresh && !take_; \
        _Pragma("unroll") for (int r = 0; r < 16; ++r) { C0[r] -= dl; C1[r] -= dl; } \
        _Pragma("unroll") for (int r = 0; r < 16; ++r) negm[r] = -mhat; asm volatile("" : "+v"(negm)); \
        const float f = take_ ? 1.f : __builtin_amdgcn_exp2f(-dl); l_reg *= f; { const int lr_ = opaque_tid() & 63; if (lr_ < 32) ((float*)(shm + LDS_WS))[wid * 64 + lr_] = f; } resc = true; } } \
    SBAR(); \
    GAPB(AQ, AP, o[0] = MFMA32(PAF(0), mk8(vfa0, vfa1), o[0]), VRDP(4, vfb0, vfb1), C0, 0); \
    GAPB(AQ, AP, o[1] = MFMA32(PAF(0), mk8(vfb0, vfb1), o[1]), VRDP(1, vfa0, vfa1), C0, 4); \
    KRD(GL, 0); GAPB(AQ, AP, o[0] = MFMA32(PAF(1), mk8(vfa0, vfa1), o[0]), VRDP(5, vfb0, vfb1), C0, 8); \
    KRD(GL, 1); GAPB(AQ, AP, o[1] = MFMA32(PAF(1), mk8(vfb0, vfb1), o[1]), VRDP(2, vfa0, vfa1), C0, 12); \
    KRD(GL, 2); GAPB(AQ, AP, o[0] = MFMA32(PAF(2), mk8(vfa0, vfa1), o[0]), VRDP(6, vfb0, vfb1), C1, 0); \
    KRD(GL, 3); GAPB(AQ, AP, o[1] = MFMA32(PAF(2), mk8(vfb0, vfb1), o[1]), VRDP(3, vfa0, vfa1), C1, 4); \
    GAPB(AQ, AP, o[0] = MFMA32(PAF(3), mk8(vfa0, vfa1), o[0]), VRDP(7, vfb0, vfb1), C1, 8); \
    GAPB(AQ, AP, o[1] = MFMA32(PAF(3), mk8(vfb0, vfb1), o[1]), (void)0, C1, 12); \
    } while (0)
#define STEPV(C0, C1, P0, P1, t) do { const unsigned bnext = SBIT((t) + 1); const bool anext = ((t) + 1 < NT) && __any(bnext != 0u); \
    const bool gk_ = ((t) + 3 < NT), gv_ = ((t) + 1 < NT); \
    STEP(C0, C1, P0, P1, t, acur, aprev, gk_, gv_, anext); \
    ENDW(t); RESC(); ROT(); bprev = bcur; aprev = acur; bcur = bnext; acur = anext; } while (0)
#define ENDW(tt) do { if ((tt) + 3 < NT) { WAIT_BAR(2); } else if ((tt) + 2 < NT) { WAIT_BAR(1); } else { WAIT_BAR(0); } } while (0)
    int t = 1;
    for (; t + 1 < NT; t += 2) {
        STEPV(pB0, pB1, pA0, pA1, t);
        STEPV(pA0, pA1, pB0, pB1, t + 1);
    }
    {
        const bool gk_ = false, gv_ = false;
        STEP(pB0, pB1, pA0, pA1, NT - 1, acur, aprev, gk_, gv_, false);
        RESC();
        if (acur) {
            float sacc = pB0[0] + pB0[1]; _Pragma("unroll") for (int r = 2; r < 16; ++r) sacc += pB0[r]; _Pragma("unroll") for (int r = 0; r < 16; ++r) sacc += pB1[r]; l_reg += bcur ? sacc : 0.f;
            const unsigned mw_ = bcur ? 0xFFFFFFFFu : 0u;
            pw0 = (u32x4){PKW(pB0, 0), PKW(pB0, 2), PKW(pB0, 4), PKW(pB0, 6)} & mw_; pw1 = (u32x4){PKW(pB0, 8), PKW(pB0, 10), PKW(pB0, 12), PKW(pB0, 14)} & mw_;
            pw2 = (u32x4){PKW(pB1, 0), PKW(pB1, 2), PKW(pB1, 4), PKW(pB1, 6)} & mw_; pw3 = (u32x4){PKW(pB1, 8), PKW(pB1, 10), PKW(pB1, 12), PKW(pB1, 14)} & mw_;
            SBAR(); pv(o, vb0 + sl_cur, PAF(0), PAF(1), PAF(2), PAF(3)); }
    }
    { auto rr = __builtin_amdgcn_permlane32_swap(__float_as_uint(l_reg), __float_as_uint(l_reg), false, false); l_reg = __uint_as_float(rr[0]) + __uint_as_float(rr[1]); }
    E(o, mhat, l_reg, shm, wid);
    asm volatile("s_waitcnt lgkmcnt(0)\n\ts_barrier" ::: "memory");
#undef DMA_K
#undef DMA_V
#undef SBIT
#undef START
#undef RESC
#undef ROT
#undef PKW
#undef PAF
#undef PIN
#undef MX3
#undef GAPA
#undef GAPB
#undef EX
#undef VRDP
#undef KRD
#undef STEP
#undef STEPV
#undef ENDW
}
struct EpiCmpA { const float* gates; f16* O; int b, g, q0; float& m_out; float& il_out;
    __device__ __forceinline__ void after_q() const {}
    __device__ __forceinline__ void operator()(const f32x16 (&o)[2], float mhat, float l, char* shm, int wid) const {
        const int le = opaque_tid() & 63; const float il = l > 0.f ? __builtin_amdgcn_rcpf(l) : 0.f;
        m_out = mhat; il_out = il;
        stage_rows(o, il, shm, wid, le);
        const f16* stg = (const f16*)(shm + LDS_OST) + wid * 2048;
#pragma unroll
        for (int i = 0; i < 4; ++i) { const int row = i * 8 + (le >> 3), ch = le & 7; const int q = q0 + (row >> 2), hd = 4 * g + (row & 3);
            o_acc8(O + ((size_t)b * SEQ + q) * DM + 512 + hd * HD + ch * 8, gates[((size_t)b * SEQ + q) * 24 + hd * 3], *(const h8*)(stg + row * 64 + ch * 8)); }
    } };
__device__ __forceinline__ float quad_sum2(float v) {
    v += __int_as_float(__builtin_amdgcn_mov_dpp(__float_as_int(v), 0xB1, 0xF, 0xF, true));
    v += __int_as_float(__builtin_amdgcn_mov_dpp(__float_as_int(v), 0x4E, 0xF, 0xF, true));
    return v;
}
constexpr int IMPS = 260;
__device__ __forceinline__ float swap_half(float x, int hi) { auto rr = __builtin_amdgcn_permlane32_swap(__float_as_uint(x), __float_as_uint(x), false, false); return __uint_as_float(hi ? rr[0] : rr[1]); }
__device__ __forceinline__ void unit_imp(const f16* qrow, const f16* __restrict__ Kh, const int nt, const int cmaxq, const float mhat, const float invl, LAS float* improw, char* shm) {
    const int tid = opaque_tid(), lane = tid & 63, r32 = lane & 31, hi = lane >> 5; const int wid = __builtin_amdgcn_readfirstlane(tid >> 6);
    const unsigned lds0 = (unsigned)(uintptr_t)shm;
    const f16* ksrc = Kh + (long)lane * 64 + wid * 8;
    const unsigned kdst = lds0 + LDS_K + wid * 1024;
    const lds_cptr kp0 = (lds_cptr)shm + LDS_K + hi * 1024 + r32 * 16;
#define DMA_K(t, slot) glds16(ksrc + (long)(t) * 4096, (unsigned)__builtin_amdgcn_readfirstlane(kdst + (slot)))
    DMA_K(0, 0); if (nt > 1) DMA_K(1, SLOTB); if (nt > 2) DMA_K(2, 2 * SLOTB);
    h8 qr[4];
#pragma unroll
    for (int d0 = 0; d0 < 4; ++d0) qr[d0] = *reinterpret_cast<const h8*>(qrow + d0 * 16 + hi * 8);
    f32x16 negm;
#pragma unroll
    for (int r = 0; r < 16; ++r) negm[r] = -mhat;
    const bool wr_lane = ((r32 & 3) == 0);
    int slot = 0; float carry = 0.f;
    for (int t = 0; t < nt; ++t) {
        if (t + 1 < nt) { WAIT_BAR(1); } else { WAIT_BAR(0); }
        if (t >= 1 && t + 2 < nt) { const int sp = (slot == 0) ? 2 * SLOTB : slot - SLOTB; DMA_K(t + 2, sp); }
        h8 kf[8]; kload8(kf, kp0 + slot);
        f32x16 p0 = MFMA32(kf[0], qr[0], negm), p1 = MFMA32(kf[1], qr[0], negm);
        p0 = MFMA32(kf[2], qr[1], p0); p1 = MFMA32(kf[3], qr[1], p1);
        p0 = MFMA32(kf[4], qr[2], p0); p1 = MFMA32(kf[5], qr[2], p1);
        p0 = MFMA32(kf[6], qr[3], p0); p1 = MFMA32(kf[7], qr[3], p1);
        const bool band = (64 * t + 63 > __builtin_amdgcn_readfirstlane(cmaxq) - 2);
#pragma unroll
        for (int r = 0; r < 16; ++r) { p0[r] = fexp2(p0[r]) * invl; p1[r] = fexp2(p1[r]) * invl; }
        if (band) {
#pragma unroll
            for (int r = 0; r < 16; ++r) { const int c = 64 * t + crow(r, hi); if (c > cmaxq) p0[r] = 0.f; if (c + 32 > cmaxq) p1[r] = 0.f; }
        }
        float G0[4], L0[4], G1[4], L1[4], R0[4], R1[4];
#pragma unroll
        for (int gq = 0; gq < 4; ++gq) {
            const float a0 = quad_sum2(p0[4 * gq]), a1 = quad_sum2(p0[4 * gq + 1]), a2 = quad_sum2(p0[4 * gq + 2]), a3 = quad_sum2(p0[4 * gq + 3]);
            const float b0 = quad_sum2(p1[4 * gq]), b1 = quad_sum2(p1[4 * gq + 1]), b2 = quad_sum2(p1[4 * gq + 2]), b3 = quad_sum2(p1[4 * gq + 3]);
            G0[gq] = (a0 + a1) + (a2 + a3); L0[gq] = a3; G1[gq] = (b0 + b1) + (b2 + b3); L1[gq] = b3;
        }
#pragma unroll
        for (int gq = 0; gq < 4; ++gq) { R0[gq] = swap_half(L0[gq], hi); R1[gq] = swap_half(L1[gq], hi); }
        if (wr_lane) {
            LAS float* irow = improw + 16 * t + hi;
#pragma unroll
            for (int gq = 0; gq < 4; ++gq) {
                const float prev0 = hi ? R0[gq] : (gq == 0 ? carry : R0[gq > 0 ? gq - 1 : 0]);
                const float prev1 = hi ? R1[gq] : (gq == 0 ? R0[3] : R1[gq > 0 ? gq - 1 : 0]);
                irow[2 * gq] = G0[gq] + prev0; irow[8 + 2 * gq] = G1[gq] + prev1;
            }
        }
        carry = R1[3];
        slot = (slot == 2 * SLOTB) ? 0 : slot + SLOTB;
    }
    asm volatile("s_waitcnt lgkmcnt(0)\n\ts_barrier" ::: "memory");
#undef DMA_K
}
#undef SBAR
#undef WAIT_BAR
}

__device__ __forceinline__ int sl_off(int j) { return 64 * ((j - 1) * 254 - ((j - 1) * j) / 2); }
constexpr int SL_BG = 64 * 32131;
constexpr int PIECE = 1024;
__device__ __forceinline__ void nsa_cmp_unit(const f16* proj, const f16* kcmp, const f16* vcmp, const float* gates, f16* Onsa, unsigned* slist, gu32* scnt, int b, int g, int qt, LAS unsigned char* lds, char* shm) {
    const int tid = opaque_tid(), lane = tid & 63, r32 = lane & 31; const int wid = __builtin_amdgcn_readfirstlane(tid >> 6);
    LAS float* imp = (LAS float*)(lds + fa::LDS_V);
    const int ql = 8 * wid + (r32 >> 2), hd = 4 * g + (r32 & 3), qpos = 64 * qt + ql;
    const int pair = g * 2 + b;
    const f16* kc = kcmp + (size_t)pair * 1024 * HD; const f16* vc = vcmp + (size_t)pair * 1024 * HD;
    const f16* qp = proj + (size_t)(24 + hd) * (NB * SEQ * HD) + ((size_t)b * SEQ + qpos) * HD;
    const int cmaxq = (qpos >= 31) ? ((qpos - 31) >> 4) : -1;
    const int nt = ((4 * qt + 2) >> 6) + 1;
    const int NT = nt < 4 ? 4 : ((nt + 1) & ~1);
    float mrow = 0.f, ilrow = 0.f;
    fa::unit<8, false, true, fa::EpiCmpA, true>(qp, kc, vc, nullptr, nullptr, NT, cmaxq - 64 * (NT - 4), fa::EpiCmpA{gates, Onsa, b, g, 64 * qt + 8 * wid, mrow, ilrow}, shm);
    fa::unit_imp(qp, kc, nt, cmaxq, mrow, ilrow, imp + ql * fa::IMPS, shm);
    const int nfree = qt - 2;
    int vb[8][4];
#pragma unroll
    for (int qi = 0; qi < 8; ++qi) { const LAS float* irow = imp + (8 * wid + qi) * fa::IMPS;
#pragma unroll
        for (int i = 0; i < 4; ++i) { const int j = lane + 64 * i; vb[qi][i] = ((j >= 1) && (j <= qt - 2)) ? __float_as_int(irow[j]) : -1; } }
    int T[8];
#pragma unroll
    for (int qi = 0; qi < 8; ++qi) T[qi] = 0;
    if (nfree > 13) {
        for (int bit = 30; bit >= 0; --bit) {
#pragma unroll
            for (int qi = 0; qi < 8; ++qi) { const int cand = T[qi] | (1 << bit);
                const int cnt = __popcll(__ballot(vb[qi][0] >= cand)) + __popcll(__ballot(vb[qi][1] >= cand)) + __popcll(__ballot(vb[qi][2] >= cand)) + __popcll(__ballot(vb[qi][3] >= cand));
                T[qi] = (cnt >= 13) ? cand : T[qi]; }
        }
    }
    LAS int* lcnt = (LAS int*)lds; LAS int* lbase = lcnt + 256; LAS int* npend = lcnt + 512; LAS unsigned* pendA = (LAS unsigned*)(lds + 4096); LAS unsigned* pendB = (LAS unsigned*)(lds + 8192);
    if (tid < 256) lcnt[tid] = 0; if (tid == 256) *npend = 0;
    __syncthreads();
#pragma unroll
    for (int qi = 0; qi < 8; ++qi) {
        const int q = 8 * wid + qi; bool sfree[4];
        if (nfree <= 13) {
#pragma unroll
            for (int i = 0; i < 4; ++i) sfree[i] = (vb[qi][i] >= 0);
        } else {
            int ngt = 0; unsigned long long eqm[4];
#pragma unroll
            for (int i = 0; i < 4; ++i) { ngt += __popcll(__ballot(vb[qi][i] > T[qi])); eqm[i] = __ballot(vb[qi][i] == T[qi]); }
            const int need_eq = 13 - ngt; int before = 0;
#pragma unroll
            for (int i = 0; i < 4; ++i) { const int rank = before + __builtin_amdgcn_mbcnt_hi((unsigned)(eqm[i] >> 32), __builtin_amdgcn_mbcnt_lo((unsigned)eqm[i], 0));
                sfree[i] = (vb[qi][i] > T[qi]) || ((vb[qi][i] == T[qi]) && rank < need_eq); before += __popcll(eqm[i]); }
        }
        int sbefore = 0;
#pragma unroll
        for (int i = 0; i < 4; ++i) { const int j = lane + 64 * i; const unsigned long long fm = __ballot(sfree[i]);
            if (sfree[i]) { const int slot = sbefore + __builtin_amdgcn_mbcnt_hi((unsigned)(fm >> 32), __builtin_amdgcn_mbcnt_lo((unsigned)fm, 0));
                const int lr = __hip_atomic_fetch_add(lcnt + j, 1, __ATOMIC_RELAXED, __HIP_MEMORY_SCOPE_WORKGROUP);
                const int pi = __hip_atomic_fetch_add(npend, 1, __ATOMIC_RELAXED, __HIP_MEMORY_SCOPE_WORKGROUP);
                pendA[pi] = (unsigned)j | ((unsigned)lr << 8); pendB[pi] = (unsigned)(64 * qt + q) | ((unsigned)slot << 14); }
            sbefore += __popcll(fm); }
    }
    __syncthreads();
    if (tid < 256) { const int c = lcnt[tid]; lbase[tid] = c > 0 ? (int)__hip_atomic_fetch_add(scnt + tid, (unsigned)c, __ATOMIC_RELAXED, __HIP_MEMORY_SCOPE_AGENT) : 0; }
    __syncthreads();
    { const int np = *npend;
      for (int e = tid; e < np; e += 512) { const unsigned pa = pendA[e]; const int j = pa & 255, lr = pa >> 8; slist[sl_off(j) + lbase[j] + lr] = pendB[e]; } }
}

struct SelMergeF {
    static constexpr bool HAS_CS = false;
    const f16* proj; const unsigned char* PO; const float* PML; const float* gates; f16* O; int b, g, qt, nsl;
    int wid_, qpos, hd_, ql; LAS float* wtab;
    __device__ __forceinline__ void init(int wid, int r32, int hi) { wid_ = wid; ql = 8 * wid + (r32 >> 2); hd_ = 4 * g + (r32 & 3); qpos = 64 * qt + ql; }
    __device__ __forceinline__ const f16* qrow() const { return proj + (size_t)(24 + hd_) * (NB * SEQ * HD) + ((size_t)b * SEQ + qpos) * HD; }
    __device__ __forceinline__ int t_begin() const { return 0; }
    __device__ __forceinline__ int t_end() const { return qt >= 2 ? 3 : qt + 1; }
    __device__ __forceinline__ int blk(int t) const { return qt >= 2 ? (t == 0 ? 0 : qt - 2 + t) : t; }
    __device__ __forceinline__ const char* ktile(int t) const { return (const char*)(proj + (size_t)(34 + g) * (NB * SEQ * HD) + (size_t)b * SEQ * HD) + (size_t)blk(t) * 8192; }
    __device__ __forceinline__ const char* vtile(int t) const { return (const char*)(proj + (size_t)(40 + g) * (NB * SEQ * HD) + (size_t)b * SEQ * HD) + (size_t)blk(t) * 8192; }
    __device__ __forceinline__ const float* cs_src(int) const { return nullptr; }
    __device__ __forceinline__ void unit_prep(LAS unsigned char* lds, int) { wtab = (LAS float*)(lds + L_IMP); }
    __device__ __forceinline__ bool active(int) const { return true; }
    __device__ __forceinline__ void mask(f32x16& p0, f32x16& p1, int t, const LAS float*, int hi) const {
        if (blk(t) == qt) {
#pragma unroll
            for (int r = 0; r < 16; ++r) { const int kvp = crow(r, hi); if (kvp > ql) p0[r] = -INFINITY; if (kvp + 32 > ql) p1[r] = -INFINITY; }
        }
    }
    __device__ __forceinline__ void store(const LAS f16* stg, int lane, const LAS float* wsf) const {
        LAS float* tab = wtab + wid_ * 512;
        if (lane < 32) { const int row = lane; const int q = 64 * qt + 8 * wid_ + (row >> 2), hdl = row & 3;
            const float mF = wsf[row], lF = wsf[32 + row]; float M = mF; float ms[13], ls[13];
#pragma unroll
            for (int s_ = 0; s_ < 13; ++s_) { ms[s_] = -INFINITY; ls[s_] = 0.f; if (s_ < nsl) { const f32x2 ml = *(const f32x2*)(PML + 2 * (((size_t)q * 13 + s_) * 4 + hdl)); ms[s_] = ml[0]; ls[s_] = ml[1]; M = fmaxf(M, ml[0]); } }
            const float wF = fexp2(mF - M) * lF; float den = wF; float w[13];
#pragma unroll
            for (int s_ = 0; s_ < 13; ++s_) { w[s_] = (s_ < nsl) ? fexp2(ms[s_] - M) * ls[s_] : 0.f; den += w[s_]; }
            const float rd = 1.f / den; tab[row * 16] = wF * rd;
#pragma unroll
            for (int s_ = 0; s_ < 13; ++s_) tab[row * 16 + 1 + s_] = w[s_] * rd;
        }
        LDS_WAIT();
#pragma unroll
        for (int i = 0; i < 4; ++i) { const int row = i * 8 + (lane >> 3), ch = lane & 7; const int q = 64 * qt + 8 * wid_ + (row >> 2), hdl = row & 3;
            const LAS float* a = tab + row * 16; const h8 own = *(const LAS h8*)(stg + row * 64 + ch * 8);
            float acc[8];
#pragma unroll
            for (int e = 0; e < 8; ++e) acc[e] = a[0] * (float)own[e];
            u32x2 pvs[13];
#pragma unroll
            for (int s_ = 0; s_ < 13; ++s_) pvs[s_] = *(const u32x2*)(PO + (((size_t)q * 13 + (s_ < nsl ? s_ : 0)) * 4 + hdl) * 64 + ch * 8);
#pragma unroll
            for (int s_ = 0; s_ < 13; ++s_) if (s_ < nsl) { const float as = a[1 + s_];
                acc[0] += as * __builtin_amdgcn_cvt_f32_fp8(pvs[s_].x, 0); acc[1] += as * __builtin_amdgcn_cvt_f32_fp8(pvs[s_].x, 1); acc[2] += as * __builtin_amdgcn_cvt_f32_fp8(pvs[s_].x, 2); acc[3] += as * __builtin_amdgcn_cvt_f32_fp8(pvs[s_].x, 3);
                acc[4] += as * __builtin_amdgcn_cvt_f32_fp8(pvs[s_].y, 0); acc[5] += as * __builtin_amdgcn_cvt_f32_fp8(pvs[s_].y, 1); acc[6] += as * __builtin_amdgcn_cvt_f32_fp8(pvs[s_].y, 2); acc[7] += as * __builtin_amdgcn_cvt_f32_fp8(pvs[s_].y, 3); }
            const float g1 = gates[((size_t)b * SEQ + q) * 24 + (4 * g + hdl) * 3 + 1];
            f16* op = O + ((size_t)b * SEQ + q) * DM + 512 + (4 * g + hdl) * HD + ch * 8;
            const h8 c = *(const h8*)op; float r_[8];
#pragma unroll
            for (int e = 0; e < 8; ++e) r_[e] = (float)c[e] + g1 * acc[e];
            u32x4 o4; o4.x = pkh(r_[0], r_[1]); o4.y = pkh(r_[2], r_[3]); o4.z = pkh(r_[4], r_[5]); o4.w = pkh(r_[6], r_[7]);
            *(u32x4*)op = o4; }
        LDS_WAIT();
    }
};
__device__ __forceinline__ void sel_gather_unit(const f16* proj, int b, int g, int j, const unsigned* ent, int cnt, unsigned char* PO, float* PML, LAS unsigned char* lds) {
    const int tid = opaque_tid(), lane = tid & 63, r32 = lane & 31, hi = lane >> 5; const int wid = __builtin_amdgcn_readfirstlane(tid >> 6);
    __syncthreads();
    { KVStage st; kv_issue(st, (const char*)(proj + (size_t)(34 + g) * (NB * SEQ * HD) + (size_t)b * SEQ * HD) + (size_t)j * 8192, (const char*)(proj + (size_t)(40 + g) * (NB * SEQ * HD) + (size_t)b * SEQ * HD) + (size_t)j * 8192, wid, lane); kv_write(st, lds, wid, lane); }
    __syncthreads();
    LAS float* wsf = (LAS float*)(lds + L_WSF) + wid * 64; LAS f16* stg = (LAS f16*)(lds + 32768) + wid * 4096; LAS int* tab = (LAS int*)(lds + L_SEL) + wid * 64;
    LAS float* rinv = (LAS float*)(lds + 98304) + wid * 64;
    const f16* qbase = proj + (size_t)(24 + 4 * g + (r32 & 3)) * (NB * SEQ * HD) + (size_t)b * SEQ * HD;
    const int nch = (cnt + 7) >> 3, el = r32 >> 2;
    int codeN[2]; h8 qn[2][4];
#pragma unroll
    for (int k = 0; k < 2; ++k) { const int c = 2 * wid + k; codeN[k] = (c < nch && 8 * c + el < cnt) ? (int)ent[8 * c + el] : -1;
        const f16* qp = qbase + (size_t)((codeN[k] < 0 ? 0 : codeN[k]) & 16383) * HD;
#pragma unroll
        for (int d0 = 0; d0 < 4; ++d0) qn[k][d0] = *(const h8*)(qp + 16 * d0 + 8 * hi); }
    for (int c0 = 2 * wid; c0 < nch; c0 += 16) {
        int code[2]; h8 qr[2][4];
#pragma unroll
        for (int k = 0; k < 2; ++k) { code[k] = codeN[k];
#pragma unroll
            for (int d0 = 0; d0 < 4; ++d0) qr[k][d0] = qn[k][d0]; }
#pragma unroll
        for (int k = 0; k < 2; ++k) { const int c = c0 + 16 + k; codeN[k] = (c < nch && 8 * c + el < cnt) ? (int)ent[8 * c + el] : -1;
            const f16* qp = qbase + (size_t)((codeN[k] < 0 ? 0 : codeN[k]) & 16383) * HD;
#pragma unroll
            for (int d0 = 0; d0 < 4; ++d0) qn[k][d0] = *(const h8*)(qp + 16 * d0 + 8 * hi); }
        f32x16 p0[2], p1[2], o[2][2]; float m[2], l[2];
#pragma unroll
        for (int k = 0; k < 2; ++k) qk_tile(p0[k], p1[k], lds, qr[k], r32, hi);
#pragma unroll
        for (int k = 0; k < 2; ++k) { m[k] = rowmax32(p0[k], p1[k]); l[k] = 0.f;
#pragma unroll
            for (int r = 0; r < 16; ++r) { p0[k][r] = fexp2(p0[k][r] - m[k]); p1[k][r] = fexp2(p1[k][r] - m[k]); l[k] += p0[k][r] + p1[k][r]; } }
#pragma unroll
        for (int k = 0; k < 2; ++k) {
#pragma unroll
            for (int r = 0; r < 16; ++r) { o[k][0][r] = 0.f; o[k][1][r] = 0.f; }
            u32x4 pw[4]; pack_p(pw, p0[k], p1[k]); pv_tile(o[k], lds + 8192, pw, lane, hi); l[k] = swapsum(l[k]); }
#pragma unroll
        for (int k = 0; k < 2; ++k) { const bool valid = code[k] >= 0; const int dst = valid ? (((code[k] & 16383) * 13 + (code[k] >> 14)) * 4 + (r32 & 3)) : -1;
            if (hi == 0) { tab[32 * k + r32] = dst; rinv[32 * k + r32] = 1.f / l[k]; if (valid) { f32x2 ml = {m[k], l[k]}; *(f32x2*)(PML + 2 * (size_t)dst) = ml; } } }
        LDS_WAIT();
#pragma unroll
        for (int k = 0; k < 2; ++k)
#pragma unroll
            for (int r = 0; r < 16; ++r) { const int orow = crow(r, hi); const float rl = rinv[32 * k + orow];
                stg[(32 * k + orow) * 64 + r32] = (f16)(o[k][0][r] * rl); stg[(32 * k + orow) * 64 + 32 + r32] = (f16)(o[k][1][r] * rl); }
        LDS_WAIT();
#pragma unroll
        for (int i = 0; i < 8; ++i) { const int row = i * 8 + (lane >> 3), ch = lane & 7; const int d = tab[row];
            if (d >= 0) { const h8 v = *(const LAS h8*)(stg + row * 64 + ch * 8); u32x2 w = {0u, 0u};
                w.x = __builtin_amdgcn_cvt_pk_fp8_f32((float)v[0], (float)v[1], w.x, false); w.x = __builtin_amdgcn_cvt_pk_fp8_f32((float)v[2], (float)v[3], w.x, true);
                w.y = __builtin_amdgcn_cvt_pk_fp8_f32((float)v[4], (float)v[5], w.y, false); w.y = __builtin_amdgcn_cvt_pk_fp8_f32((float)v[6], (float)v[7], w.y, true);
                *(u32x2*)(PO + (size_t)d * 64 + ch * 8) = w; } }
        LDS_WAIT();
    }
    (void)wsf;
}
constexpr int LIST_BH = 256 * 2016;
__device__ __forceinline__ int list_off(int j) { return 256 * (63 * j - (j * (j - 1)) / 2); }
__device__ __forceinline__ void top3_ins(float s, int n, float& v0, float& v1, float& v2, int& i0, int& i1, int& i2) {
    const bool g0 = s > v0, g1 = s > v1, g2 = s > v2;
    v2 = g1 ? v1 : (g2 ? s : v2); i2 = g1 ? i1 : (g2 ? n : i2);
    v1 = g0 ? v0 : (g1 ? s : v1); i1 = g0 ? i0 : (g1 ? n : i1);
    v0 = g0 ? s : v0; i0 = g0 ? n : i0;
}
__device__ __forceinline__ void top3_ins_tie(float s, int n, float& v0, float& v1, float& v2, int& i0, int& i1, int& i2) {
    const bool g0 = s > v0 || (s == v0 && n < i0), g1 = s > v1 || (s == v1 && n < i1), g2 = s > v2 || (s == v2 && n < i2);
    v2 = g1 ? v1 : (g2 ? s : v2); i2 = g1 ? i1 : (g2 ? n : i2);
    v1 = g0 ? v0 : (g1 ? s : v1); i1 = g0 ? i0 : (g1 ? n : i1);
    v0 = g0 ? s : v0; i0 = g0 ? n : i0;
}
__device__ __forceinline__ float swapf(float x) { auto rr = __builtin_amdgcn_permlane32_swap(__float_as_uint(x), __float_as_uint(x), false, false); const int hi = (opaque_tid() >> 5) & 1; return __uint_as_float(hi ? rr[0] : rr[1]); }
__device__ __forceinline__ void moba_gate_unit(const f16* qslot, const f16* kimg, unsigned short* lists, gu32* cnt, int unit, LAS unsigned char* lds) {
    const int tid = opaque_tid(), lane = tid & 63, r32 = lane & 31, hi = lane >> 5; const int wid = __builtin_amdgcn_readfirstlane(tid >> 6);
    const int bh = unit >> 6, blk = unit & 63;
    LAS int* lcnt = (LAS int*)(lds + 16384); LAS int* lbase = lcnt + 64;
    __syncthreads();
    { const u32x4* src = (const u32x4*)(kimg + (size_t)bh * 8192); LAS u32x4* dst = (LAS u32x4*)lds; dst[tid] = src[tid]; dst[tid + 512] = src[tid + 512]; }
    if (tid < 64) lcnt[tid] = 0;
    __syncthreads();
    const int qpos = 256 * blk + 32 * wid + r32;
    const f16* qp = qslot + ((size_t)bh * SEQ + qpos) * HD;
    h8 qr[4];
#pragma unroll
    for (int d0 = 0; d0 < 4; ++d0) qr[d0] = *(const h8*)(qp + 16 * d0 + 8 * hi);
    float v0 = -INFINITY, v1 = -INFINITY, v2 = -INFINITY; int i0 = -1, i1 = -1, i2 = -1;
    if (blk > 0) {
        f32x16 ph0, ph1, pl0, pl1;
        qk_tile(ph0, ph1, lds, qr, r32, hi); qk_tile(pl0, pl1, lds + 8192, qr, r32, hi);
#pragma unroll
        for (int r = 0; r < 16; ++r) { const int n = crow(r, hi); const float g = ph0[r] + pl0[r] * (1.f / 4096.f); if (n < blk) top3_ins(g, n, v0, v1, v2, i0, i1, i2); }
#pragma unroll
        for (int r = 0; r < 16; ++r) { const int n = 32 + crow(r, hi); const float g = ph1[r] + pl1[r] * (1.f / 4096.f); if (n < blk) top3_ins(g, n, v0, v1, v2, i0, i1, i2); }
        const float w0 = swapf(v0), w1 = swapf(v1), w2 = swapf(v2); const int j0 = __float_as_int(swapf(__int_as_float(i0))), j1 = __float_as_int(swapf(__int_as_float(i1))), j2 = __float_as_int(swapf(__int_as_float(i2)));
        if (j0 >= 0) top3_ins_tie(w0, j0, v0, v1, v2, i0, i1, i2);
        if (j1 >= 0) top3_ins_tie(w1, j1, v0, v1, v2, i0, i1, i2);
        if (j2 >= 0) top3_ins_tie(w2, j2, v0, v1, v2, i0, i1, i2);
    }
    const bool own = (hi == 0);
    int r0 = 0, r1 = 0, r2 = 0;
    if (own && i0 >= 0) r0 = __hip_atomic_fetch_add(lcnt + i0, 1, __ATOMIC_RELAXED, __HIP_MEMORY_SCOPE_WORKGROUP);
    if (own && i1 >= 0) r1 = __hip_atomic_fetch_add(lcnt + i1, 1, __ATOMIC_RELAXED, __HIP_MEMORY_SCOPE_WORKGROUP);
    if (own && i2 >= 0) r2 = __hip_atomic_fetch_add(lcnt + i2, 1, __ATOMIC_RELAXED, __HIP_MEMORY_SCOPE_WORKGROUP);
    __syncthreads();
    if (tid < 64) { const int c = lcnt[tid]; lbase[tid] = c > 0 ? (int)__hip_atomic_fetch_add(cnt + bh * 64 + tid, (unsigned)c, __ATOMIC_RELAXED, __HIP_MEMORY_SCOPE_AGENT) : 0; }
    __syncthreads();
    unsigned short* lb = lists + (size_t)bh * LIST_BH;
    if (own && i0 >= 0) lb[list_off(i0) + lbase[i0] + r0] = (unsigned short)(qpos);
    if (own && i1 >= 0) lb[list_off(i1) + lbase[i1] + r1] = (unsigned short)(qpos | (1 << 14));
    if (own && i2 >= 0) lb[list_off(i2) + lbase[i2] + r2] = (unsigned short)(qpos | (2 << 14));
}
__device__ __forceinline__ void moba_gather_unit3(const f16* qs, const f16* kblk, const f16* vblk, const unsigned short* ent, int n, int hh, f16* PO, float* PML, LAS unsigned char* lds, char* shm) {
    const int tid = opaque_tid(), lane = tid & 63; const int wid = __builtin_amdgcn_readfirstlane(tid >> 6);
    __syncthreads();
#pragma unroll
    for (int t = 0; t < 4; ++t) { KVStage st; kv_issue(st, (const char*)kblk + t * 8192, (const char*)vblk + t * 8192, wid, lane);
        *(LAS u32x4*)(lds + t * 8192 + wid * 1024 + lane * 16) = st.k; *(LAS u32x4*)(lds + fa::RES_V + t * 8192 + wid * 1024 + lane * 16) = st.v; }
    __syncthreads();
    const int qoff = wid < 4 ? 32768 + wid * 4096 : fa::RES_V + 32768 + (wid - 4) * 4096;
    const unsigned qst = (unsigned)(uintptr_t)shm + (unsigned)qoff;
    int codeN = (wid * 32 + (lane & 31) < n) ? (int)ent[wid * 32 + (lane & 31)] : -1;
    { fa::EpiPartial pre{PO, PML, -1, qs, codeN, qst}; pre.after_q(); }
    for (int c = wid; c * 32 < n; c += 8) {
        const int code = codeN;
        { const int e2 = (c + 8) * 32 + (opaque_tid() & 31); codeN = (e2 < n) ? (int)ent[e2] : -1; }
        const int dst = code >= 0 ? (hh * SEQ + (code & 16383)) * 3 + (code >> 14) : -1;
        asm volatile("s_waitcnt vmcnt(0)" ::: "memory");
        fa::unit<8, false, false, fa::EpiPartial, false, true>((const f16*)(shm + qoff) + (opaque_tid() & 31) * HD, nullptr, nullptr, nullptr, nullptr, 4, fa::QREL_ROW, fa::EpiPartial{PO, PML, dst, qs, codeN, qst}, shm);
    }
}
__device__ __forceinline__ void fox_norm_unit(const f16* qb_, const f16* kb_, float* qn2, float* qdmin, gu32* kn2, LAS unsigned char* lds) {
    const int tid = opaque_tid(); const int t = tid & 255; const bool isq = tid < 256;
    const f16* rp = (isq ? qb_ : kb_) + (size_t)t * HD; const f16* kp = kb_ + (size_t)t * HD;
    float s = 0.f, d = 0.f;
#pragma unroll
    for (int c = 0; c < 8; ++c) { const h8 x = *(const h8*)(rp + 8 * c); const h8 y = *(const h8*)(kp + 8 * c);
#pragma unroll
        for (int e = 0; e < 8; ++e) { s += (float)x[e] * (float)x[e]; d += (float)x[e] * (float)y[e]; } }
#pragma unroll
    for (int o = 1; o < 64; o <<= 1) { s = fmaxf(s, __shfl_xor(s, o)); d = fminf(d, __shfl_xor(d, o)); }
    LAS float* red = (LAS float*)lds;
    __syncthreads();
    if ((tid & 63) == 0) { red[tid >> 6] = s; red[8 + (tid >> 6)] = d; }
    __syncthreads();
    if (tid == 0) { *qn2 = fmaxf(fmaxf(red[0], red[1]), fmaxf(red[2], red[3])); *qdmin = fminf(fminf(red[8], red[9]), fminf(red[10], red[11])); }
    if (tid == 256) (void)__hip_atomic_fetch_max(kn2, __float_as_uint(fmaxf(fmaxf(red[4], red[5]), fmaxf(red[6], red[7]))), __ATOMIC_RELAXED, __HIP_MEMORY_SCOPE_AGENT);
}
__device__ __forceinline__ void kbar_block(const f16* kslot, f16* kimg, int unit, int lane) {
    const int kg = lane >> 3, dc = lane & 7;
    const f16* kp = kslot + ((size_t)(unit >> 6) * SEQ + 256 * (unit & 63)) * HD + dc * 8;
    float a[8];
#pragma unroll
    for (int e = 0; e < 8; ++e) a[e] = 0.f;
#pragma unroll 1
    for (int i0 = 0; i0 < 32; i0 += 8) {
        h8 x[8];
#pragma unroll
        for (int i = 0; i < 8; ++i) x[i] = *(const h8*)(kp + (size_t)(kg + 8 * (i0 + i)) * HD);
#pragma unroll
        for (int i = 0; i < 8; ++i)
#pragma unroll
            for (int e = 0; e < 8; ++e) a[e] += (float)x[i][e]; }
#pragma unroll
    for (int e = 0; e < 8; ++e) { a[e] += __shfl_xor(a[e], 8); a[e] += __shfl_xor(a[e], 16); a[e] += __shfl_xor(a[e], 32); }
    if (kg == 0) {
        h8 hi8, lo8;
#pragma unroll
        for (int e = 0; e < 8; ++e) { const float mval = a[e] * (1.f / 256.f); const f16 hh = (f16)mval; hi8[e] = hh; lo8[e] = (f16)((mval - (float)hh) * 4096.f); }
        f16* ib = kimg + (size_t)(unit >> 6) * 8192 + dc * 512 + (unit & 63) * 8;
        *(h8*)ib = hi8; *(h8*)(ib + 4096) = lo8;
    }
}
__device__ __forceinline__ void scan_bh(const float* logf, float* c, LAS unsigned char* lds) {
    const int tid = opaque_tid(), lane = tid & 63, wid = tid >> 6;
    LAS double* wsum = (LAS double*)lds;
    float x[32]; double run = 0.0;
#pragma unroll
    for (int i = 0; i < 8; ++i) { const f32x4 v = *(const f32x4*)(logf + tid * 32 + 4 * i); x[4 * i] = v[0]; x[4 * i + 1] = v[1]; x[4 * i + 2] = v[2]; x[4 * i + 3] = v[3]; }
#pragma unroll
    for (int i = 0; i < 32; ++i) run += (double)x[i];
    double inc = run;
#pragma unroll
    for (int o = 1; o < 64; o <<= 1) { const double y = __shfl_up(inc, o); if (lane >= o) inc += y; }
    __syncthreads();
    if (lane == 63) wsum[wid] = inc;
    __syncthreads();
    double base = inc - run;
    for (int w = 0; w < wid; ++w) base += wsum[w];
    double acc = base;
#pragma unroll
    for (int i = 0; i < 8; ++i) { f32x4 o;
#pragma unroll
        for (int j = 0; j < 4; ++j) { acc += (double)x[4 * i + j]; o[j] = (float)(acc * (double)LOG2E); }
        *(f32x4*)(c + tid * 32 + 4 * i) = o; }
    __syncthreads();
}

typedef f16 ytype;
#define YF16 1
template <int NR, bool LAST> __device__ __forceinline__ void norm_rows(const f16* xin, const f16* y, f16* xout, float* rsout, float* fout, const float* gpost, size_t rstride, int lane) {
    h8 xw[NR][2], yw[NR][2];
#pragma unroll
    for (int k = 0; k < NR; ++k)
#pragma unroll
        for (int j = 0; j < 2; ++j) { xw[k][j] = *(const h8*)(xin + k * rstride + 8 * lane + 512 * j); yw[k][j] = *(const h8*)(y + k * rstride + 8 * lane + 512 * j); }
    f32x4 gp[2][2];
#pragma unroll
    for (int j = 0; j < 2; ++j) { gp[j][0] = *(const f32x4*)(gpost + 8 * lane + 512 * j); gp[j][1] = *(const f32x4*)(gpost + 8 * lane + 512 * j + 4); }
#pragma unroll
    for (int k = 0; k < NR; ++k) {
        float yv[2][8]; float ss = 0.f;
#pragma unroll
        for (int j = 0; j < 2; ++j)
#pragma unroll
            for (int e = 0; e < 8; ++e) { yv[j][e] = (float)yw[k][j][e]; ss += yv[j][e] * yv[j][e]; }
        const float rs = 1.f / sqrtf(wave_sum(ss) * (1.f / DM) + RMS_EPS);
        float xn[2][8]; float s2 = 0.f;
#pragma unroll
        for (int j = 0; j < 2; ++j)
#pragma unroll
            for (int e = 0; e < 8; ++e) { xn[j][e] = (float)xw[k][j][e] + yv[j][e] * rs * gp[j][e >> 2][e & 3]; s2 += xn[j][e] * xn[j][e]; }
        if (LAST) {
#pragma unroll
            for (int j = 0; j < 2; ++j) { float* op = fout + k * rstride + 8 * lane + 512 * j;
                *(f32x4*)op = (f32x4){xn[j][0], xn[j][1], xn[j][2], xn[j][3]}; *(f32x4*)(op + 4) = (f32x4){xn[j][4], xn[j][5], xn[j][6], xn[j][7]}; }
        } else {
            const float r2 = 1.f / sqrtf(wave_sum(s2) * (1.f / DM) + RMS_EPS);
#pragma unroll
            for (int j = 0; j < 2; ++j) { u32x4 w; w.x = pkh(xn[j][0], xn[j][1]); w.y = pkh(xn[j][2], xn[j][3]); w.z = pkh(xn[j][4], xn[j][5]); w.w = pkh(xn[j][6], xn[j][7]);
                *(u32x4*)(xout + k * rstride + 8 * lane + 512 * j) = w; }
            if (lane == 0) rsout[k * (rstride / DM)] = r2;
        }
    }
}
__device__ __forceinline__ void norm0_row(const float* xin, f16* xh, float* rsout, int lane) {
    f32x4 xv[4]; float s2 = 0.f;
#pragma unroll
    for (int j = 0; j < 4; ++j) { xv[j] = *(const f32x4*)(xin + 4 * lane + 256 * j); s2 += (xv[j][0] * xv[j][0] + xv[j][1] * xv[j][1]) + (xv[j][2] * xv[j][2] + xv[j][3] * xv[j][3]); }
    const float r2 = 1.f / sqrtf(wave_sum(s2) * (1.f / DM) + RMS_EPS);
#pragma unroll
    for (int j = 0; j < 4; ++j) { u32x2 w; w.x = pkh(xv[j][0], xv[j][1]); w.y = pkh(xv[j][2], xv[j][3]); *(u32x2*)(xh + 4 * lane + 256 * j) = w; }
    if (lane == 0) *rsout = r2;
}

struct RmId { __device__ __forceinline__ int operator()(int n) const { return n; } };
struct RmGate { int off; __device__ __forceinline__ int operator()(int n) const { return (n >> 7) * 256 + off + (n & 127); } };
__device__ __forceinline__ int slot_row(int hs, int d) { return (hs >> 2) * 256 + (d >> 5) * 128 + (hs & 3) * 32 + (d & 31); }
struct RmIn0 { __device__ __forceinline__ int operator()(int n) const {
    int hs, d;
    if (n < 1536) { hs = n >> 6; d = n & 63; }
    else if (n < 1544) { hs = 38; d = n - 1536; }
    else if (n < 2056) { hs = 24 + ((n - 1544) >> 6); d = (n - 1544) & 63; }
    else if (n < 2184) { hs = 32 + ((n - 2056) >> 6); d = (n - 2056) & 63; }
    else if (n < 2312) { hs = 40 + ((n - 2184) >> 6); d = (n - 2184) & 63; }
    else if (n < 2440) { hs = 34 + ((n - 2312) >> 6); d = (n - 2312) & 63; }
    else if (n < 2568) { hs = 42 + ((n - 2440) >> 6); d = (n - 2440) & 63; }
    else if (n < 2696) { hs = 36 + ((n - 2568) >> 6); d = (n - 2568) & 63; }
    else if (n < 2824) { hs = 44 + ((n - 2696) >> 6); d = (n - 2696) & 63; }
    else { hs = 38; d = 8 + (n - 2824); }
    return slot_row(hs, d); } };
struct RmIn1 { __device__ __forceinline__ int operator()(int n) const { return slot_row(n >> 6, n & 63); } };
template <class RM> __device__ __forceinline__ void transpose_item(const float* W, int K, int N, f16* WT, const RM rm, LAS float* scr, int item, int lane, const float* gk = nullptr) {
    const int nblk = N / 32, kb = item / nblk, nb = item % nblk, k0 = 64 * kb, n0 = 32 * nb;
    float wv[32];
#pragma unroll
    for (int i = 0; i < 32; ++i) { const int kk = 2 * i + (lane >> 5); wv[i] = W[(size_t)(k0 + kk) * N + n0 + (lane & 31)]; }
#pragma unroll
    for (int i = 0; i < 32; ++i) { const int kk = 2 * i + (lane >> 5); scr[kk * 33 + (lane & 31)] = gk ? wv[i] * gk[k0 + kk] : wv[i]; }
    LDS_WAIT(); asm volatile("" ::: "memory");
    const int c = lane & 7;
#pragma unroll
    for (int j = 0; j < 4; ++j) { const int n = (lane >> 3) + 8 * j; const LAS float* s = scr + (8 * c) * 33 + n;
        u32x4 o; o.x = pkh(s[0 * 33], s[1 * 33]); o.y = pkh(s[2 * 33], s[3 * 33]); o.z = pkh(s[4 * 33], s[5 * 33]); o.w = pkh(s[6 * 33], s[7 * 33]);
        *(u32x4*)(WT + (size_t)rm(n0 + n) * K + k0 + 8 * c) = o; }
    LDS_WAIT(); asm volatile("" ::: "memory");
}

constexpr int N_PHASES = 30;
struct Args { const float* in[19]; float* out; unsigned char* ws; int ph_lo, ph_hi, rep, pad; };
static_assert(sizeof(Args) == 184 && offsetof(Args, out) == 152 && offsetof(Args, ws) == 160 && offsetof(Args, ph_lo) == 168, "kernarg offsets used by arg_in()");
__device__ __forceinline__ int q_next(gu32* ctr, volatile LAS int* slot, int) {
    __syncthreads();
    if (threadIdx.x == 0) *slot = (int)__hip_atomic_fetch_add(ctr, 1u, __ATOMIC_RELAXED, __HIP_MEMORY_SCOPE_AGENT);
    __syncthreads();
    return *slot;
}
__device__ __forceinline__ const float* arg_in(int k) { const CAS char* kp = (const CAS char*)__builtin_amdgcn_kernarg_segment_ptr(); asm volatile("" : "+s"(kp)); return *(const float* const CAS*)(kp + 8 * k); }
__device__ __forceinline__ f16* slot_ptr(unsigned char* ws, int slot, int b) { return (f16*)(ws + WS_PROJ) + ((size_t)slot * NB + b) * SEQ * HD; }

__global__ void __launch_bounds__(512, 2) trunk_fwd(Args args) {
    extern __shared__ __attribute__((aligned(16))) unsigned char lds_raw[];
    LAS unsigned char* lds = (LAS unsigned char*)lds_raw;
    volatile LAS unsigned* MISC = (volatile LAS unsigned*)(lds + L_MISC);
    volatile LAS int* qslot = (volatile LAS int*)(lds + L_MISC);
    const int G = gridDim.x, bid = blockIdx.x, NGW = G * 8;
    const int qrep = 8 * ((const CAS int*)__builtin_amdgcn_kernarg_segment_ptr())[44];
    unsigned char* ws_ = (unsigned char*)arg_in(20);
    gu32* ctl = (gu32*)(ws_ + WS_CTL);
#define PH_LOCALS unsigned char* ws = ws_; asm volatile("" : "+s"(ws)); const int tid = opaque_tid(), lane = tid & 63; const int wave = __builtin_amdgcn_readfirstlane(tid >> 6); const int gw = bid * 8 + wave; \
    f16* Hb = (f16*)(ws + WS_H); f16* Xh = (f16*)arg_in(19); float* RSb = (float*)(ws + WS_RS); f16* Ob = (f16*)(ws + WS_O); ytype* Yh = (ytype*)(ws + WS_Y); f16* PROJ = (f16*)(ws + WS_PROJ); f16* HID = (f16*)(ws + WS_PROJ); \
    (void)tid; (void)lane; (void)wave; (void)gw; (void)Hb; (void)Xh; (void)RSb; (void)Ob; (void)Yh; (void)PROJ; (void)HID
    if (threadIdx.x < 64) MISC[threadIdx.x] = 0u;
    __syncthreads();
    XcdBarrier bar; bar.bar = (unsigned*)(ctl + CW_BAR); bar.x = 0; bar.st = nullptr;
    if (N_LAUNCH_MODE) bar = xcd_barrier_post((unsigned*)(ctl + CW_BAR), MISC + 8);
    const int lo = ((const CAS int*)__builtin_amdgcn_kernarg_segment_ptr())[42], hi_ = ((const CAS int*)__builtin_amdgcn_kernarg_segment_ptr())[43];
#ifndef PH_MASK
#define PH_MASK 0x3FFu
#endif
#define IN(k) (lo <= (k) && (k) < hi_)
#define INR(r) (IN(pb + (r)))
#define SNAKE(i) ((i) * G + (((i) & 1) ? (G - 1 - bid) : bid))
#define SEAM(k) do { if (IN(k) && IN((k) + 1)) xcd_barrier(bar); } while (0)

    (void)args;

    if (IN(0)) {
        PH_LOCALS;
        LAS float* scr = (LAS float*)(lds + wave * 16384);
        constexpr int I_IN0 = 16 * 89, I_OUT = 16 * 32, I_IN1 = 16 * 96, I_GU = 16 * 88, I_DN = 44 * 32, I_C1 = 32 * 8, I_C2 = 4 * 2;
        constexpr int E0 = I_IN0, E1 = E0 + I_OUT, E2 = E1 + I_IN1, E3 = E2 + I_OUT, E4 = E3 + 4 * I_GU, E5 = E4 + 2 * I_DN, E6 = E5 + 2 * I_C1, E7 = E6 + 2 * I_C2;
        constexpr int Z0 = E7 + 224, Z1 = Z0 + 384, R0 = Z1 + (SEQ * 32) / 64, NBI = 64, CB = R0 + NBI;
        constexpr int SC = CB - E7;
        for (int itr = gw; itr < CB; itr += NGW) {
            const int it = itr < NBI ? R0 + itr : (itr < NBI + (R0 - Z1) ? Z1 + (itr - NBI) : (itr < SC ? E7 + (itr - NBI - (R0 - Z1)) : itr - SC));
            if (it < E0) { transpose_item(arg_in(1), 1024, EVEN_IN, (f16*)(ws + WS_W_IN0), RmIn0{}, scr, it, lane, arg_in(12)); }
            else if (it < E1) { transpose_item(arg_in(9), 1024, 1024, (f16*)(ws + WS_W_OUT0), RmId{}, scr, it - E0, lane); }
            else if (it < E2) { transpose_item(arg_in(10), 1024, 3072, (f16*)(ws + WS_W_IN1), RmIn1{}, scr, it - E1, lane, arg_in(12) + DM); }
            else if (it < E3) { transpose_item(arg_in(11), 1024, 1024, (f16*)(ws + WS_W_OUT1), RmId{}, scr, it - E2, lane); }
            else if (it < E4) { const int r = it - E3, w = r / I_GU, i = r % I_GU; const int layer = w >> 1, up = w & 1;
                transpose_item(arg_in(up ? 17 : 16) + (size_t)layer * 1024 * FF, 1024, FF, (f16*)(ws + (layer ? WS_W_GU1 : WS_W_GU0)), RmGate{up * 128}, scr, i, lane, arg_in(14) + layer * DM); }
            else if (it < E5) { const int r = it - E4, layer = r / I_DN, i = r % I_DN;
                transpose_item(arg_in(18) + (size_t)layer * FF * 1024, FF, 1024, (f16*)(ws + (layer ? WS_W_DN1 : WS_W_DN0)), RmId{}, scr, i, lane); }
            else if (it < E6) { const int r = it - E5, w = r / I_C1, i = r % I_C1;
                transpose_item(arg_in(w ? 7 : 4), 2048, 256, (f16*)(ws + (w ? WS_W_C1V : WS_W_C1K)), RmId{}, scr, i, lane); }
            else if (it < E7) { const int r = it - E6, w = r / I_C2, i = r % I_C2;
                transpose_item(arg_in(w ? 8 : 5), 256, 64, (f16*)(ws + (w ? WS_W_C2V : WS_W_C2K)), RmId{}, scr, i, lane); }
            else if (it < Z0) { const int r = it - E7; int row;
                if (r < 32) row = slot_row(38, 32 + r); else if (r < 96) row = slot_row(39, r - 32); else if (r < 160) row = slot_row(46, r - 96); else row = slot_row(47, r - 160);
                u32x4 z = {0u, 0u, 0u, 0u}; u32x4* p = (u32x4*)((f16*)(ws + WS_W_IN0) + (size_t)row * 1024); p[lane] = z; p[lane + 64] = z; }
            else if (it < Z1) { const int r = it - Z0, w = r / 192, row = 64 + r % 192;
                if (lane < 32) ((u32x4*)((f16*)(ws + (w ? WS_W_C2V : WS_W_C2K)) + (size_t)row * 256))[lane] = (u32x4){0u, 0u, 0u, 0u}; }
            else if (it < R0) { const int e = (it - Z1) * 64 + lane; const int pos = e >> 5, i = e & 31;
                constexpr float INVF[32] = {1.000000000e+00f, 7.498942018e-01f, 5.623413324e-01f, 4.216965139e-01f, 3.162277639e-01f, 2.371373773e-01f, 1.778279394e-01f, 1.333521456e-01f, 1.000000015e-01f, 7.498942316e-02f, 5.623413250e-02f, 4.216964915e-02f, 3.162277490e-02f, 2.371373773e-02f, 1.778279431e-02f, 1.333521400e-02f, 9.999999776e-03f, 7.498942316e-03f, 5.623413250e-03f, 4.216964822e-03f, 3.162277630e-03f, 2.371373819e-03f, 1.778279431e-03f, 1.333521446e-03f, 1.000000047e-03f, 7.498941850e-04f, 5.623413017e-04f, 4.216965172e-04f, 3.162277571e-04f, 2.371373703e-04f, 1.778279402e-04f, 1.333521504e-04f};
                const float ang = (float)pos * INVF[i];
                const double a_ = (double)ang, kk_ = rint(a_ * 0.15915494309189535); double r_ = fma(-kk_, 6.283185307179586, a_); r_ = fma(-kk_, 2.4492935982947064e-16, r_);
                const float rf_ = (float)r_;
                ((float*)(ws + WS_COS))[e] = cosf(rf_); ((float*)(ws + WS_SIN))[e] = sinf(rf_); }
            else { const int r = it - R0, part = r >> 3, w = (r >> 2) & 1, n = (r & 3) * 64 + lane;
                const float* pe = arg_in(w ? 6 : 3) + 256 * part; const float* w1 = arg_in(w ? 7 : 4) + (size_t)256 * part * 256; float sa[8];
#pragma unroll
                for (int i = 0; i < 8; ++i) sa[i] = 0.f;
                for (int k = 0; k < 256; k += 8) {
#pragma unroll
                    for (int i = 0; i < 8; ++i) sa[i] += pe[k + i] * w1[(size_t)(k + i) * 256 + n]; }
                ((float*)(ws + WS_CBIAS))[part * 512 + w * 256 + n] = ((sa[0] + sa[1]) + (sa[2] + sa[3])) + ((sa[4] + sa[5]) + (sa[6] + sa[7])); }
        }
        const float* xin0 = arg_in(0);
        for (int m = gw; m < MROWS / 2; m += NGW) { norm0_row(xin0 + (size_t)m * DM, Xh + (size_t)m * DM, RSb + m, lane); norm0_row(xin0 + (size_t)(m + MROWS / 2) * DM, Xh + (size_t)(m + MROWS / 2) * DM, RSb + m + MROWS / 2, lane); }
    }
    SEAM(0);

    for (int layer = 0; layer < 2; ++layer) {
        const int pb = 1 + 17 * layer;
        const int ro = layer == 0 ? 12 : 7;
        if (INR(0)) {
            PH_LOCALS;
            pg8::Gemm g{Xh, (const f16*)(ws + (layer ? WS_W_IN1 : WS_W_IN0)), 1024, 1024}; pg8::StaticOrder S; S.init(MROWS, NIN, G, bid);
            pg8::EpiInProj E{PROJ, (const float*)(ws + WS_COS), (const float*)(ws + WS_SIN), (float*)(ws + WS_LOGF), (float*)(ws + WS_GATES), arg_in(2), layer, RSb};
            pg8::gemm_phase<pg8::EpiInProj, pg8::StaticOrder, true>(lds, g, S, E);
        }
        SEAM(pb);
        if (layer == 0) {
            if (INR(1)) {
                PH_LOCALS;
                if (bid < 16) scan_bh((const float*)(ws + WS_LOGF) + (size_t)bid * SEQ, (float*)(ws + WS_C) + (size_t)bid * SEQ, lds);
                for (int u = bid; u < 1024; u += G) { const int bh = u >> 6, blk = u & 63, b = bh >> 3, h = bh & 7;
                    fox_norm_unit(slot_ptr(ws, h, b) + (size_t)256 * blk * HD, slot_ptr(ws, 8 + h, b) + (size_t)256 * blk * HD, (float*)(ws + WS_QN2) + u, (float*)(ws + WS_QN2) + 1024 + u, ctl + CW_KN2 + bh, lds); }
            }
            SEAM(pb + 1);
            if (INR(2)) {
                PH_LOCALS;
                if (bid < 32) {
                    const int which = bid >> 4, pm = bid & 15;
                    int c1k = 2048, c1lda = 1024, c2k = 256; asm volatile("" : "+s"(c1k), "+s"(c1lda), "+s"(c2k));
                    f16* hid = (f16*)(ws + (which ? WS_HIDV : WS_HIDK));
                    { pg8::Gemm g{slot_ptr(ws, which ? 38 : 32, 0), (const f16*)(ws + (which ? WS_W_C1V : WS_W_C1K)), c1lda, c1k}; pg8::SingleOrder S{{pm, 0}, G > 0 ? 1 : 0};
                      pg8::EpiCmp1 E{hid, (const float*)(ws + WS_CBIAS) + which * 256};
                      pg8::gemm_phase<pg8::EpiCmp1, pg8::SingleOrder, false>(lds, g, S, E); }
                    VM_WAIT(); __syncthreads(); __builtin_amdgcn_fence(__ATOMIC_ACQUIRE, "agent"); VM_WAIT(); __syncthreads();
                    { pg8::Gemm g{hid, (const f16*)(ws + (which ? WS_W_C2V : WS_W_C2K)), c2k, c2k}; pg8::SingleOrder S{{pm, 0}, G > 0 ? 1 : 0};
                      pg8::EpiCmp2 E{(f16*)(ws + (which ? WS_VCMP : WS_KCMP))};
                      pg8::gemm_phase<pg8::EpiCmp2, pg8::SingleOrder, false>(lds, g, S, E); }
                }
                ((LAS unsigned*)(lds + L_SEL))[opaque_tid() & 7] = 0xFFFFFFFFu;
                for (int u = q_next(ctl + CW_Q + qrep, qslot, tid); u < 1024; u = q_next(ctl + CW_Q + qrep, qslot, tid)) {
                    const int qt = 255 - (u >> 2), b = (u & 3) >> 1, g = u & 1; const int tq = opaque_tid(); const int wv = __builtin_amdgcn_readfirstlane(tq >> 6);
                    const int hd = 4 * g + (wv >> 1), ql = 32 * (wv & 1) + (tq & 31);
                    const int t0 = qt >= 8 ? qt - 8 : 0;
                    fa::unit_sel<8, fa::EpiWinGate>(slot_ptr(ws, 24 + hd, b) + (size_t)(64 * qt + ql) * HD, slot_ptr(ws, 36 + g, b) + (size_t)t0 * 64 * HD, slot_ptr(ws, 42 + g, b) + (size_t)t0 * 64 * HD,
                        (const LAS unsigned*)(lds + L_SEL), qt - t0, ql, qt >= 8,
                        fa::EpiWinGate{(const float*)(ws + WS_GATES), Ob, b, hd, 64 * qt + 32 * (wv & 1)}, (char*)lds_raw);
                }
                for (int u = q_next(ctl + CW_Q + 64 + qrep, qslot, tid); u < 1024; u = q_next(ctl + CW_Q + 64 + qrep, qslot, tid)) {
                    const int qb = 63 - (u >> 4), b = (u & 15) >> 3, h = u & 7; const int tq = opaque_tid(); const int wv = __builtin_amdgcn_readfirstlane(tq >> 6); const int row = 256 * qb + 32 * wv + (tq & 31);
                    const float* cbh = (const float*)(ws + WS_C) + ((size_t)b * 8 + h) * SEQ;
                    int t0 = 0;
                    { const float bnd = sqrtf(((const float*)(ws + WS_QN2))[((b * 8 + h) << 6) + qb] * __uint_as_float(__hip_atomic_load(ctl + CW_KN2 + b * 8 + h, __ATOMIC_RELAXED, __HIP_MEMORY_SCOPE_AGENT)))
                                        - ((const float*)(ws + WS_QN2))[1024 + ((b * 8 + h) << 6) + qb] + 1.f;
                      const float cq0 = cbh[256 * qb]; const int ln = tq & 63; int cntv = 0;
#pragma unroll
                      for (int i = 0; i < 4; ++i) { const int tt = ln + 64 * i; const bool sk = (tt < 4 * qb) && (bnd + cq0 - cbh[64 * tt + 63] < -40.f); cntv += __popcll(__ballot(sk)); }
                      t0 = __builtin_amdgcn_readfirstlane(cntv) & ~1; }
                    fa::unit<8, true, true, fa::EpiPlain>(slot_ptr(ws, h, b) + (size_t)row * HD, slot_ptr(ws, 8 + h, b) + (size_t)t0 * 64 * HD, slot_ptr(ws, 16 + h, b) + (size_t)t0 * 64 * HD, cbh + row, cbh + 64 * t0, 4 * qb + 4 - t0, fa::QREL_ROW,
                                      fa::EpiPlain{Ob + ((size_t)b * SEQ + 256 * qb + 32 * wv) * DM + h * HD, DM}, (char*)lds_raw);
                }
            }
            SEAM(pb + 2);
            if (INR(3)) {
                PH_LOCALS;
                for (int i = 0, u; (u = SNAKE(i)) < 1024; ++i) {
                    __syncthreads();
                    nsa_cmp_unit(PROJ, (const f16*)(ws + WS_KCMP), (const f16*)(ws + WS_VCMP), (const float*)(ws + WS_GATES), Ob, (unsigned*)(ws + WS_SLIST) + (size_t)((u & 3)) * SL_BG, ctl + CW_SCNT + 256 * (u & 3), (u & 3) >> 1, u & 1, 255 - (u >> 2), lds, (char*)lds_raw);
                }
            }
            SEAM(pb + 3);
            for (int rnd = 0; rnd < 4; ++rnd) {
                const int b = rnd >> 1, g = rnd & 1;
                if (INR(4 + 2 * rnd)) {
                    PH_LOCALS;
                    LAS int* pref = (LAS int*)(lds + 102400);
                    __syncthreads();
                    if (tid < 256) { const int n = (tid >= 1 && tid <= 253) ? (int)__hip_atomic_load(ctl + CW_SCNT + 256 * rnd + tid, __ATOMIC_RELAXED, __HIP_MEMORY_SCOPE_AGENT) : 0; pref[tid + 1] = (n + PIECE - 1) / PIECE; }
                    if (tid == 0) pref[0] = 0;
                    __syncthreads();
                    for (int st = 1; st < 256; st <<= 1) { int v = 0; if (tid < 256 && tid + 1 > st) v = pref[tid + 1 - st]; __syncthreads(); if (tid < 256 && tid + 1 > st) pref[tid + 1] += v; __syncthreads(); }
                    const int nunits = pref[256];
                    for (int u = q_next(ctl + CW_Q + 512 + 64 * rnd + qrep, qslot, tid); u < nunits; u = q_next(ctl + CW_Q + 512 + 64 * rnd + qrep, qslot, tid)) {
                        int lo_ = 0, hi2 = 255;
                        while (lo_ < hi2) { const int mid = (lo_ + hi2 + 1) >> 1; if (pref[mid] <= u) lo_ = mid; else hi2 = mid - 1; }
                        const int j = lo_, piece = u - pref[j];
                        const int n = (int)__hip_atomic_load(ctl + CW_SCNT + 256 * rnd + j, __ATOMIC_RELAXED, __HIP_MEMORY_SCOPE_AGENT);
                        const int cnt = (n - PIECE * piece) < PIECE ? (n - PIECE * piece) : PIECE;
                        sel_gather_unit(PROJ, b, g, j, (const unsigned*)(ws + WS_SLIST) + (size_t)rnd * SL_BG + sl_off(j) + PIECE * piece, cnt, (unsigned char*)(ws + WS_SPO), (float*)(ws + WS_SPML), lds);
                    }
                }
                SEAM(pb + 4 + 2 * rnd);
                if (INR(5 + 2 * rnd)) {
                    PH_LOCALS;
                    for (int u = bid; u < 256; u += G) {
                        SelMergeF f; f.proj = PROJ; f.PO = (const unsigned char*)(ws + WS_SPO); f.PML = (const float*)(ws + WS_SPML); f.gates = (const float*)(ws + WS_GATES); f.O = Ob;
                        f.b = b; f.g = g; f.qt = 255 - u; f.nsl = f.qt - 2 < 0 ? 0 : (f.qt - 2 > 13 ? 13 : f.qt - 2);
                        attn_unit(f, lds);
                    }
                }
                SEAM(pb + 5 + 2 * rnd);
            }
        } else {
            if (INR(1)) { PH_LOCALS; for (int u = gw; u < 2048; u += NGW) kbar_block(slot_ptr(ws, 16, 0), (f16*)(ws + WS_KBAR), u, lane); }
            SEAM(pb + 1);
            if (INR(2)) { PH_LOCALS; for (int u = bid; u < 2048; u += G) moba_gate_unit(slot_ptr(ws, 0, 0), (const f16*)(ws + WS_KBAR), (unsigned short*)(ws + WS_LISTS), ctl + CW_LCNT, u, lds); }
            SEAM(pb + 2);
            for (int half = 0; half < 2; ++half) {
                if (INR(3 + 2 * half)) {
                    PH_LOCALS;
                    for (int u = q_next(ctl + CW_Q + 256 + 64 * half + qrep, qslot, tid); u < 63 * 16; u = q_next(ctl + CW_Q + 256 + 64 * half + qrep, qslot, tid)) {
                        const int j = u >> 4, hh = u & 15, bh = hh * 2 + half;
                        const int n = (int)__hip_atomic_load(ctl + CW_LCNT + bh * 64 + j, __ATOMIC_RELAXED, __HIP_MEMORY_SCOPE_AGENT);
                        const unsigned short* ent = (const unsigned short*)(ws + WS_LISTS) + (size_t)bh * LIST_BH + list_off(j);
                        const f16* qs = slot_ptr(ws, 0, 0) + (size_t)bh * SEQ * HD; const f16* ks = slot_ptr(ws, 16, 0) + ((size_t)bh * SEQ + 256 * j) * HD; const f16* vs = slot_ptr(ws, 32, 0) + ((size_t)bh * SEQ + 256 * j) * HD;
                        moba_gather_unit3(qs, ks, vs, ent, n, hh, (f16*)(ws + WS_PO), (float*)(ws + WS_PML), lds, (char*)lds_raw);
                    }
                }
                SEAM(pb + 3 + 2 * half);
                if (INR(4 + 2 * half)) {
                    PH_LOCALS;
                    for (int i = 0, u; (u = SNAKE(i)) < 1024; ++i) {
                        __syncthreads();
                        const int qb = u >> 4, hh = u & 15, bh = hh * 2 + half; const int tq = opaque_tid(); const int wv = __builtin_amdgcn_readfirstlane(tq >> 6); const int row = 256 * qb + 32 * wv + (tq & 31);
                        const f16* ks = slot_ptr(ws, 16, 0) + ((size_t)bh * SEQ + 256 * qb) * HD; const f16* vs = slot_ptr(ws, 32, 0) + ((size_t)bh * SEQ + 256 * qb) * HD;
                        fa::unit<8, false, true, fa::EpiMerge>(slot_ptr(ws, 0, 0) + ((size_t)bh * SEQ + row) * HD, ks, vs, nullptr, nullptr, 4, fa::QREL_ROW,
                            fa::EpiMerge{(const f16*)(ws + WS_PO), (const float*)(ws + WS_PML), (size_t)hh * SEQ + 256 * qb + 32 * wv, qb < 3 ? qb : 3, Ob + ((size_t)half * SEQ + 256 * qb + 32 * wv) * DM + hh * HD, DM}, (char*)lds_raw);
                    }
                }
                SEAM(pb + 4 + 2 * half);
            }
        }
        if (INR(ro)) {
            PH_LOCALS;
            pg8::Gemm g{Ob, (const f16*)(ws + (layer ? WS_W_OUT1 : WS_W_OUT0)), 1024, 1024}; pg8::StaticOrder S; S.init(MROWS, DM, G, bid);

#if YF16
            pg8::EpiF16 E{Yh, DM};
            pg8::gemm_phase<pg8::EpiF16, pg8::StaticOrder, true>(lds, g, S, E);
#else
            pg8::EpiF32 E{Yh, DM};
            pg8::gemm_phase<pg8::EpiF32, pg8::StaticOrder, true>(lds, g, S, E);
#endif
        }
        SEAM(pb + ro);
        if (INR(ro + 1)) {
            PH_LOCALS;
            f16* xdst = layer == 0 ? Xh : Hb;
            for (int m = gw; m < MROWS / 2; m += NGW) norm_rows<2, false>(Xh + (size_t)m * DM, Yh + (size_t)m * DM, xdst + (size_t)m * DM, RSb + m, nullptr, arg_in(13) + layer * DM, (size_t)(MROWS / 2) * DM, lane);
        }
        SEAM(pb + ro + 1);
        if (INR(ro + 2)) {
            PH_LOCALS;
            pg8::Gemm g{layer == 0 ? Xh : Hb, (const f16*)(ws + (layer ? WS_W_GU1 : WS_W_GU0)), 1024, 1024}; pg8::StaticOrder S; S.init(MROWS, 2 * FF, G, bid);
            pg8::EpiSwiGLU E{HID, RSb};
            pg8::gemm_phase<pg8::EpiSwiGLU, pg8::StaticOrder, true>(lds, g, S, E);
        }
        SEAM(pb + ro + 2);
        if (INR(ro + 3)) {
            PH_LOCALS;
            pg8::Gemm g{HID, (const f16*)(ws + (layer ? WS_W_DN1 : WS_W_DN0)), FF, FF}; pg8::StaticOrder S; S.init(MROWS, DM, G, bid);

#if YF16
            pg8::EpiF16 E{Yh, DM};
            pg8::gemm_phase<pg8::EpiF16, pg8::StaticOrder, true>(lds, g, S, E);
#else
            pg8::EpiF32 E{Yh, DM};
            pg8::gemm_phase<pg8::EpiF32, pg8::StaticOrder, true>(lds, g, S, E);
#endif
        }
        SEAM(pb + ro + 3);
        if (INR(ro + 4)) {
            PH_LOCALS;
            if (layer == 0) { for (int m = gw; m < MROWS / 2; m += NGW) norm_rows<2, false>(Xh + (size_t)m * DM, Yh + (size_t)m * DM, Xh + (size_t)m * DM, RSb + m, nullptr, arg_in(15), (size_t)(MROWS / 2) * DM, lane); }
            else { float* outp = (float*)arg_in(19); for (int m = gw; m < MROWS / 2; m += NGW) norm_rows<2, true>(Hb + (size_t)m * DM, Yh + (size_t)m * DM, nullptr, nullptr, outp + (size_t)m * DM, arg_in(15) + DM, (size_t)(MROWS / 2) * DM, lane); }
        }
        SEAM(pb + ro + 4);
    }
#undef IN
#undef SEAM
}

extern "C" void kernel_launch(void* const* d_in, const int* in_sizes, int n_in, void* d_out, int out_size, void* d_ws, size_t ws_size, hipStream_t stream) {
    static int grid = 0;
    if (grid == 0) {
        if (n_in != 19 || out_size != MROWS * DM || ws_size < WS_END) { fprintf(stderr, "kernel_launch: unexpected problem (n_in %d, out %d, ws %zu)\n", n_in, out_size, ws_size); grid = -1; return; }
        int dev = 0, cus = 0, per_cu = 0;
        if (hipGetDevice(&dev) != hipSuccess || hipDeviceGetAttribute(&cus, hipDeviceAttributeMultiprocessorCount, dev) != hipSuccess) { grid = -1; return; }
        if (hipFuncSetAttribute((const void*)trunk_fwd, hipFuncAttributeMaxDynamicSharedMemorySize, LDS_BYTES) != hipSuccess) { fprintf(stderr, "kernel_launch: hipFuncSetAttribute failed\n"); grid = -1; return; }
        if (hipOccupancyMaxActiveBlocksPerMultiprocessor(&per_cu, (const void*)trunk_fwd, 512, LDS_BYTES) != hipSuccess || per_cu < 1) fprintf(stderr, "kernel_launch: occupancy query says %d\n", per_cu);
        (void)hipGetLastError();
        grid = cus;
    }
    if (grid < 0) return;
    (void)hipMemsetAsync((char*)d_ws + WS_CTL, 0, CTL_ZERO_BYTES, stream);
    Args a{};
    for (int i = 0; i < 19; ++i) a.in[i] = (const float*)d_in[i];
    a.out = (float*)d_out; a.ws = (unsigned char*)d_ws;
#if N_LAUNCH_MODE
    a.ph_lo = 0; a.ph_hi = N_PHASES;
    hipLaunchKernelGGL(trunk_fwd, dim3(grid), dim3(512), LDS_BYTES, stream, a);
#else
    for (int p = 0; p < N_PHASES; ++p) { a.ph_lo = p; a.ph_hi = p + 1; a.rep = 0; hipLaunchKernelGGL(trunk_fwd, dim3(grid), dim3(512), LDS_BYTES, stream, a);
#ifdef REPEAT_PHASES
        if ((REPEAT_PHASES >> p) & 1) for (int r = 1; r <= 2; ++r) { a.rep = r; hipLaunchKernelGGL(trunk_fwd, dim3(grid), dim3(512), LDS_BYTES, stream, a); }
#endif
    }
#endif
}
```

```cpp
#include <hip/hip_runtime.h>
#include <cstdio>
#include <cstdint>
#include <cstddef>

#ifndef N_LAUNCH_MODE
#define N_LAUNCH_MODE 1

#endif

#define LAS __attribute__((address_space(3)))
#define GAS __attribute__((address_space(1)))
#define CAS __attribute__((address_space(4)))
typedef _Float16 f16;
typedef _Float16 h8 __attribute__((ext_vector_type(8)));
typedef _Float16 h2 __attribute__((ext_vector_type(2)));
typedef _Float16 h4 __attribute__((ext_vector_type(4)));
typedef short s16x4 __attribute__((ext_vector_type(4)));
typedef float f32x2 __attribute__((ext_vector_type(2)));
typedef float f32x4 __attribute__((ext_vector_type(4)));
typedef float f32x16 __attribute__((ext_vector_type(16)));
typedef unsigned u32x4 __attribute__((ext_vector_type(4)));
typedef unsigned u32x2 __attribute__((ext_vector_type(2)));
typedef GAS unsigned gu32;

constexpr int NB = 2, SEQ = 16384, DM = 1024, MROWS = NB * SEQ, HD = 64, FF = 2816;
constexpr int NIN = 3072;
constexpr int EVEN_IN = 2848;
constexpr float RMS_EPS = 1e-6f;
constexpr float LOG2E = 1.4426950408889634f;
constexpr float QSCALE = 0.125f * LOG2E;
constexpr float NEG_BIG = -1e30f;

constexpr size_t MiB = 1u << 20;
constexpr size_t WS_CTL = 0, CTL_ZERO_BYTES = 1 * MiB;
constexpr size_t WS_COS = 1 * MiB, WS_SIN = 3 * MiB;
constexpr size_t WS_CBIAS = 5 * MiB;
constexpr size_t WS_KBAR = 5 * MiB + 65536;
constexpr size_t WS_C = 6 * MiB;
constexpr size_t WS_LOGF = 7 * MiB;
constexpr size_t WS_W_IN0 = 8 * MiB, WS_W_OUT0 = 14 * MiB, WS_W_IN1 = 16 * MiB, WS_W_OUT1 = 22 * MiB;
constexpr size_t WS_W_GU0 = 24 * MiB, WS_W_GU1 = 35 * MiB, WS_W_DN0 = 46 * MiB, WS_W_DN1 = 46 * MiB + 5632 * 1024, WS_W_C1K = 57 * MiB, WS_W_C1V = 58 * MiB;
constexpr size_t WS_W_C2K = 59 * MiB, WS_W_C2V = 59 * MiB + 131072;
constexpr size_t WS_GATES = 60 * MiB;
constexpr size_t WS_H = 64 * MiB;
constexpr size_t WS_HIDK = WS_H, WS_HIDV = WS_H + 2 * MiB;
constexpr size_t WS_KCMP = WS_H + 4 * MiB, WS_VCMP = WS_H + 4 * MiB + 524288;
constexpr size_t WS_NSEL = WS_H + 5 * MiB;
constexpr size_t WS_LISTS = WS_H + 8 * MiB;
constexpr size_t WS_O = 128 * MiB;
constexpr size_t WS_PROJ = 192 * MiB;
constexpr size_t WS_Y = 384 * MiB;
constexpr size_t WS_OC = WS_Y, WS_OW = WS_Y + 32 * MiB;
constexpr size_t WS_PO = WS_Y, WS_PML = WS_Y + 96 * MiB;
constexpr size_t WS_SLIST = WS_H + 8 * MiB;
constexpr size_t WS_SPML = WS_H + 40 * MiB;
constexpr size_t WS_SPO = WS_Y;
constexpr size_t WS_RS = 5 * MiB + 640 * 1024;
constexpr size_t WS_END = 512 * MiB;
constexpr size_t SLOT_BYTES = (size_t)NB * SEQ * HD * 2;

constexpr int CW_BAR = 4096;
constexpr int CW_Q = 16384;
constexpr int CW_LCNT = 32768;
constexpr int CW_SCNT = 40960;
constexpr int CW_PAIR = 49152;
constexpr int CW_KN2 = 36864;
constexpr size_t WS_QN2 = WS_CBIAS + 32768;

constexpr int LDS_BYTES = 147456;
constexpr int L_KV = 0;
constexpr int L_OST = 32768;
constexpr int L_IMP = 65536;
constexpr int L_WSF = 131072;
constexpr int L_CS = 133120;
constexpr int L_SEL = 133632;
constexpr int L_MISC = 147456 - 256;

__device__ __forceinline__ unsigned pkh(float lo, float hi) { f32x2 v = {lo, hi}; h2 b = __builtin_convertvector(v, h2); return __builtin_bit_cast(unsigned, b); }
__device__ __forceinline__ float wave_sum(float v) {
#pragma unroll
    for (int o = 1; o < 64; o <<= 1) v += __shfl_xor(v, o);
    return v;
}
__device__ __forceinline__ int opaque_tid() { int t = threadIdx.x; asm volatile("" : "+v"(t)); return t; }
__device__ __forceinline__ float fexp2(float x) { return __builtin_amdgcn_exp2f(x); }
#define MFMA32(a, b, c) __builtin_amdgcn_mfma_f32_32x32x16_f16(a, b, c, 0, 0, 0)
#define MFMA16(a, b, c) __builtin_amdgcn_mfma_f32_16x16x32_f16(a, b, c, 0, 0, 0)
#define LDS_WAIT() asm volatile("s_waitcnt lgkmcnt(0)" ::: "memory")
#define VM_WAIT() asm volatile("s_waitcnt vmcnt(0)" ::: "memory")

#define XB_TMO      128
#define XB_XCNT(j)  (256  + 64 * (j))
#define XB_XSUB(j)  (1280 + 64 * (j))
#define XB_XGEN(j)  (2304 + 64 * (j))
#define XB_TOP      3328
#define XB_TOPGEN   3392
#define XCD_BAR_WORDS 3456
#define XB_SPIN_CAP (1u << 20)
__device__ __forceinline__ unsigned xb_ld(unsigned* p)              { return __hip_atomic_load(p, __ATOMIC_RELAXED, __HIP_MEMORY_SCOPE_AGENT); }
__device__ __forceinline__ unsigned xb_add(unsigned* p, unsigned v) { return __hip_atomic_fetch_add(p, v, __ATOMIC_RELAXED, __HIP_MEMORY_SCOPE_AGENT); }
__device__ __forceinline__ unsigned xb_xcc_id() { return (unsigned)__builtin_amdgcn_s_getreg((3 << 11) | 20) & 0xFu; }
#define XB_SPIN(cond, bar) do { unsigned _sp = 0; while (cond) { __builtin_amdgcn_s_sleep(1); \
    if ((++_sp & 255u) == 0u) { if (xb_ld(&(bar)[XB_TMO])) break; if (_sp > XB_SPIN_CAP) { atomicAdd(&(bar)[XB_TMO], 1u); break; } } } } while (0)
struct XcdBarrier { unsigned* bar; unsigned x; volatile LAS unsigned* st; };
__device__ __forceinline__ XcdBarrier xcd_barrier_post(unsigned* bar, volatile LAS unsigned* st) {
    XcdBarrier b; b.bar = bar; b.x = xb_xcc_id(); b.st = st;
    if (threadIdx.x == 0) (void)xb_add(&bar[XB_XCNT(b.x)], 1u);
    return b;
}
__device__ __forceinline__ void xcd_barrier_complete(unsigned* bar, unsigned x, unsigned& nloc, unsigned& nx) {
    const unsigned G = gridDim.x * gridDim.y * gridDim.z;
    unsigned sum, cnt, mine, sp = 0u;
    for (;;) {
        sum = 0u; cnt = 0u; mine = 0u;
#pragma unroll
        for (unsigned j = 0; j < 16; ++j) { const unsigned c = xb_ld(&bar[XB_XCNT(j)]); sum += c; cnt += (c > 0u) ? 1u : 0u; mine = (j == x) ? c : mine; }
        if (sum == G) break;
        __builtin_amdgcn_s_sleep(1);
        if ((++sp & 255u) == 0u) { if (xb_ld(&bar[XB_TMO])) break; if (sp > XB_SPIN_CAP) { atomicAdd(&bar[XB_TMO], 1u); break; } }
    }
    nloc = mine > 0u ? mine : 1u; nx = cnt > 0u ? cnt : 1u;
}
__device__ __forceinline__ void xcd_barrier(const XcdBarrier& b) {
    asm volatile("s_waitcnt vmcnt(0)" ::: "memory");
    __syncthreads();
    if (threadIdx.x == 0) {
        unsigned* bar = b.bar;
        __builtin_amdgcn_s_waitcnt(0);
        unsigned nloc = b.st[0], nx = b.st[1];
        if (nloc == 0u) { xcd_barrier_complete(bar, b.x, nloc, nx); b.st[0] = nloc; b.st[1] = nx; }
        const unsigned old = xb_add(&bar[XB_XSUB(b.x)], 1u);
        const unsigned gen = old / nloc;
        if (old + 1u == (gen + 1u) * nloc) {
            __builtin_amdgcn_fence(__ATOMIC_RELEASE, "agent");
            asm volatile("s_waitcnt vmcnt(0)" ::: "memory");
            const unsigned og = xb_add(&bar[XB_TOP], 1u);
            const unsigned tg = og / nx;
            if (og + 1u == (tg + 1u) * nx) xb_add(&bar[XB_TOPGEN], 1u);
            else XB_SPIN(xb_ld(&bar[XB_TOPGEN]) == tg, bar);
            __builtin_amdgcn_fence(__ATOMIC_ACQUIRE, "agent");
            xb_add(&bar[XB_XGEN(b.x)], 1u);
            asm volatile("s_waitcnt vmcnt(0)" ::: "memory");
        } else {
            XB_SPIN(xb_ld(&bar[XB_XGEN(b.x)]) == gen, bar);
            __builtin_amdgcn_fence(__ATOMIC_ACQUIRE, "agent");
            asm volatile("s_waitcnt vmcnt(0)" ::: "memory");
        }
    }
    __syncthreads();
}

__device__ __forceinline__ void pair_sync(gu32* ctr, unsigned target, unsigned* tmo, bool same_l2) {
    asm volatile("s_waitcnt vmcnt(0)" ::: "memory");
    __syncthreads();
    if (threadIdx.x == 0) {
        if (!same_l2) __builtin_amdgcn_fence(__ATOMIC_RELEASE, "agent");
        asm volatile("s_waitcnt vmcnt(0)" ::: "memory");
        (void)__hip_atomic_fetch_add(ctr, 1u, __ATOMIC_RELAXED, __HIP_MEMORY_SCOPE_AGENT);
        unsigned sp = 0u;
        while (__hip_atomic_load(ctr, __ATOMIC_RELAXED, __HIP_MEMORY_SCOPE_AGENT) < target) { __builtin_amdgcn_s_sleep(1);
            if ((++sp & 255u) == 0u) { if (xb_ld(tmo)) break; if (sp > XB_SPIN_CAP) { atomicAdd(tmo, 1u); break; } } }
        __builtin_amdgcn_fence(__ATOMIC_ACQUIRE, "agent");
        asm volatile("s_waitcnt vmcnt(0)" ::: "memory");
    }
    __syncthreads();
}

namespace pg8 {
constexpr int BM = 256, BK = 64, HALF = 128, HTB = HALF * BK * 2, NXCD = 8, WGM = 4;
__host__ __device__ __forceinline__ int lds_byte(int r, int c) { const int st = (r >> 4) * 2 + (c >> 5), rr = r & 15, cc = c & 31, ob = rr * 64 + cc * 2; return st * 1024 + (ob ^ (((ob >> 9) & 1) << 5)); }
__host__ __device__ __forceinline__ void stage_rc(int b, int& R, int& C) { const int st = b / 1024, sb = b % 1024, swz = sb ^ (((sb >> 9) & 1) << 5); R = (st >> 1) * 16 + swz / 64; C = (st & 1) * 32 + (swz % 64) / 2; }
__host__ __device__ __forceinline__ int perm32(int rho) { const int n = rho >> 4, i = rho & 15; return 8 * (i >> 2) + 4 * n + (i & 3); }
struct Unit { int pm, pn; };
struct Gemm { const f16* A; const f16* Bt; int lda, K; };
struct StaticOrder {
    int nM, nN, nwg, G, c;
    __device__ void init(int M, int N, int G_, int c_) { nM = M / BM; nN = N / BM; nwg = nM * nN; G = G_; c = c_; }
    __device__ bool next(int i, Unit& u) const {
        const long L = (long)i * G + c; if (L >= nwg) return false;
        int wgid = (int)L; { const int q = nwg / NXCD, r = nwg % NXCD, xcd = wgid % NXCD, off = wgid / NXCD; wgid = (xcd < r ? xcd * (q + 1) : r * (q + 1) + (xcd - r) * q) + off; }
        const int nig = WGM * nN, gid = wgid / nig, fm = gid * WGM, gsz = (nM - fm) < WGM ? (nM - fm) : WGM;
        u.pm = fm + ((wgid % nig) % gsz); u.pn = (wgid % nig) / gsz; return true;
    }
};
struct SingleOrder { Unit u; int n; __device__ bool next(int i, Unit& o) const { if (i >= n) return false; o = u; return true; } };
struct PairOrder { int pm, pn0, n; __device__ bool next(int i, Unit& o) const { if (i >= n) return false; int q = pm; asm volatile("" : "+s"(q)); o.pm = q; o.pn = pn0 + i; return true; } };

template <class Epi, class Sched, bool ALIGN_EPI>
__device__ __forceinline__ void gemm_phase(LAS unsigned char* lds, const Gemm g, const Sched& S, const Epi& E) {
    const int tid = opaque_tid(), wid = __builtin_amdgcn_readfirstlane(tid >> 6), lane = tid & 63, wr = wid >> 2, wc = wid & 3, fr = lane & 15, fq = lane >> 4;
    const int K = g.K, nt = K / BK, lda = g.lda;
    unsigned voffA[2], voffB[2];
#pragma unroll
    for (int i = 0; i < 2; ++i) { int R, C; stage_rc(tid * 16 + i * 8192, R, C); const int Rb = (R & ~31) + perm32(R & 31);
        voffA[i] = (unsigned)(R * lda + C) * 2u; voffB[i] = (unsigned)(Rb * K + C) * 2u; }
    const size_t kstep = (size_t)(BK * 2);
    const size_t hstepA = (size_t)HALF * lda * 2, tstepA = 2 * hstepA;
    const size_t hstepB = (size_t)HALF * K * 2, tstepB = 2 * hstepB;
    const unsigned ldsw = (unsigned)wid * 1024u;
    const int aoff = lds_byte(wr * 64 + fr, fq * 8), boff = lds_byte(wc * 32 + fr, fq * 8);
#define PG8_SA(b, h) (((b) * 2 + (h)) * HTB)
#define PG8_SB(b, h) ((4 + (b) * 2 + (h)) * HTB)
#define PG8_STAGE(bufoff, gbase, voff) do { _Pragma("unroll") for (int _i = 0; _i < 2; ++_i) \
        __builtin_amdgcn_global_load_lds((const unsigned*)((const char*)(gbase) + (voff)[_i]), (LAS unsigned*)(lds + (bufoff) + ldsw + _i * 8192), 16, 0, 0); } while (0)
#define PG8_LDA(dst, b, h) do { _Pragma("unroll") for (int m = 0; m < 4; ++m) _Pragma("unroll") for (int k = 0; k < 2; ++k) dst[m][k] = *(const LAS h8*)(lds + PG8_SA(b, h) + aoff + m * 2048 + k * 1024); } while (0)
#define PG8_LDB(dst, b, h) do { _Pragma("unroll") for (int n = 0; n < 2; ++n) _Pragma("unroll") for (int k = 0; k < 2; ++k) dst[n][k] = *(const LAS h8*)(lds + PG8_SB(b, h) + boff + n * 2048 + k * 1024); } while (0)
#define PG8_MMA(ai, bj, At, Bt) do { __builtin_amdgcn_s_setprio(1); _Pragma("unroll") for (int m = 0; m < 4; ++m) _Pragma("unroll") for (int n = 0; n < 2; ++n) _Pragma("unroll") for (int k = 0; k < 2; ++k) \
        acc[ai][bj][m][n] = MFMA16(Bt[n][k], At[m][k], acc[ai][bj][m][n]); __builtin_amdgcn_s_setprio(0); } while (0)
#define PG8_WAIT_V(n) asm volatile("s_waitcnt vmcnt(" #n ")" ::: "memory")
#define PG8_WAIT_L(n) asm volatile("s_waitcnt lgkmcnt(" #n ")" ::: "memory")
#define PG8_BAR __builtin_amdgcn_s_barrier()
#define PG8_SCHED __builtin_amdgcn_sched_barrier(0)
    Unit cur, nxt; int ui = 0;
    if (!S.next(0, cur)) return;
    f32x4 acc[2][2][4][2];
#pragma unroll
    for (int a = 0; a < 2; ++a)
#pragma unroll
        for (int b = 0; b < 2; ++b)
#pragma unroll
            for (int m = 0; m < 4; ++m)
#pragma unroll
                for (int n = 0; n < 2; ++n) acc[a][b][m][n] = (f32x4){0.f, 0.f, 0.f, 0.f};
    h8 At[4][2], B0[2][2], B1[2][2];
    const char* cA = (const char*)g.A + (size_t)cur.pm * tstepA; const char* cB = (const char*)g.Bt + (size_t)cur.pn * tstepB;
    PG8_STAGE(PG8_SB(0, 0), cB, voffB); PG8_STAGE(PG8_SB(0, 1), cB + hstepB, voffB); PG8_STAGE(PG8_SA(0, 0), cA, voffA); PG8_STAGE(PG8_SA(0, 1), cA + hstepA, voffA);
    if (wr == 1) PG8_BAR;
    PG8_WAIT_V(2); PG8_BAR;
    PG8_STAGE(PG8_SB(1, 0), cB + kstep, voffB); PG8_STAGE(PG8_SA(1, 0), cA + kstep, voffA); PG8_STAGE(PG8_SB(1, 1), cB + hstepB + kstep, voffB);
    PG8_WAIT_V(6); PG8_BAR;
    for (;;) {
        const bool has_next = S.next(ui + 1, nxt);
        const char* nA = has_next ? (const char*)g.A + (size_t)nxt.pm * tstepA : cA; const char* nB = has_next ? (const char*)g.Bt + (size_t)nxt.pn * tstepB : cB;
#pragma unroll 1
        for (int t = 0; t < nt; t += 2) {
            const bool last = (t == nt - 2);
            const char* a1 = cA + (size_t)(t + 1) * kstep;
            const char* a2 = last ? nA : cA + (size_t)(t + 2) * kstep; const char* b2 = last ? nB : cB + (size_t)(t + 2) * kstep;
            const char* a3 = a2 + kstep; const char* b3 = b2 + kstep;
            PG8_LDB(B0, 0, 0); PG8_LDB(B1, 0, 1); PG8_SCHED; PG8_LDA(At, 0, 0); PG8_STAGE(PG8_SA(1, 1), a1 + hstepA, voffA);
            PG8_WAIT_V(8); PG8_WAIT_L(0); PG8_BAR; PG8_MMA(0, 0, At, B0); PG8_MMA(0, 1, At, B1); PG8_BAR; PG8_SCHED;
            PG8_LDA(At, 0, 1); PG8_STAGE(PG8_SB(0, 0), b2, voffB); PG8_STAGE(PG8_SB(0, 1), b2 + hstepB, voffB); PG8_STAGE(PG8_SA(0, 0), a2, voffA);
            PG8_WAIT_V(8); PG8_WAIT_L(0); PG8_BAR; PG8_MMA(1, 0, At, B0); PG8_MMA(1, 1, At, B1); PG8_BAR; PG8_SCHED;
            PG8_LDB(B0, 1, 0); PG8_LDB(B1, 1, 1); PG8_SCHED; PG8_LDA(At, 1, 0); PG8_STAGE(PG8_SA(0, 1), a2 + hstepA, voffA);
            PG8_WAIT_V(8); PG8_WAIT_L(0); PG8_BAR; PG8_MMA(0, 0, At, B0); PG8_MMA(0, 1, At, B1); PG8_BAR; PG8_SCHED;
            PG8_LDA(At, 1, 1); PG8_STAGE(PG8_SB(1, 0), b3, voffB); PG8_STAGE(PG8_SB(1, 1), b3 + hstepB, voffB); PG8_STAGE(PG8_SA(1, 0), a3, voffA);
            PG8_WAIT_V(8); PG8_WAIT_L(0); PG8_BAR; PG8_MMA(1, 0, At, B0); PG8_MMA(1, 1, At, B1); PG8_BAR; PG8_SCHED;
        }
        if constexpr (ALIGN_EPI) { if (wr == 0) PG8_BAR; }
        E(acc, cur, wr, wc, fr, fq);
        if (!has_next) break;
#pragma unroll
        for (int a = 0; a < 2; ++a)
#pragma unroll
            for (int b = 0; b < 2; ++b)
#pragma unroll
                for (int m = 0; m < 4; ++m)
#pragma unroll
                    for (int n = 0; n < 2; ++n) acc[a][b][m][n] = (f32x4){0.f, 0.f, 0.f, 0.f};
        cur = nxt; cA = nA; cB = nB; ++ui;
        if constexpr (ALIGN_EPI) { if (wr == 1) PG8_BAR; }
    }
    PG8_WAIT_V(0);
    if constexpr (!ALIGN_EPI) { if (wr == 0) PG8_BAR; }
    PG8_BAR;
#undef PG8_SA
#undef PG8_SB
#undef PG8_STAGE
#undef PG8_LDA
#undef PG8_LDB
#undef PG8_MMA
#undef PG8_WAIT_V
#undef PG8_WAIT_L
#undef PG8_BAR
#undef PG8_SCHED
}
typedef f32x4 Acc[2][2][4][2];

struct EpiF32 {
    float* Y; int ldc;
    __device__ __forceinline__ void operator()(const Acc& acc, const Unit& u, int wr, int wc, int fr, int fq) const {
        const int row0 = u.pm * BM + wr * 64 + fr, col0 = u.pn * BM + wc * 32 + 8 * fq;
#pragma unroll
        for (int ai = 0; ai < 2; ++ai)
#pragma unroll
            for (int m = 0; m < 4; ++m) { float* rowp = Y + (size_t)(row0 + ai * HALF + m * 16) * ldc + col0;
#pragma unroll
                for (int bj = 0; bj < 2; ++bj) { *(f32x4*)(rowp + bj * HALF) = acc[ai][bj][m][0]; *(f32x4*)(rowp + bj * HALF + 4) = acc[ai][bj][m][1]; } }
    }
};
struct EpiF16 {
    f16* Y; int ldc;
    __device__ __forceinline__ void operator()(const Acc& acc, const Unit& u, int wr, int wc, int fr, int fq) const {
        const int row0 = u.pm * BM + wr * 64 + fr, col0 = u.pn * BM + wc * 32 + 8 * fq;
#pragma unroll
        for (int ai = 0; ai < 2; ++ai)
#pragma unroll
            for (int m = 0; m < 4; ++m) { f16* rowp = Y + (size_t)(row0 + ai * HALF + m * 16) * ldc + col0;
#pragma unroll
                for (int bj = 0; bj < 2; ++bj) { const f32x4 a = acc[ai][bj][m][0], b = acc[ai][bj][m][1];
                    u32x4 w; w.x = pkh(a[0], a[1]); w.y = pkh(a[2], a[3]); w.z = pkh(b[0], b[1]); w.w = pkh(b[2], b[3]); *(GAS u32x4*)(rowp + bj * HALF) = w; } }
    }
};
struct EpiSwiGLU {
    f16* Hd; const float* rs;
    __device__ __forceinline__ void operator()(const Acc& acc, const Unit& u, int wr, int wc, int fr, int fq) const {
        const int row0 = u.pm * BM + wr * 64 + fr, col0 = u.pn * HALF + wc * 32 + 8 * fq;
        float r8[8];
#pragma unroll
        for (int it = 0; it < 8; ++it) r8[it] = ((const GAS float*)rs)[row0 + (it >> 2) * HALF + (it & 3) * 16];
#pragma unroll
        for (int ai = 0; ai < 2; ++ai)
#pragma unroll
            for (int m = 0; m < 4; ++m) {
                float o[8]; const float r = r8[ai * 4 + m];
#pragma unroll
                for (int n = 0; n < 2; ++n)
#pragma unroll
                    for (int j = 0; j < 4; ++j) { const float gt = acc[ai][0][m][n][j] * r, up = acc[ai][1][m][n][j] * r; o[4 * n + j] = gt * up * __builtin_amdgcn_rcpf(1.f + __expf(-gt)); }
                u32x4 w; w.x = pkh(o[0], o[1]); w.y = pkh(o[2], o[3]); w.z = pkh(o[4], o[5]); w.w = pkh(o[6], o[7]);
                *(GAS u32x4*)(Hd + (size_t)(row0 + ai * HALF + m * 16) * FF + col0) = w; }
    }
};
__device__ __forceinline__ float gelu_tanh(float x) { const float u = 0.7978845608028654f * (x + 0.044715f * x * x * x); const float e = __expf(2.f * u); return 0.5f * x * (2.f - 2.f * __builtin_amdgcn_rcpf(e + 1.f)); }
struct EpiCmp1 {
    f16* Hd; const float* bias;
    __device__ __forceinline__ void operator()(const Acc& acc, const Unit& u, int wr, int wc, int fr, int fq) const {
        const int row0 = u.pm * BM + wr * 64 + fr, col0 = wc * 32 + 8 * fq;
        f32x4 bv[2][2];
#pragma unroll
        for (int bj = 0; bj < 2; ++bj)
#pragma unroll
            for (int n = 0; n < 2; ++n) { f32x4 a = *(const f32x4*)(bias + col0 + bj * HALF + 4 * n);
#pragma unroll
                for (int p = 1; p < 8; ++p) a = a + *(const f32x4*)(bias + p * 512 + col0 + bj * HALF + 4 * n);
                bv[bj][n] = a; }
#pragma unroll
        for (int ai = 0; ai < 2; ++ai)
#pragma unroll
            for (int m = 0; m < 4; ++m) {
#pragma unroll
                for (int bj = 0; bj < 2; ++bj) {
                    float o[8];
#pragma unroll
                    for (int n = 0; n < 2; ++n)
#pragma unroll
                        for (int j = 0; j < 4; ++j) o[4 * n + j] = gelu_tanh(acc[ai][bj][m][n][j] + bv[bj][n][j]);
                    u32x4 w; w.x = pkh(o[0], o[1]); w.y = pkh(o[2], o[3]); w.z = pkh(o[4], o[5]); w.w = pkh(o[6], o[7]);
                    *(u32x4*)(Hd + (size_t)(row0 + ai * HALF + m * 16) * 256 + col0 + bj * HALF) = w; }
                __builtin_amdgcn_sched_barrier(0); }
    }
};
struct EpiCmp2 {
    f16* Out;
    __device__ __forceinline__ void operator()(const Acc& acc, const Unit& u, int wr, int wc, int fr, int fq) const {
        if (wc >= 2) return;
        const int row0 = u.pm * BM + wr * 64 + fr, col0 = wc * 32 + 8 * fq;
#pragma unroll
        for (int ai = 0; ai < 2; ++ai)
#pragma unroll
            for (int m = 0; m < 4; ++m) {
                u32x4 w; w.x = pkh(acc[ai][0][m][0][0], acc[ai][0][m][0][1]); w.y = pkh(acc[ai][0][m][0][2], acc[ai][0][m][0][3]);
                w.z = pkh(acc[ai][0][m][1][0], acc[ai][0][m][1][1]); w.w = pkh(acc[ai][0][m][1][2], acc[ai][0][m][1][3]);
                *(u32x4*)(Out + (size_t)(row0 + ai * HALF + m * 16) * 64 + col0) = w; }
    }
};
struct EpiInProj {
    f16* proj; const float* cosT; const float* sinT; float* logf; float* gates; const float* b_f; int layer; const float* rs; f16* kimg; LAS float* kred;
    __device__ __forceinline__ void operator()(const Acc& acc, const Unit& u, int wr, int wc, int fr, int fq) const {
        const int hs = u.pn * 4 + wc;
        int kind, dst;
        if (layer == 0) {
            if (hs < 8) { kind = 2; dst = hs; } else if (hs < 24) { kind = 0; dst = hs; } else if (hs < 32) { kind = 3; dst = hs; }
            else if (hs < 38) { kind = 1; dst = hs; } else if (hs == 38) { kind = 4; dst = 0; } else if (hs == 39) { kind = 5; dst = 0; }
            else if (hs < 46) { kind = 0; dst = hs - 2; } else { kind = 5; dst = 0; }
        } else { dst = hs; kind = hs < 16 ? 3 : (hs < 32 ? 1 : 0); }
        if (kind == 5) return;
        const int row0 = u.pm * BM + wr * 64 + fr;
        if (kind == 4) {
            const float bf0 = b_f[(8 * fq) & 7], bf1 = b_f[(8 * fq + 1) & 7], bf2 = b_f[(8 * fq + 2) & 7], bf3 = b_f[(8 * fq + 3) & 7], bf4 = b_f[(8 * fq + 4) & 7], bf5 = b_f[(8 * fq + 5) & 7], bf6 = b_f[(8 * fq + 6) & 7], bf7 = b_f[(8 * fq + 7) & 7];
            const float bfv[8] = {bf0, bf1, bf2, bf3, bf4, bf5, bf6, bf7};
            float rw8[8];
#pragma unroll
            for (int it = 0; it < 8; ++it) rw8[it] = ((const GAS float*)rs)[row0 + (it >> 2) * HALF + (it & 3) * 16];
#pragma unroll
            for (int ai = 0; ai < 2; ++ai)
#pragma unroll
                for (int m = 0; m < 4; ++m) { const int row = row0 + ai * HALF + m * 16; const int b = row / SEQ, s = row % SEQ; const float rw = rw8[ai * 4 + m];
#pragma unroll
                    for (int n = 0; n < 2; ++n) {
                        if (fq == 0) {
#pragma unroll
                            for (int j = 0; j < 4; ++j) { const int d = 4 * n + j; const float x = acc[ai][0][m][n][j] * rw + bfv[4 * n + j]; const float e = __expf(-fabsf(x));
                                const float l1p = e < 0.03f ? e * (1.f - e * (0.5f - e * (0.33333333f - 0.25f * e))) : __logf(1.f + e);
                                ((GAS float*)logf)[((size_t)b * 8 + d) * SEQ + s] = fminf(x, 0.f) - l1p; }
                        } else {
                            f32x4 gv4;
#pragma unroll
                            for (int j = 0; j < 4; ++j) gv4[j] = __builtin_amdgcn_rcpf(1.f + __expf(-(acc[ai][0][m][n][j] * rw)));
                            *(GAS f32x4*)(gates + (size_t)row * 24 + 8 * (fq - 1) + 4 * n) = gv4; }
                    }
                    __builtin_amdgcn_sched_barrier(0); }
            return;
        }
        const float sc = (kind >= 2) ? QSCALE : 1.f; const bool rope = (kind == 1 || kind == 3);
        const bool dokb = (layer == 1) && (hs >= 16) && (hs < 32);
        float ksum[16];
#pragma unroll
        for (int i = 0; i < 16; ++i) ksum[i] = 0.f;
        f16* base = proj + (size_t)dst * (NB * SEQ * HD);
        float rwv[8];
#pragma unroll
        for (int it = 0; it < 8; ++it) rwv[it] = ((const GAS float*)rs)[row0 + (it >> 2) * HALF + (it & 3) * 16];
        f32x4 tc[2][2], ts[2][2];
        if (rope) {
#pragma unroll
            for (int n = 0; n < 2; ++n) { const int s0 = row0 % SEQ; tc[0][n] = *(const GAS f32x4*)(cosT + (size_t)s0 * 32 + 8 * fq + 4 * n); ts[0][n] = *(const GAS f32x4*)(sinT + (size_t)s0 * 32 + 8 * fq + 4 * n); } }
#pragma unroll
        for (int it = 0; it < 8; ++it) { const int ai = it >> 2, m = it & 3; const int row = row0 + ai * HALF + m * 16; const float rw = rwv[it] * sc;
                if (rope && it + 1 < 8) { const int s1 = (row0 + ((it + 1) >> 2) * HALF + ((it + 1) & 3) * 16) % SEQ;
#pragma unroll
                    for (int n = 0; n < 2; ++n) { tc[(it + 1) & 1][n] = *(const GAS f32x4*)(cosT + (size_t)s1 * 32 + 8 * fq + 4 * n); ts[(it + 1) & 1][n] = *(const GAS f32x4*)(sinT + (size_t)s1 * 32 + 8 * fq + 4 * n); } }
                f32x4 x1[2] = {acc[ai][0][m][0] * rw, acc[ai][0][m][1] * rw}, x2[2] = {acc[ai][1][m][0] * rw, acc[ai][1][m][1] * rw};
                if (rope) {
#pragma unroll
                    for (int n = 0; n < 2; ++n) { const f32x4 c = tc[it & 1][n], sn = ts[it & 1][n];
                        const f32x4 a = x1[n], bb = x2[n]; x1[n] = a * c - bb * sn; x2[n] = bb * c + a * sn; }
                }
                if (dokb) {
#pragma unroll
                    for (int n = 0; n < 2; ++n)
#pragma unroll
                        for (int j = 0; j < 4; ++j) { ksum[4 * n + j] += x1[n][j]; ksum[8 + 4 * n + j] += x2[n][j]; }
                }
                u32x4 w1, w2;
                w1.x = pkh(x1[0][0], x1[0][1]); w1.y = pkh(x1[0][2], x1[0][3]); w1.z = pkh(x1[1][0], x1[1][1]); w1.w = pkh(x1[1][2], x1[1][3]);
                w2.x = pkh(x2[0][0], x2[0][1]); w2.y = pkh(x2[0][2], x2[0][3]); w2.z = pkh(x2[1][0], x2[1][1]); w2.w = pkh(x2[1][2], x2[1][3]);
                f16* rp = base + (size_t)row * HD + 8 * fq;
                *(GAS u32x4*)rp = w1; *(GAS u32x4*)(rp + 32) = w2;
                __builtin_amdgcn_sched_barrier(0); }
        if (dokb) {
#pragma unroll
            for (int i = 0; i < 16; ++i) { float v = ksum[i]; v += __shfl_xor(v, 1); v += __shfl_xor(v, 2); v += __shfl_xor(v, 4); v += __shfl_xor(v, 8); ksum[i] = v; }
            if (wr == 1 && fr == 0) {
#pragma unroll
                for (int i = 0; i < 16; ++i) kred[wc * 64 + fq * 16 + i] = ksum[i]; }
            __builtin_amdgcn_s_waitcnt(0xc07f); __builtin_amdgcn_s_barrier();
            if (wr == 0 && fr == 0) {
                h8 hi1, lo1, hi2, lo2;
#pragma unroll
                for (int i = 0; i < 8; ++i) { const float m1 = (ksum[i] + kred[wc * 64 + fq * 16 + i]) * (1.f / 256.f), m2 = (ksum[8 + i] + kred[wc * 64 + fq * 16 + 8 + i]) * (1.f / 256.f);
                    const f16 h1 = (f16)m1, h2 = (f16)m2; hi1[i] = h1; lo1[i] = (f16)((m1 - (float)h1) * 4096.f); hi2[i] = h2; lo2[i] = (f16)((m2 - (float)h2) * 4096.f); }
                const int b = u.pm >> 6, blk = u.pm & 63, bh = (hs - 16) * 2 + b;
                f16* ib = kimg + (size_t)bh * 8192 + fq * 512 + blk * 8;
                *(h8*)ib = hi1; *(h8*)(ib + 4096) = lo1; *(h8*)(ib + 2048) = hi2; *(h8*)(ib + 2048 + 4096) = lo2;
            }
        }
    }
};
}

__device__ __forceinline__ int crow(int r, int hi) { return (r & 3) + 8 * (r >> 2) + 4 * hi; }
__device__ __forceinline__ float swapmax(float m) { auto rr = __builtin_amdgcn_permlane32_swap(__float_as_uint(m), __float_as_uint(m), false, false); return fmaxf(__uint_as_float(rr[0]), __uint_as_float(rr[1])); }
__device__ __forceinline__ float swapsum(float m) { auto rr = __builtin_amdgcn_permlane32_swap(__float_as_uint(m), __float_as_uint(m), false, false); return __uint_as_float(rr[0]) + __uint_as_float(rr[1]); }
struct KVStage { u32x4 k, v; };
__device__ __forceinline__ void kv_issue(KVStage& st, const char* kt, const char* vt, int wid, int lane) {
    st.k = *(const GAS u32x4*)(kt + lane * 128 + wid * 16);
    st.v = *(const GAS u32x4*)(vt + (16 * (wid & 3) + (lane >> 2)) * 128 + (wid >> 2) * 64 + (lane & 3) * 16);
}
__device__ __forceinline__ void kv_write(const KVStage& st, LAS unsigned char* buf, int wid, int lane) {
    *(LAS u32x4*)(buf + wid * 1024 + lane * 16) = st.k;
    *(LAS u32x4*)(buf + 8192 + wid * 1024 + lane * 16) = st.v;
}
__device__ __forceinline__ void qk_tile(f32x16& p0, f32x16& p1, const LAS unsigned char* kb, const h8 (&qr)[4], int r32, int hi) {
    const LAS unsigned char* kp = kb + hi * 1024 + r32 * 16;
#pragma unroll
    for (int r = 0; r < 16; ++r) { p0[r] = 0.f; p1[r] = 0.f; }
#pragma unroll
    for (int d0 = 0; d0 < 4; ++d0) {
        const h8 b0 = *(const LAS h8*)(kp + d0 * 2048), b1 = *(const LAS h8*)(kp + d0 * 2048 + 512);
        p0 = MFMA32(b0, qr[d0], p0); p1 = MFMA32(b1, qr[d0], p1);
    }
}
typedef short v4i16_t __attribute__((ext_vector_type(4)));
typedef short s16x8 __attribute__((ext_vector_type(8)));
__device__ __forceinline__ s16x4 vtr(const LAS unsigned char* p) { return __builtin_bit_cast(s16x4, __builtin_amdgcn_ds_read_tr16_b64_v4i16((LAS v4i16_t*)p)); }
__device__ __forceinline__ void pv_tile(f32x16 (&o)[2], const LAS unsigned char* vb, const u32x4 (&pw)[4], int lane, int hi) {
    const LAS unsigned char* vp = vb + ((lane >> 4) & 1) * 32 + (lane & 3) * 8 + (4 * hi + ((lane & 15) >> 2)) * 64;
#pragma unroll
    for (int d0 = 0; d0 < 2; ++d0)
#pragma unroll
        for (int ks = 0; ks < 4; ++ks) {
            const s16x4 lo = vtr(vp + d0 * 4096 + ks * 1024), hh = vtr(vp + d0 * 4096 + ks * 1024 + 512);
            const s16x8 vv = {lo[0], lo[1], lo[2], lo[3], hh[0], hh[1], hh[2], hh[3]};
            o[d0] = MFMA32(__builtin_bit_cast(h8, pw[ks]), __builtin_bit_cast(h8, vv), o[d0]);
        }
}
__device__ __forceinline__ void pack_p(u32x4 (&pw)[4], const f32x16& p0, const f32x16& p1) {
    pw[0] = (u32x4){pkh(p0[0], p0[1]), pkh(p0[2], p0[3]), pkh(p0[4], p0[5]), pkh(p0[6], p0[7])};
    pw[1] = (u32x4){pkh(p0[8], p0[9]), pkh(p0[10], p0[11]), pkh(p0[12], p0[13]), pkh(p0[14], p0[15])};
    pw[2] = (u32x4){pkh(p1[0], p1[1]), pkh(p1[2], p1[3]), pkh(p1[4], p1[5]), pkh(p1[6], p1[7])};
    pw[3] = (u32x4){pkh(p1[8], p1[9]), pkh(p1[10], p1[11]), pkh(p1[12], p1[13]), pkh(p1[14], p1[15])};
}
__device__ __forceinline__ float rowmax32(const f32x16& p0, const f32x16& p1) {
    float a = fmaxf(p0[0], p1[0]);
#pragma unroll
    for (int r = 1; r < 16; ++r) a = fmaxf(a, fmaxf(p0[r], p1[r]));
    return swapmax(a);
}
__device__ __forceinline__ void softmax_step(f32x16& p0, f32x16& p1, float& m, float& l, f32x16 (&o)[2], LAS float* wsf, int r32, int hi) {
    const float rm = rowmax32(p0, p1);
    const float mn = fmaxf(m, rm);
    const float alpha = fexp2(m - mn);
    m = mn;
    float s = 0.f;
#pragma unroll
    for (int r = 0; r < 16; ++r) { p0[r] = fexp2(p0[r] - mn); p1[r] = fexp2(p1[r] - mn); s += p0[r] + p1[r]; }
    l = l * alpha + s;
    if (__any(alpha != 1.f)) {
        if (hi == 0) wsf[r32] = alpha;
        LDS_WAIT();
#pragma unroll
        for (int r = 0; r < 16; ++r) { const float a = wsf[crow(r, hi)]; o[0][r] *= a; o[1][r] *= a; }
        LDS_WAIT();
    }
}
__device__ __forceinline__ void stage_o(const f32x16 (&o)[2], float rinv_lane, LAS float* wsf, LAS f16* stg, int r32, int hi) {
    if (hi == 0) wsf[32 + r32] = rinv_lane;
    LDS_WAIT();
#pragma unroll
    for (int r = 0; r < 16; ++r) { const int orow = crow(r, hi); const float rl = wsf[32 + orow];
        stg[orow * 64 + r32] = (f16)(o[0][r] * rl); stg[orow * 64 + 32 + r32] = (f16)(o[1][r] * rl); }
    LDS_WAIT();
}

template <class F> __device__ __forceinline__ void attn_unit(F& f, LAS unsigned char* lds) {
    const int tid = opaque_tid(), lane = tid & 63, r32 = lane & 31, hi = lane >> 5; const int wid = __builtin_amdgcn_readfirstlane(tid >> 6);
    LAS unsigned char* kv = lds + L_KV; LAS float* wsf = (LAS float*)(lds + L_WSF) + wid * 64; LAS f16* stg = (LAS f16*)(lds + L_OST) + wid * 2048;
    LAS float* csl = (LAS float*)(lds + L_CS);
    f.init(wid, r32, hi);
    const f16* qp = f.qrow();
    h8 qr[4];
#pragma unroll
    for (int d0 = 0; d0 < 4; ++d0) qr[d0] = *(const h8*)(qp + 16 * d0 + 8 * hi);
    float m = NEG_BIG, l = 0.f; f32x16 o[2];
#pragma unroll
    for (int r = 0; r < 16; ++r) { o[0][r] = 0.f; o[1][r] = 0.f; }
    const int t0 = f.t_begin(), t1 = f.t_end();
    KVStage st; float csv = 0.f;
    __syncthreads();
    f.unit_prep(lds, tid);
    kv_issue(st, f.ktile(t0), f.vtile(t0), wid, lane);
    if constexpr (F::HAS_CS) { if (wid == 0) csv = f.cs_src(t0)[lane]; }
    kv_write(st, kv, wid, lane);
    if constexpr (F::HAS_CS) { if (wid == 0) csl[lane] = csv; }
    __syncthreads();
    for (int t = t0; t < t1; ++t) {
        const int cur = (t - t0) & 1;
        const bool more = (t + 1 < t1);
        if (more) { kv_issue(st, f.ktile(t + 1), f.vtile(t + 1), wid, lane); if constexpr (F::HAS_CS) { if (wid == 0) csv = f.cs_src(t + 1)[lane]; } }
        if (f.active(t)) {
            f32x16 p0, p1;
            qk_tile(p0, p1, kv + cur * 16384, qr, r32, hi);
            f.mask(p0, p1, t, csl + cur * 64, hi);
            softmax_step(p0, p1, m, l, o, wsf, r32, hi);
            u32x4 pw[4]; pack_p(pw, p0, p1);
            pv_tile(o, kv + cur * 16384 + 8192, pw, lane, hi);
        }
        if (more) { kv_write(st, kv + (cur ^ 1) * 16384, wid, lane); if constexpr (F::HAS_CS) { if (wid == 0) csl[(cur ^ 1) * 64 + lane] = csv; } }
        __syncthreads();
    }
    const float lt = swapsum(l);
    stage_o(o, lt > 0.f ? 1.f / lt : 0.f, wsf, stg, r32, hi);
    if (hi == 0) { wsf[r32] = m; wsf[32 + r32] = lt; }
    LDS_WAIT();
    f.store(stg, lane, wsf);
}

namespace fa {
constexpr int NW = 8, QBLK = 32, QB = 256, KVBLK = 64, NSLOT = 3, SLOTB = 8192;
constexpr int LDS_K = 0, LDS_V = NSLOT * SLOTB, LDS_WS = 2 * NSLOT * SLOTB, LDS_OST = LDS_WS + NW * 64 * 4, LDS_CS = LDS_OST + NW * 4096, LDS_END = LDS_CS + NW * 1024;
#define SBAR() __builtin_amdgcn_sched_barrier(0)
__device__ __forceinline__ void cmask(f32x16& p0, f32x16& p1, int jb, int qrel, int hi) {
    const float NEG = -INFINITY; int kb = 64 * jb + 4 * hi;
#pragma unroll
    for (int r = 0; r < 16; ++r) { int kvp = kb + (r & 3) + 8 * (r >> 2); if (kvp > qrel) p0[r] = NEG; if (kvp + 32 > qrel) p1[r] = NEG; }
}
__device__ __forceinline__ void glds16(const void* gsrc, unsigned lds_dst) { unsigned keep;
    asm volatile("s_mov_b32 %0, m0\n\ts_mov_b32 m0, %2\n\ts_nop 0\n\tglobal_load_lds_dwordx4 %1, off\n\ts_mov_b32 m0, %0" : "=&s"(keep) : "v"(gsrc), "s"(lds_dst) : "memory"); }
__device__ __forceinline__ void glds4(const void* gsrc, unsigned lds_dst) { unsigned keep;
    asm volatile("s_mov_b32 %0, m0\n\ts_mov_b32 m0, %2\n\ts_nop 0\n\tglobal_load_lds_dword %1, off\n\ts_mov_b32 m0, %0" : "=&s"(keep) : "v"(gsrc), "s"(lds_dst) : "memory"); }
__device__ __forceinline__ float max3f(float a, float b, float c) { float r; asm("v_max3_f32 %0, %1, %2, %3" : "=v"(r) : "v"(a), "v"(b), "v"(c)); return r; }
__device__ __forceinline__ float max2f(float a, float b) { float r; asm("v_max_f32_e32 %0, %1, %2" : "=v"(r) : "v"(a), "v"(b)); return r; }
__device__ __forceinline__ float fadd_s(float a, float b) { float r; asm("v_add_f32_e32 %0, %1, %2" : "=v"(r) : "v"(a), "v"(b)); return r; }
__device__ __forceinline__ float fsub_s(float a, float b) { float r; asm("v_sub_f32_e32 %0, %1, %2" : "=v"(r) : "v"(a), "v"(b)); return r; }
#define WAIT_BAR(N) asm volatile("s_waitcnt vmcnt(" #N ") lgkmcnt(0)\n\ts_barrier" ::: "memory")
typedef LAS const char* lds_cptr;
__device__ __forceinline__ void qkt(f32x16& p0, f32x16& p1, const char* Kslot, const h8* qr, const f32x16& negm, int r32, int hi) {
    const char* kb = Kslot + hi * 1024 + r32 * 16;
#pragma unroll
    for (int d0 = 0; d0 < 4; ++d0) {
        const h8 b0 = *reinterpret_cast<const h8*>(kb + d0 * 2048);
        const h8 b1 = *reinterpret_cast<const h8*>(kb + d0 * 2048 + 512);
        if (d0 == 0) { p0 = MFMA32(b0, qr[0], negm); p1 = MFMA32(b1, qr[0], negm); }
        else { p0 = MFMA32(b0, qr[d0], p0); p1 = MFMA32(b1, qr[d0], p1); } }
}
__device__ __forceinline__ void kload8(h8* kf, lds_cptr kp) {
    kf[0] = *(const LAS h8*)(kp);        kf[1] = *(const LAS h8*)(kp + 512);
    kf[2] = *(const LAS h8*)(kp + 2048); kf[3] = *(const LAS h8*)(kp + 2560);
    kf[4] = *(const LAS h8*)(kp + 4096); kf[5] = *(const LAS h8*)(kp + 4608);
    kf[6] = *(const LAS h8*)(kp + 6144); kf[7] = *(const LAS h8*)(kp + 6656);
}
__device__ __forceinline__ void kload2(h8* kf, lds_cptr kp, int j) { kf[2 * j] = *(const LAS h8*)(kp + j * 2048); kf[2 * j + 1] = *(const LAS h8*)(kp + j * 2048 + 512); }
__device__ __forceinline__ s16x4 vtr2(lds_cptr p) { return __builtin_bit_cast(s16x4, __builtin_amdgcn_ds_read_tr16_b64_v4i16((LAS v4i16_t*)p)); }
__device__ __forceinline__ float rowmax(const f32x16& p0, const f32x16& p1) {
    float a = max3f(p0[0], p0[1], p1[0]), b = max3f(p0[2], p0[3], p1[1]); a = max3f(a, p1[2], p1[3]);
#pragma unroll
    for (int r = 4; r < 16; r += 4) { a = max3f(a, p0[r], p0[r + 1]); b = max3f(b, p0[r + 2], p0[r + 3]); a = max3f(a, p1[r], p1[r + 1]); b = max3f(b, p1[r + 2], p1[r + 3]); }
    const float m = max2f(a, b);
    auto rr = __builtin_amdgcn_permlane32_swap(__float_as_uint(m), __float_as_uint(m), false, false);
    return max2f(__uint_as_float(rr[0]), __uint_as_float(rr[1]));
}
__device__ __forceinline__ h8 mk8(s16x4 lo, s16x4 hi) { const s16x8 v = {lo[0], lo[1], lo[2], lo[3], hi[0], hi[1], hi[2], hi[3]}; return __builtin_bit_cast(h8, v); }
__device__ __forceinline__ void pv(f32x16* o, int vb, h8 pa0, h8 pa1, h8 pa2, h8 pa3) {
#pragma unroll
    for (int d0 = 0; d0 < 2; ++d0) { s16x4 lo[4], hi[4];
#pragma unroll
        for (int ks = 0; ks < 4; ++ks) {
            asm volatile("ds_read_b64_tr_b16 %0,%1 offset:%c2" : "=&v"(lo[ks]) : "v"(vb), "i"(d0 * 4096 + ks * 1024) : "memory");
            asm volatile("ds_read_b64_tr_b16 %0,%1 offset:%c2" : "=&v"(hi[ks]) : "v"(vb), "i"(d0 * 4096 + ks * 1024 + 512) : "memory"); }
        asm volatile("s_waitcnt lgkmcnt(0)" ::: "memory"); SBAR();
        o[d0] = MFMA32(pa0, mk8(lo[0], hi[0]), o[d0]);
        o[d0] = MFMA32(pa1, mk8(lo[1], hi[1]), o[d0]);
        o[d0] = MFMA32(pa2, mk8(lo[2], hi[2]), o[d0]);
        o[d0] = MFMA32(pa3, mk8(lo[3], hi[3]), o[d0]);
    }
}
__device__ __forceinline__ void stage_rows(const f32x16 (&o)[2], float rinv, char* shm, int wid, int le) {
    const int r32e = le & 31, hie = le >> 5;
    float* wse = (float*)(shm + LDS_WS) + wid * 64;
    if (hie == 0) wse[32 + r32e] = rinv; asm volatile("s_waitcnt lgkmcnt(0)" ::: "memory");
    f16* stg = (f16*)(shm + LDS_OST) + wid * 2048;
#pragma unroll
    for (int r = 0; r < 16; ++r) { const int orow = crow(r, hie); const float rl = wse[32 + orow];
#pragma unroll
        for (int d0 = 0; d0 < 2; ++d0) stg[orow * 64 + d0 * 32 + r32e] = (f16)(o[d0][r] * rl); }
    asm volatile("s_waitcnt lgkmcnt(0)" ::: "memory");
}
struct EpiPlain { f16* Ow; int opitch;
    __device__ __forceinline__ void after_q() const {}
    __device__ __forceinline__ void operator()(const f32x16 (&o)[2], float, float l, char* shm, int wid) const {
        const int le = opaque_tid() & 63;
        stage_rows(o, l > 0.f ? __builtin_amdgcn_rcpf(l) : 0.f, shm, wid, le);
        const f16* stg = (const f16*)(shm + LDS_OST) + wid * 2048;
#pragma unroll
        for (int i = 0; i < 4; ++i) { const int row = i * 8 + (le >> 3), ch = le & 7; const u32x4 v = *(const u32x4*)(stg + row * 64 + ch * 8); *(GAS u32x4*)(Ow + (long)row * opitch + ch * 8) = v; }
    } };
struct EpiPartial { f16* PO; float* PML; int dst; const f16* qs; int code_next; unsigned qst;
    __device__ __forceinline__ void after_q() const {
        asm volatile("s_waitcnt lgkmcnt(0)" ::: "memory");
        const int le = opaque_tid() & 63;
#pragma unroll
        for (int i = 0; i < 4; ++i) { const int cn = __shfl(code_next, 8 * i + (le >> 3), 64);
            glds16(qs + (size_t)((cn < 0 ? 0 : cn) & 16383) * HD + (le & 7) * 8, (unsigned)__builtin_amdgcn_readfirstlane(qst + i * 1024)); }
    }
    __device__ __forceinline__ void operator()(const f32x16 (&o)[2], float mhat, float l, char* shm, int wid) const {
        const int le = opaque_tid() & 63, r32e = le & 31, hie = le >> 5;
        int* tab = (int*)(shm + LDS_CS) + wid * 256;
        if (hie == 0) { tab[r32e] = dst; if (dst >= 0) { f32x2 ml = {mhat, l}; *(GAS f32x2*)(PML + 2 * (size_t)dst) = ml; } }
        stage_rows(o, __builtin_amdgcn_rcpf(l), shm, wid, le);
        const f16* stg = (const f16*)(shm + LDS_OST) + wid * 2048;
#pragma unroll
        for (int i = 0; i < 4; ++i) { const int row = i * 8 + (le >> 3), ch = le & 7; const int d = tab[row];
            if (d >= 0) { const u32x4 v = *(const u32x4*)(stg + row * 64 + ch * 8); *(GAS u32x4*)(PO + (size_t)d * 64 + ch * 8) = v; } }
    } };
struct EpiMerge { const f16* PO; const float* PML; size_t prow0; int nv; f16* Ow; int opitch;
    __device__ __forceinline__ void after_q() const {}
    __device__ __forceinline__ void operator()(const f32x16 (&o)[2], float mhat, float l, char* shm, int wid) const {
        const int le = opaque_tid() & 63, r32e = le & 31, hie = le >> 5;
        float* tab = (float*)(shm + LDS_CS) + wid * 256;
        if (hie == 0) {
            float ms[3], ls[3]; float M = mhat;
#pragma unroll
            for (int s_ = 0; s_ < 3; ++s_) { ms[s_] = -INFINITY; ls[s_] = 0.f; if (s_ < nv) { const f32x2 ml = *(const f32x2*)(PML + 2 * ((prow0 + r32e) * 3 + s_)); ms[s_] = ml[0]; ls[s_] = ml[1]; M = fmaxf(M, ml[0]); } }
            const float wo = fexp2(mhat - M) * l; float w[3], den = wo;
#pragma unroll
            for (int s_ = 0; s_ < 3; ++s_) { w[s_] = (s_ < nv) ? fexp2(ms[s_] - M) * ls[s_] : 0.f; den += w[s_]; }
            const float rd = 1.f / den;
            tab[r32e * 4] = wo * rd; tab[r32e * 4 + 1] = w[0] * rd; tab[r32e * 4 + 2] = w[1] * rd; tab[r32e * 4 + 3] = w[2] * rd;
        }
        stage_rows(o, __builtin_amdgcn_rcpf(l), shm, wid, le);
        const f16* stg = (const f16*)(shm + LDS_OST) + wid * 2048;
        h8 pvv[4][3];
#pragma unroll
        for (int i = 0; i < 4; ++i)
#pragma unroll
            for (int s_ = 0; s_ < 3; ++s_) if (s_ < nv) pvv[i][s_] = *(const GAS h8*)(PO + ((prow0 + i * 8 + (le >> 3)) * 3 + s_) * 64 + (le & 7) * 8);
#pragma unroll
        for (int i = 0; i < 4; ++i) { const int row = i * 8 + (le >> 3), ch = le & 7;
            const f32x4 a = *(const f32x4*)(tab + row * 4); const h8 own = *(const h8*)(stg + row * 64 + ch * 8);
            float acc[8];
#pragma unroll
            for (int e = 0; e < 8; ++e) acc[e] = a[0] * (float)own[e];
#pragma unroll
            for (int s_ = 0; s_ < 3; ++s_) if (s_ < nv) { const h8 pv_ = pvv[i][s_]; const float as = a[1 + s_];
#pragma unroll
                for (int e = 0; e < 8; ++e) acc[e] += as * (float)pv_[e]; }
            u32x4 v; v.x = pkh(acc[0], acc[1]); v.y = pkh(acc[2], acc[3]); v.z = pkh(acc[4], acc[5]); v.w = pkh(acc[6], acc[7]);
            *(GAS u32x4*)(Ow + (long)row * opitch + ch * 8) = v; }
    } };
struct EpiWinGate { const float* gates; f16* O; int b, hd, q0;
    __device__ __forceinline__ void after_q() const {}
    __device__ __forceinline__ void operator()(const f32x16 (&o)[2], float, float l, char* shm, int wid) const {
        const int le = opaque_tid() & 63;
        stage_rows(o, l > 0.f ? __builtin_amdgcn_rcpf(l) : 0.f, shm, wid, le);
        const f16* stg = (const f16*)(shm + LDS_OST) + wid * 2048;
        float g2v[4];
#pragma unroll
        for (int i = 0; i < 4; ++i) g2v[i] = ((const GAS float*)gates)[((size_t)b * SEQ + q0 + i * 8 + (le >> 3)) * 24 + hd * 3 + 2];
#pragma unroll
        for (int i = 0; i < 4; ++i) { const int row = i * 8 + (le >> 3), ch = le & 7; const int q = q0 + row;
            const float g2 = g2v[i];
            const h8 s_ = *(const h8*)(stg + row * 64 + ch * 8);
            u32x4 o4; o4.x = pkh(g2 * (float)s_[0], g2 * (float)s_[1]); o4.y = pkh(g2 * (float)s_[2], g2 * (float)s_[3]); o4.z = pkh(g2 * (float)s_[4], g2 * (float)s_[5]); o4.w = pkh(g2 * (float)s_[6], g2 * (float)s_[7]);
            *(GAS u32x4*)(O + ((size_t)b * SEQ + q) * DM + 512 + hd * HD + ch * 8) = o4; }
    } };
__device__ __forceinline__ void o_acc8(f16* p, float gt, const h8 v) {
    const h8 c = *(const h8*)p; float r_[8];
#pragma unroll
    for (int e = 0; e < 8; ++e) r_[e] = (float)c[e] + gt * (float)v[e];
    u32x4 o4; o4.x = pkh(r_[0], r_[1]); o4.y = pkh(r_[2], r_[3]); o4.z = pkh(r_[4], r_[5]); o4.w = pkh(r_[6], r_[7]);
    *(u32x4*)p = o4;
}
constexpr int QREL_ROW = -(1 << 30);
constexpr int RES_V = 92160;
template <int THRL, bool BIAS, bool CAUSAL, class Epi, bool QLDS = false, bool RES = false> __device__ __forceinline__ void unit(const f16* qrow, const f16* __restrict__ Kh, const f16* __restrict__ Vh, const float* cq, const float* ck, const int NT, const int qrel_in, const Epi& E, char* shm) {
    const int tid = opaque_tid(), lane = tid & 63, r32 = lane & 31, hi = lane >> 5; const int wid = __builtin_amdgcn_readfirstlane(tid >> 6);
    const unsigned lds0 = (unsigned)(uintptr_t)shm;
    float* wsf = (float*)(shm + LDS_WS) + wid * 64;
    if (QLDS) ((int*)wsf)[32 + r32] = qrel_in;
    const f16* ksrc = Kh + (long)lane * 64 + wid * 8;
    const f16* vsrc = Vh + (long)(16 * (wid & 3) + (lane >> 2)) * 64 + (wid >> 2) * 32 + (lane & 3) * 8;
    const float* cssrc = ck + lane;
    const unsigned kdst = lds0 + LDS_K + wid * 1024, vdst = lds0 + LDS_V + wid * 1024, csdst = lds0 + LDS_CS + wid * 1024;
#define DMA_K(t, slot) do { if (!RES) { glds16(ksrc + (long)(t) * 4096, (unsigned)__builtin_amdgcn_readfirstlane(kdst + (slot))); \
        if (BIAS) glds4(cssrc + 64 * (t), (unsigned)__builtin_amdgcn_readfirstlane(csdst + (((t) & 3) << 8))); } } while (0)
#define DMA_V(t, slot) do { if (!RES) glds16(vsrc + (long)(t) * 4096, (unsigned)__builtin_amdgcn_readfirstlane(vdst + (slot))); } while (0)
    constexpr int VBASE = RES ? RES_V : LDS_V;
    const int vb0 = (int)(lds0 + VBASE) + ((lane >> 4) & 1) * 32 + (lane & 3) * 8 + (4 * hi + ((lane & 15) >> 2)) * 64;
    const char* Kbase = shm + LDS_K; h8 kf[8];
    const lds_cptr shm3 = (lds_cptr)shm; const lds_cptr kp0 = shm3 + LDS_K + hi * 1024 + r32 * 16; const lds_cptr vp0 = shm3 + VBASE + ((lane >> 4) & 1) * 32 + (lane & 3) * 8 + (4 * hi + ((lane & 15) >> 2)) * 64;
    const lds_cptr csp0 = shm3 + LDS_CS + wid * 1024 + hi * 16;
    DMA_K(0, 0); DMA_V(0, 0); DMA_K(1, SLOTB);
    h8 qr[4];
#pragma unroll
    for (int d0 = 0; d0 < 4; ++d0) qr[d0] = *reinterpret_cast<const h8*>(qrow + d0 * 16 + hi * 8);
    E.after_q();
    float ctv = 0.f; if (BIAS) ctv = *cq;
    float l_reg = 0.f; f32x16 o[2];
#pragma unroll
    for (int r = 0; r < 16; ++r) { o[0][r] = 0.f; o[1][r] = 0.f; }
    f32x16 negm;
#pragma unroll
    for (int r = 0; r < 16; ++r) negm[r] = ctv;
    asm volatile("" : "+v"(negm));
#define CMASK(P0, P1, t) do { if (CAUSAL) { int jb_ = (t) - (NT - 4); if (jb_ >= 0) { const int lq_ = opaque_tid() & 31; const int qrel = QLDS ? ((const int*)(shm + LDS_WS))[wid * 64 + 32 + lq_] : wid * QBLK + lq_; cmask(P0, P1, jb_, qrel, hi); } } } while (0)
#define CSUB(P0, P1, t) do { if (BIAS) { const lds_cptr cp_ = csp0 + (((t) & 3) << 8); \
        _Pragma("unroll") for (int g_ = 0; g_ < 4; ++g_) { const f32x4 c0_ = *(const LAS f32x4*)(cp_ + g_ * 32), c1_ = *(const LAS f32x4*)(cp_ + 128 + g_ * 32); \
            _Pragma("unroll") for (int j_ = 0; j_ < 4; ++j_) { P0[4 * g_ + j_] -= c0_[j_]; P1[4 * g_ + j_] -= c1_[j_]; } } } } while (0)
    bool resc = false;
#define START(P0, P1) do { const float rm = rowmax(P0, P1); resc = false; \
    { const float dl = (rm > -INFINITY) ? rm : 0.f;        \
      _Pragma("unroll") for (int r = 0; r < 16; ++r) { P0[r] = fsub_s(P0[r], dl); P1[r] = fsub_s(P1[r], dl); } \
      const float nm_ = ctv - dl; _Pragma("unroll") for (int r = 0; r < 16; ++r) negm[r] = nm_; asm volatile("" : "+v"(negm)); } \
    _Pragma("unroll") for (int r = 0; r < 16; ++r) P0[r] = __builtin_amdgcn_exp2f(P0[r]); } while (0)
#define RESC() do { if (resc) { asm volatile("s_waitcnt lgkmcnt(0)" ::: "memory"); \
      _Pragma("unroll") for (int d_ = 0; d_ < 2; ++d_) _Pragma("unroll") for (int r = 0; r < 16; ++r) o[d_][r] *= wsf[crow(r, hi)]; } } while (0)
    f32x16 pA0, pA1, pB0, pB1;
    int sl_prev = 0, sl_cur = 0, sl_next = SLOTB;
#define ROT() do { sl_prev = sl_cur; sl_cur = sl_next; sl_next = (!RES && sl_next == (NSLOT - 1) * SLOTB) ? 0 : sl_next + SLOTB; } while (0)
#define WBR(N) do { if (RES) { asm volatile("" ::: "memory"); } else { WAIT_BAR(N); } } while (0)
#define WB2() do { if (BIAS) { WBR(3); } else { WBR(2); } } while (0)
    DMA_K(2, 2 * SLOTB);
    WBR(3);
    qkt(pA0, pA1, Kbase, qr, negm, r32, hi); asm volatile("s_nop 15\n\ts_nop 7" : "+v"(pA0), "+v"(pA1)); CSUB(pA0, pA1, 0); CMASK(pA0, pA1, 0);
    START(pA0, pA1);
    _Pragma("unroll") for (int r = 0; r < 16; ++r) pA1[r] = __builtin_amdgcn_exp2f(pA1[r]);
    WBR(0);
    DMA_K(3, 0); DMA_V(1, SLOTB);
    ROT();
    kload8(kf, kp0 + sl_cur);
    WB2();
    s16x4 vlo[8], vhi[8]; u32x4 pw0, pw1, pw2, pw3;
#define PKW(P, B) pkh(P[B], P[B + 1])
#define PAF(k) __builtin_bit_cast(h8, pw##k)
#define VFR(i) mk8(vlo[i], vhi[i])
#define PIN(x) asm volatile("" : "+v"(x))
#define MX3(a, b, c) __builtin_fmaxf(__builtin_fmaxf((a), (b)), (c))
#define GAPA(MF, A0, A1, A2, A3, W0, W1, PW) do { MF; sacc += A0; sacc += A1; sacc += A2; sacc += A3; PIN(sacc); W0; W1; PIN(PW); SBAR(); } while (0)
#define EX(v) __builtin_amdgcn_exp2f(v)
#define GAPB(MF, X, B) do { MF; X[B] = EX(X[B]); X[B + 1] = EX(X[B + 1]); X[B + 2] = EX(X[B + 2]); X[B + 3] = EX(X[B + 3]); PIN(X); SBAR(); } while (0)
#define VRD(i) do { vlo[i] = vtr2(vp_ + (((i) >> 2) * 4096 + ((i) & 3) * 1024)); vhi[i] = vtr2(vp_ + (((i) >> 2) * 4096 + ((i) & 3) * 1024 + 512)); } while (0)
#define KRD(G, j) do { if (G) { kload2(kf, kp0 + sl_next, j); SBAR(); } } while (0)
#define STEP(C0, C1, P0, P1, t, GK, GV, GL) do { SBAR(); \
    const lds_cptr vp_ = vp0 + sl_prev; \
    VRD(0); SBAR(); float sacc = (P0[0] + P0[1]); \
    GAPA(C0 = MFMA32(kf[0], qr[0], negm), P0[2], P0[3], P0[4], P0[5],     pw0[0] = PKW(P0, 0), pw0[1] = PKW(P0, 2), pw0); \
    VRD(4); SBAR(); GAPA(C1 = MFMA32(kf[1], qr[0], negm), P0[6], P0[7], P0[8], P0[9],     pw0[2] = PKW(P0, 4), pw0[3] = PKW(P0, 6), pw0); \
    VRD(1); SBAR(); GAPA(C0 = MFMA32(kf[2], qr[1], C0),   P0[10], P0[11], P0[12], P0[13], pw1[0] = PKW(P0, 8), pw1[1] = PKW(P0, 10), pw1); \
    VRD(5); SBAR(); GAPA(C1 = MFMA32(kf[3], qr[1], C1),   P0[14], P0[15], P1[0], P1[1],   pw1[2] = PKW(P0, 12), pw1[3] = PKW(P0, 14), pw1); \
    VRD(2); SBAR(); GAPA(C0 = MFMA32(kf[4], qr[2], C0),   P1[2], P1[3], P1[4], P1[5],     pw2[0] = PKW(P1, 0), pw2[1] = PKW(P1, 2), pw2); \
    VRD(6); SBAR(); GAPA(C1 = MFMA32(kf[5], qr[2], C1),   P1[6], P1[7], P1[8], P1[9],     pw2[2] = PKW(P1, 4), pw2[3] = PKW(P1, 6), pw2); \
    VRD(3); SBAR(); GAPA(C0 = MFMA32(kf[6], qr[3], C0),   P1[10], P1[11], P1[12], P1[13], pw3[0] = PKW(P1, 8), pw3[1] = PKW(P1, 10), pw3); \
    VRD(7); SBAR(); GAPA(C1 = MFMA32(kf[7], qr[3], C1),   P1[14], P1[15], 0.f, 0.f,       pw3[2] = PKW(P1, 12), pw3[3] = PKW(P1, 14), pw3); \
    l_reg += sacc; \
    if (GK) { DMA_K((t) + 3, sl_cur); } if (GV) { DMA_V((t) + 1, sl_next); } \
    CSUB(C0, C1, t); \
    CMASK(C0, C1, t); \
    { float a = MX3(C0[0], C0[1], C1[0]), b = MX3(C0[2], C0[3], C1[1]); a = MX3(a, C1[2], C1[3]); \
      _Pragma("unroll") for (int r = 4; r < 16; r += 4) { a = MX3(a, C0[r], C0[r + 1]); b = MX3(b, C0[r + 2], C0[r + 3]); a = MX3(a, C1[r], C1[r + 1]); b = MX3(b, C1[r + 2], C1[r + 3]); } \
      float rm = __builtin_fmaxf(a, b); { auto rr = __builtin_amdgcn_permlane32_swap(__float_as_uint(rm), __float_as_uint(rm), false, false); rm = __builtin_fmaxf(__uint_as_float(rr[0]), __uint_as_float(rr[1])); } \
      resc = false; \
      if (__builtin_expect(__any(rm > (float)THRL), 0)) { const float dl = __builtin_fmaxf(rm, 0.f); \
        _Pragma("unroll") for (int r = 0; r < 16; ++r) { C0[r] -= dl; C1[r] -= dl; } \
        { const float nm_ = negm[0] - dl; _Pragma("unroll") for (int r = 0; r < 16; ++r) negm[r] = nm_; } asm volatile("" : "+v"(negm)); \
        const float f = __builtin_amdgcn_exp2f(-dl); l_reg *= f; { const int lr_ = opaque_tid() & 63; if (lr_ < 32) ((float*)(shm + LDS_WS))[wid * 64 + lr_] = f; } resc = true; } } \
    SBAR(); \
    GAPB(o[0] = MFMA32(PAF(0), VFR(0), o[0]), C0, 0); \
    GAPB(o[1] = MFMA32(PAF(0), VFR(4), o[1]), C0, 4); \
    KRD(GL, 0); GAPB(o[0] = MFMA32(PAF(1), VFR(1), o[0]), C0, 8); \
    KRD(GL, 1); GAPB(o[1] = MFMA32(PAF(1), VFR(5), o[1]), C0, 12); \
    KRD(GL, 2); GAPB(o[0] = MFMA32(PAF(2), VFR(2), o[0]), C1, 0); \
    KRD(GL, 3); GAPB(o[1] = MFMA32(PAF(2), VFR(6), o[1]), C1, 4); \
    GAPB(o[0] = MFMA32(PAF(3), VFR(3), o[0]), C1, 8); \
    GAPB(o[1] = MFMA32(PAF(3), VFR(7), o[1]), C1, 12); \
    } while (0)
    int t = 1;
#undef CMASK
#define CMASK(P0, P1, t) do {} while (0)
    for (; t + 5 < NT; t += 2) {
        STEP(pB0, pB1, pA0, pA1, t, true, true, true);     WB2(); RESC(); ROT();
        STEP(pA0, pA1, pB0, pB1, t + 1, true, true, true); WB2(); RESC(); ROT();
    }
#undef CMASK
#define CMASK(P0, P1, t) do { if (CAUSAL) { int jb_ = (t) - (NT - 4); if (jb_ >= 0) { const int lq_ = opaque_tid() & 31; const int qrel = QLDS ? ((const int*)(shm + LDS_WS))[wid * 64 + 32 + lq_] : wid * QBLK + lq_; cmask(P0, P1, jb_, qrel, hi); } } } while (0)
#define ENDW(tt) do { if ((tt) + 3 < NT) { WB2(); } else if ((tt) + 2 < NT) { WBR(1); } else { WBR(0); } } while (0)
    for (; t + 1 < NT; t += 2) {
        STEP(pB0, pB1, pA0, pA1, t, (t + 3 < NT), (t + 1 < NT), (t + 1 < NT));     ENDW(t);     RESC(); ROT();
        STEP(pA0, pA1, pB0, pB1, t + 1, (t + 4 < NT), (t + 2 < NT), (t + 2 < NT)); ENDW(t + 1); RESC(); ROT();
    }
    STEP(pB0, pB1, pA0, pA1, NT - 1, false, false, false); RESC();
    { float sacc = pB0[0] + pB0[1]; _Pragma("unroll") for (int r = 2; r < 16; ++r) sacc += pB0[r]; _Pragma("unroll") for (int r = 0; r < 16; ++r) sacc += pB1[r]; l_reg += sacc;
      pw0 = (u32x4){PKW(pB0, 0), PKW(pB0, 2), PKW(pB0, 4), PKW(pB0, 6)}; pw1 = (u32x4){PKW(pB0, 8), PKW(pB0, 10), PKW(pB0, 12), PKW(pB0, 14)}; pw2 = (u32x4){PKW(pB1, 0), PKW(pB1, 2), PKW(pB1, 4), PKW(pB1, 6)}; pw3 = (u32x4){PKW(pB1, 8), PKW(pB1, 10), PKW(pB1, 12), PKW(pB1, 14)};
      SBAR(); pv(o, vb0 + sl_cur, PAF(0), PAF(1), PAF(2), PAF(3)); }
    { auto rr = __builtin_amdgcn_permlane32_swap(__float_as_uint(l_reg), __float_as_uint(l_reg), false, false); l_reg = __uint_as_float(rr[0]) + __uint_as_float(rr[1]); }
    E(o, ctv - negm[0], l_reg, shm, wid);
    if (RES) { asm volatile("s_waitcnt lgkmcnt(0)" ::: "memory"); } else { asm volatile("s_waitcnt lgkmcnt(0)\n\ts_barrier" ::: "memory"); }
#undef DMA_K
#undef DMA_V
#undef CMASK
#undef CSUB
#undef START
#undef RESC
#undef ROT
#undef WB2
#undef WBR
#undef PKW
#undef PAF
#undef VFR
#undef PIN
#undef MX3
#undef GAPA
#undef GAPB
#undef EX
#undef VRD
#undef KRD
#undef STEP
#undef ENDW
}
__device__ __forceinline__ void cmask_own(f32x16& p0, f32x16& p1, int ql, int hi) {
#pragma unroll
    for (int r = 0; r < 16; ++r) { const int kvp = 4 * hi + (r & 3) + 8 * (r >> 2); if (kvp > ql) p0[r] = -INFINITY; if (kvp + 32 > ql) p1[r] = -INFINITY; }
}
template <int THRL, class Epi> __device__ __forceinline__ void unit_sel(const f16* qrow, const f16* __restrict__ Kh, const f16* __restrict__ Vh, const LAS unsigned* selw, const int qt, const int ql, const bool winl, const Epi& E, char* shm) {
    const int tid = opaque_tid(), lane = tid & 63, r32 = lane & 31, hi = lane >> 5; const int wid = __builtin_amdgcn_readfirstlane(tid >> 6);
    const unsigned lds0 = (unsigned)(uintptr_t)shm;
    float* wsf = (float*)(shm + LDS_WS) + wid * 64;
    const int NT = (qt + 2) < 4 ? 4 : ((qt + 2) & ~1);
    const f16* ksrc = Kh + (long)lane * 64 + wid * 8;
    const f16* vsrc = Vh + (long)(16 * (wid & 3) + (lane >> 2)) * 64 + (wid >> 2) * 32 + (lane & 3) * 8;
    const unsigned kdst = lds0 + LDS_K + wid * 1024, vdst = lds0 + LDS_V + wid * 1024;
#define DMA_K(t, slot) glds16(ksrc + (long)(t) * 4096, (unsigned)__builtin_amdgcn_readfirstlane(kdst + (slot)))
#define DMA_V(t, slot) glds16(vsrc + (long)(t) * 4096, (unsigned)__builtin_amdgcn_readfirstlane(vdst + (slot)))
#define SBIT(t) (((t) <= qt) ? ((selw[(t) >> 5] >> ((t) & 31)) & 1u) : 0u)
    const int vb0 = (int)(lds0 + LDS_V) + ((lane >> 4) & 1) * 32 + (lane & 3) * 8 + (4 * hi + ((lane & 15) >> 2)) * 64;
    const char* Kbase = shm + LDS_K; h8 kf[8];
    const lds_cptr shm3 = (lds_cptr)shm; const lds_cptr kp0 = shm3 + LDS_K + hi * 1024 + r32 * 16; const lds_cptr vp0 = shm3 + LDS_V + ((lane >> 4) & 1) * 32 + (lane & 3) * 8 + (4 * hi + ((lane & 15) >> 2)) * 64;
    DMA_K(0, 0); DMA_V(0, 0); DMA_K(1, SLOTB);
    h8 qr[4];
#pragma unroll
    for (int d0 = 0; d0 < 4; ++d0) qr[d0] = *reinterpret_cast<const h8*>(qrow + d0 * 16 + hi * 8);
    float mhat = 0.f, l_reg = 0.f; f32x16 o[2];
#pragma unroll
    for (int r = 0; r < 16; ++r) { o[0][r] = 0.f; o[1][r] = 0.f; }
    f32x16 negm;
#pragma unroll
    for (int r = 0; r < 16; ++r) negm[r] = 0.f;
    asm volatile("" : "+v"(negm));
    bool resc = false;
    bool fresh = false;
#define START(P0, P1) do { const float rm = rowmax(P0, P1); resc = false; fresh = !(rm > -INFINITY); \
    { const float dl = fresh ? 0.f : rm; mhat = fadd_s(mhat, dl); \
      _Pragma("unroll") for (int r = 0; r < 16; ++r) { P0[r] = fsub_s(P0[r], dl); P1[r] = fsub_s(P1[r], dl); } \
      _Pragma("unroll") for (int r = 0; r < 16; ++r) negm[r] = -mhat; asm volatile("" : "+v"(negm)); } \
    _Pragma("unroll") for (int r = 0; r < 16; ++r) P0[r] = __builtin_amdgcn_exp2f(P0[r]); } while (0)
#define RESC() do { if (resc) { asm volatile("s_waitcnt lgkmcnt(0)" ::: "memory"); \
      _Pragma("unroll") for (int d_ = 0; d_ < 2; ++d_) _Pragma("unroll") for (int r = 0; r < 16; ++r) o[d_][r] *= wsf[crow(r, hi)]; } } while (0)
    f32x16 pA0, pA1, pB0, pB1;
    int sl_prev = 0, sl_cur = 0, sl_next = SLOTB;
#define ROT() do { sl_prev = sl_cur; sl_cur = sl_next; sl_next = (sl_next == (NSLOT - 1) * SLOTB) ? 0 : sl_next + SLOTB; } while (0)
    DMA_K(2, 2 * SLOTB);
    WAIT_BAR(3);
    qkt(pA0, pA1, Kbase, qr, negm, r32, hi); asm volatile("s_nop 15\n\ts_nop 7" : "+v"(pA0), "+v"(pA1)); if (qt == 0) cmask_own(pA0, pA1, ql, hi);
    if (winl) {
#pragma unroll
        for (int r = 0; r < 16; ++r) { const int kvp = 4 * hi + (r & 3) + 8 * (r >> 2); if (kvp <= ql) pA0[r] = -INFINITY; if (kvp + 32 <= ql) pA1[r] = -INFINITY; }
    }
    START(pA0, pA1);
    _Pragma("unroll") for (int r = 0; r < 16; ++r) pA1[r] = __builtin_amdgcn_exp2f(pA1[r]);
    WAIT_BAR(0);
    DMA_K(3, 0); DMA_V(1, SLOTB);
    ROT();
    unsigned bprev = 1u;
    unsigned bcur = SBIT(1); bool acur = __any(bcur != 0u);
    if (acur) kload8(kf, kp0 + sl_cur);
    WAIT_BAR(2);
    bool aprev = true;
    s16x4 vfa0, vfa1, vfb0, vfb1; u32x4 pw0, pw1, pw2, pw3;
#define PKW(P, B) pkh(P[B], P[B + 1])
#define PAF(k) __builtin_bit_cast(h8, pw##k)
#define PIN(x) asm volatile("" : "+v"(x))
#define MX3(a, b, c) __builtin_fmaxf(__builtin_fmaxf((a), (b)), (c))
#define EX(v) __builtin_amdgcn_exp2f(v)
#define VRDP(i, LO, HI) do { LO = vtr2(vp_ + (((i) >> 2) * 4096 + ((i) & 3) * 1024)); HI = vtr2(vp_ + (((i) >> 2) * 4096 + ((i) & 3) * 1024 + 512)); } while (0)
#define KRD(G, j) do { if (G) { kload2(kf, kp0 + sl_next, j); SBAR(); } } while (0)
#define GAPA(AQ, AP, MF, A0, A1, A2, A3, W0, W1, PW) do { if (AQ) { MF; } if (AP) { sacc += A0; sacc += A1; sacc += A2; sacc += A3; PIN(sacc); W0; W1; PIN(PW); } SBAR(); } while (0)
#define GAPB(AQ, AP, MF, NEXTRD, X, B) do { if (AP) { MF; NEXTRD; } if (AQ) { X[B] = EX(X[B]); X[B + 1] = EX(X[B + 1]); X[B + 2] = EX(X[B + 2]); X[B + 3] = EX(X[B + 3]); PIN(X); } SBAR(); } while (0)
#define STEP(C0, C1, P0, P1, t, AQ, AP, GK, GV, GL) do { SBAR(); \
    const lds_cptr vp_ = vp0 + sl_prev; \
    if (!(AQ)) { asm volatile("" : "=v"(C0), "=v"(C1)); }        \
    float sacc = 0.f; \
    if (AP) { sacc = (P0[0] + P0[1]); } \
    GAPA(AQ, AP, C0 = MFMA32(kf[0], qr[0], negm), P0[2], P0[3], P0[4], P0[5],     pw0[0] = PKW(P0, 0), pw0[1] = PKW(P0, 2), pw0); \
    GAPA(AQ, AP, C1 = MFMA32(kf[1], qr[0], negm), P0[6], P0[7], P0[8], P0[9],     pw0[2] = PKW(P0, 4), pw0[3] = PKW(P0, 6), pw0); \
    GAPA(AQ, AP, C0 = MFMA32(kf[2], qr[1], C0),   P0[10], P0[11], P0[12], P0[13], pw1[0] = PKW(P0, 8), pw1[1] = PKW(P0, 10), pw1); \
    GAPA(AQ, AP, C1 = MFMA32(kf[3], qr[1], C1),   P0[14], P0[15], P1[0], P1[1],   pw1[2] = PKW(P0, 12), pw1[3] = PKW(P0, 14), pw1); \
    GAPA(AQ, AP, C0 = MFMA32(kf[4], qr[2], C0),   P1[2], P1[3], P1[4], P1[5],     pw2[0] = PKW(P1, 0), pw2[1] = PKW(P1, 2), pw2); \
    GAPA(AQ, AP, C1 = MFMA32(kf[5], qr[2], C1),   P1[6], P1[7], P1[8], P1[9],     pw2[2] = PKW(P1, 4), pw2[3] = PKW(P1, 6), pw2); \
    GAPA(AQ, AP, C0 = MFMA32(kf[6], qr[3], C0),   P1[10], P1[11], P1[12], P1[13], pw3[0] = PKW(P1, 8), pw3[1] = PKW(P1, 10), pw3); \
    GAPA(AQ, AP, C1 = MFMA32(kf[7], qr[3], C1),   P1[14], P1[15], 0.f, 0.f,       pw3[2] = PKW(P1, 12), pw3[3] = PKW(P1, 14), pw3); \
    if (AP) { const unsigned mw_ = bprev ? 0xFFFFFFFFu : 0u; l_reg += bprev ? sacc : 0.f;        \
        pw0 &= mw_; pw1 &= mw_; pw2 &= mw_; pw3 &= mw_; } \
    if (GK) { DMA_K((t) + 3, sl_cur); } if (GV) { DMA_V((t) + 1, sl_next); } \
    if (AP) { VRDP(0, vfa0, vfa1); } \
    resc = false; \
    if (AQ) { if ((t) == qt) cmask_own(C0, C1, ql, hi); \
      float a = MX3(C0[0], C0[1], C1[0]), b = MX3(C0[2], C0[3], C1[1]); a = MX3(a, C1[2], C1[3]); \
      _Pragma("unroll") for (int r = 4; r < 16; r += 4) { a = MX3(a, C0[r], C0[r + 1]); b = MX3(b, C0[r + 2], C0[r + 3]); a = MX3(a, C1[r], C1[r + 1]); b = MX3(b, C1[r + 2], C1[r + 3]); } \
      float rm = __builtin_fmaxf(a, b); { auto rr = __builtin_amdgcn_permlane32_swap(__float_as_uint(rm), __float_as_uint(rm), false, false); rm = __builtin_fmaxf(__uint_as_float(rr[0]), __uint_as_float(rr[1])); } \
      rm = bcur ? rm : -INFINITY; \
      const bool take_ = fresh && (rm > -INFINITY); \
      if (__builtin_expect(__any(rm > (float)THRL || take_), 0)) { const float dl = take_ ? rm : __builtin_fmaxf(rm, 0.f); mhat += dl; fresh = fresh && !take_; \
        _Pragma("unroll") for (int r = 0; r < 16; ++r) { C0[r] -= dl; C1[r] -= dl; } \
        _Pragma("unroll") for (int r = 0; r < 16; ++r) negm[r] = -mhat; asm volatile("" : "+v"(negm)); \
        const float f = take_ ? 1.f : __builtin_amdgcn_exp2f(-dl); l_reg *= f; { const int lr_ = opaque_tid() & 63; if (lr_ < 32) ((float*)(shm + LDS_WS))[wid * 64 + lr_] = f; } resc = true; } } \
    SBAR(); \
    GAPB(AQ, AP, o[0] = MFMA32(PAF(0), mk8(vfa0, vfa1), o[0]), VRDP(4, vfb0, vfb1), C0, 0); \
    GAPB(AQ, AP, o[1] = MFMA32(PAF(0), mk8(vfb0, vfb1), o[1]), VRDP(1, vfa0, vfa1), C0, 4); \
    KRD(GL, 0); GAPB(AQ, AP, o[0] = MFMA32(PAF(1), mk8(vfa0, vfa1), o[0]), VRDP(5, vfb0, vfb1), C0, 8); \
    KRD(GL, 1); GAPB(AQ, AP, o[1] = MFMA32(PAF(1), mk8(vfb0, vfb1), o[1]), VRDP(2, vfa0, vfa1), C0, 12); \
    KRD(GL, 2); GAPB(AQ, AP, o[0] = MFMA32(PAF(2), mk8(vfa0, vfa1), o[0]), VRDP(6, vfb0, vfb1), C1, 0); \
    KRD(GL, 3); GAPB(AQ, AP, o[1] = MFMA32(PAF(2), mk8(vfb0, vfb1), o[1]), VRDP(3, vfa0, vfa1), C1, 4); \
    GAPB(AQ, AP, o[0] = MFMA32(PAF(3), mk8(vfa0, vfa1), o[0]), VRDP(7, vfb0, vfb1), C1, 8); \
    GAPB(AQ, AP, o[1] = MFMA32(PAF(3), mk8(vfb0, vfb1), o[1]), (void)0, C1, 12); \
    } while (0)
#define STEPV(C0, C1, P0, P1, t) do { const unsigned bnext = SBIT((t) + 1); const bool anext = ((t) + 1 < NT) && __any(bnext != 0u); \
    const bool gk_ = ((t) + 3 < NT), gv_ = ((t) + 1 < NT); \
    STEP(C0, C1, P0, P1, t, acur, aprev, gk_, gv_, anext); \
    ENDW(t); RESC(); ROT(); bprev = bcur; aprev = acur; bcur = bnext; acur = anext; } while (0)
#define ENDW(tt) do { if ((tt) + 3 < NT) { WAIT_BAR(2); } else if ((tt) + 2 < NT) { WAIT_BAR(1); } else { WAIT_BAR(0); } } while (0)
    int t = 1;
    for (; t + 1 < NT; t += 2) {
        STEPV(pB0, pB1, pA0, pA1, t);
        STEPV(pA0, pA1, pB0, pB1, t + 1);
    }
    {
        const bool gk_ = false, gv_ = false;
        STEP(pB0, pB1, pA0, pA1, NT - 1, acur, aprev, gk_, gv_, false);
        RESC();
        if (acur) {
            float sacc = pB0[0] + pB0[1]; _Pragma("unroll") for (int r = 2; r < 16; ++r) sacc += pB0[r]; _Pragma("unroll") for (int r = 0; r < 16; ++r) sacc += pB1[r]; l_reg += bcur ? sacc : 0.f;
            const unsigned mw_ = bcur ? 0xFFFFFFFFu : 0u;
            pw0 = (u32x4){PKW(pB0, 0), PKW(pB0, 2), PKW(pB0, 4), PKW(pB0, 6)} & mw_; pw1 = (u32x4){PKW(pB0, 8), PKW(pB0, 10), PKW(pB0, 12), PKW(pB0, 14)} & mw_;
            pw2 = (u32x4){PKW(pB1, 0), PKW(pB1, 2), PKW(pB1, 4), PKW(pB1, 6)} & mw_; pw3 = (u32x4){PKW(pB1, 8), PKW(pB1, 10), PKW(pB1, 12), PKW(pB1, 14)} & mw_;
            SBAR(); pv(o, vb0 + sl_cur, PAF(0), PAF(1), PAF(2), PAF(3)); }
    }
    { auto rr = __builtin_amdgcn_permlane32_swap(__float_as_uint(l_reg), __float_as_uint(l_reg), false, false); l_reg = __uint_as_float(rr[0]) + __uint_as_float(rr[1]); }
    E(o, mhat, l_reg, shm, wid);
    asm volatile("s_waitcnt lgkmcnt(0)\n\ts_barrier" ::: "memory");
#undef DMA_K
#undef DMA_V
#undef SBIT
#undef START
#undef RESC
#undef ROT
#undef PKW
#undef PAF
#undef PIN
#undef MX3
#undef GAPA
#undef GAPB
#undef EX
#undef VRDP
#undef KRD
#undef STEP
#undef STEPV
#undef ENDW
}
struct EpiCmpA { const float* gates; f16* O; int b, g, q0; float& m_out; float& il_out;
    __device__ __forceinline__ void after_q() const {}
    __device__ __forceinline__ void operator()(const f32x16 (&o)[2], float mhat, float l, char* shm, int wid) const {
        const int le = opaque_tid() & 63; const float il = l > 0.f ? __builtin_amdgcn_rcpf(l) : 0.f;
        m_out = mhat; il_out = il;
        stage_rows(o, il, shm, wid, le);
        const f16* stg = (const f16*)(shm + LDS_OST) + wid * 2048;
        float gv[4]; h8 cv[4];
#pragma unroll
        for (int i = 0; i < 4; ++i) { const int row = i * 8 + (le >> 3), ch = le & 7; const int q = q0 + (row >> 2), hd = 4 * g + (row & 3);
            gv[i] = ((const GAS float*)gates)[((size_t)b * SEQ + q) * 24 + hd * 3]; cv[i] = *(const GAS h8*)(O + ((size_t)b * SEQ + q) * DM + 512 + hd * HD + ch * 8); }
#pragma unroll
        for (int i = 0; i < 4; ++i) { const int row = i * 8 + (le >> 3), ch = le & 7; const int q = q0 + (row >> 2), hd = 4 * g + (row & 3);
            const h8 v = *(const h8*)(stg + row * 64 + ch * 8); float r_[8];
#pragma unroll
            for (int e = 0; e < 8; ++e) r_[e] = (float)cv[i][e] + gv[i] * (float)v[e];
            u32x4 o4; o4.x = pkh(r_[0], r_[1]); o4.y = pkh(r_[2], r_[3]); o4.z = pkh(r_[4], r_[5]); o4.w = pkh(r_[6], r_[7]);
            *(GAS u32x4*)(O + ((size_t)b * SEQ + q) * DM + 512 + hd * HD + ch * 8) = o4; }
    } };
__device__ __forceinline__ float quad_sum2(float v) {
    v += __int_as_float(__builtin_amdgcn_mov_dpp(__float_as_int(v), 0xB1, 0xF, 0xF, true));
    v += __int_as_float(__builtin_amdgcn_mov_dpp(__float_as_int(v), 0x4E, 0xF, 0xF, true));
    return v;
}
constexpr int IMPS = 260;
__device__ __forceinline__ float swap_half(float x, int hi) { auto rr = __builtin_amdgcn_permlane32_swap(__float_as_uint(x), __float_as_uint(x), false, false); return __uint_as_float(hi ? rr[0] : rr[1]); }
__device__ __forceinline__ void unit_imp(const f16* qrow, const f16* __restrict__ Kh, const int nt, const int cmaxq, const float mhat, const float invl, LAS float* improw, char* shm) {
    const int tid = opaque_tid(), lane = tid & 63, r32 = lane & 31, hi = lane >> 5; const int wid = __builtin_amdgcn_readfirstlane(tid >> 6);
    const unsigned lds0 = (unsigned)(uintptr_t)shm;
    const f16* ksrc = Kh + (long)lane * 64 + wid * 8;
    const unsigned kdst = lds0 + LDS_K + wid * 1024;
    const lds_cptr kp0 = (lds_cptr)shm + LDS_K + hi * 1024 + r32 * 16;
#define DMA_K(t, slot) glds16(ksrc + (long)(t) * 4096, (unsigned)__builtin_amdgcn_readfirstlane(kdst + (slot)))
    DMA_K(0, 0); if (nt > 1) DMA_K(1, SLOTB); if (nt > 2) DMA_K(2, 2 * SLOTB);
    h8 qr[4];
#pragma unroll
    for (int d0 = 0; d0 < 4; ++d0) qr[d0] = *reinterpret_cast<const h8*>(qrow + d0 * 16 + hi * 8);
    f32x16 negm;
#pragma unroll
    for (int r = 0; r < 16; ++r) negm[r] = -mhat;
    const bool wr_lane = ((r32 & 3) == 0);
    int slot = 0; float carry = 0.f;
    for (int t = 0; t < nt; ++t) {
        if (t + 1 < nt) { WAIT_BAR(1); } else { WAIT_BAR(0); }
        if (t >= 1 && t + 2 < nt) { const int sp = (slot == 0) ? 2 * SLOTB : slot - SLOTB; DMA_K(t + 2, sp); }
        h8 kf[8]; kload8(kf, kp0 + slot);
        f32x16 p0 = MFMA32(kf[0], qr[0], negm), p1 = MFMA32(kf[1], qr[0], negm);
        p0 = MFMA32(kf[2], qr[1], p0); p1 = MFMA32(kf[3], qr[1], p1);
        p0 = MFMA32(kf[4], qr[2], p0); p1 = MFMA32(kf[5], qr[2], p1);
        p0 = MFMA32(kf[6], qr[3], p0); p1 = MFMA32(kf[7], qr[3], p1);
        const bool band = (64 * t + 63 > __builtin_amdgcn_readfirstlane(cmaxq) - 2);
#pragma unroll
        for (int r = 0; r < 16; ++r) { p0[r] = fexp2(p0[r]) * invl; p1[r] = fexp2(p1[r]) * invl; }
        if (band) {
#pragma unroll
            for (int r = 0; r < 16; ++r) { const int c = 64 * t + crow(r, hi); if (c > cmaxq) p0[r] = 0.f; if (c + 32 > cmaxq) p1[r] = 0.f; }
        }
        float G0[4], L0[4], G1[4], L1[4], R0[4], R1[4];
#pragma unroll
        for (int gq = 0; gq < 4; ++gq) {
            const float a0 = quad_sum2(p0[4 * gq]), a1 = quad_sum2(p0[4 * gq + 1]), a2 = quad_sum2(p0[4 * gq + 2]), a3 = quad_sum2(p0[4 * gq + 3]);
            const float b0 = quad_sum2(p1[4 * gq]), b1 = quad_sum2(p1[4 * gq + 1]), b2 = quad_sum2(p1[4 * gq + 2]), b3 = quad_sum2(p1[4 * gq + 3]);
            G0[gq] = (a0 + a1) + (a2 + a3); L0[gq] = a3; G1[gq] = (b0 + b1) + (b2 + b3); L1[gq] = b3;
        }
#pragma unroll
        for (int gq = 0; gq < 4; ++gq) { R0[gq] = swap_half(L0[gq], hi); R1[gq] = swap_half(L1[gq], hi); }
        if (wr_lane) {
            LAS float* irow = improw + 16 * t + hi;
#pragma unroll
            for (int gq = 0; gq < 4; ++gq) {
                const float prev0 = hi ? R0[gq] : (gq == 0 ? carry : R0[gq > 0 ? gq - 1 : 0]);
                const float prev1 = hi ? R1[gq] : (gq == 0 ? R0[3] : R1[gq > 0 ? gq - 1 : 0]);
                irow[2 * gq] = G0[gq] + prev0; irow[8 + 2 * gq] = G1[gq] + prev1;
            }
        }
        carry = R1[3];
        slot = (slot == 2 * SLOTB) ? 0 : slot + SLOTB;
    }
    asm volatile("s_waitcnt lgkmcnt(0)\n\ts_barrier" ::: "memory");
#undef DMA_K
}
#undef SBAR
#undef WAIT_BAR
}

__device__ __forceinline__ int sl_off(int j) { return 64 * ((j - 1) * 254 - ((j - 1) * j) / 2); }
constexpr int SL_BG = 64 * 32131;
constexpr int PIECE = 512;
__device__ __forceinline__ void nsa_cmp_unit(const f16* proj, const f16* kcmp, const f16* vcmp, const float* gates, f16* Onsa, unsigned* slist, gu32* scnt, int b, int g, int qt, LAS unsigned char* lds, char* shm) {
    const int tid = opaque_tid(), lane = tid & 63, r32 = lane & 31; const int wid = __builtin_amdgcn_readfirstlane(tid >> 6);
    LAS float* imp = (LAS float*)(lds + fa::LDS_V);
    const int ql = 8 * wid + (r32 >> 2), hd = 4 * g + (r32 & 3), qpos = 64 * qt + ql;
    const int pair = g * 2 + b;
    const f16* kc = kcmp + (size_t)pair * 1024 * HD; const f16* vc = vcmp + (size_t)pair * 1024 * HD;
    const f16* qp = proj + (size_t)(24 + hd) * (NB * SEQ * HD) + ((size_t)b * SEQ + qpos) * HD;
    const int cmaxq = (qpos >= 31) ? ((qpos - 31) >> 4) : -1;
    const int nt = ((4 * qt + 2) >> 6) + 1;
    const int NT = nt < 4 ? 4 : ((nt + 1) & ~1);
    float mrow = 0.f, ilrow = 0.f;
    fa::unit<8, false, true, fa::EpiCmpA, true>(qp, kc, vc, nullptr, nullptr, NT, cmaxq - 64 * (NT - 4), fa::EpiCmpA{gates, Onsa, b, g, 64 * qt + 8 * wid, mrow, ilrow}, shm);
    fa::unit_imp(qp, kc, nt, cmaxq, mrow, ilrow, imp + ql * fa::IMPS, shm);
    const int nfree = qt - 2;
    int vb[8][4];
#pragma unroll
    for (int qi = 0; qi < 8; ++qi) { const LAS float* irow = imp + (8 * wid + qi) * fa::IMPS;
#pragma unroll
        for (int i = 0; i < 4; ++i) { const int j = lane + 64 * i; vb[qi][i] = ((j >= 1) && (j <= qt - 2)) ? __float_as_int(irow[j]) : -1; } }
    int T[8];
#pragma unroll
    for (int qi = 0; qi < 8; ++qi) T[qi] = 0;
    if (nfree > 13) {
        for (int bit = 30; bit >= 0; --bit) {
#pragma unroll
            for (int qi = 0; qi < 8; ++qi) { const int cand = T[qi] | (1 << bit);
                const int cnt = __popcll(__ballot(vb[qi][0] >= cand)) + __popcll(__ballot(vb[qi][1] >= cand)) + __popcll(__ballot(vb[qi][2] >= cand)) + __popcll(__ballot(vb[qi][3] >= cand));
                T[qi] = (cnt >= 13) ? cand : T[qi]; }
        }
    }
    LAS int* lcnt = (LAS int*)lds; LAS int* lbase = lcnt + 256; LAS int* npend = lcnt + 512; LAS unsigned* pendA = (LAS unsigned*)(lds + 4096); LAS unsigned* pendB = (LAS unsigned*)(lds + 8192);
    if (tid < 256) lcnt[tid] = 0; if (tid == 256) *npend = 0;
    __syncthreads();
#pragma unroll
    for (int qi = 0; qi < 8; ++qi) {
        const int q = 8 * wid + qi; bool sfree[4];
        if (nfree <= 13) {
#pragma unroll
            for (int i = 0; i < 4; ++i) sfree[i] = (vb[qi][i] >= 0);
        } else {
            int ngt = 0; unsigned long long eqm[4];
#pragma unroll
            for (int i = 0; i < 4; ++i) { ngt += __popcll(__ballot(vb[qi][i] > T[qi])); eqm[i] = __ballot(vb[qi][i] == T[qi]); }
            const int need_eq = 13 - ngt; int before = 0;
#pragma unroll
            for (int i = 0; i < 4; ++i) { const int rank = before + __builtin_amdgcn_mbcnt_hi((unsigned)(eqm[i] >> 32), __builtin_amdgcn_mbcnt_lo((unsigned)eqm[i], 0));
                sfree[i] = (vb[qi][i] > T[qi]) || ((vb[qi][i] == T[qi]) && rank < need_eq); before += __popcll(eqm[i]); }
        }
        int sbefore = 0;
#pragma unroll
        for (int i = 0; i < 4; ++i) { const int j = lane + 64 * i; const unsigned long long fm = __ballot(sfree[i]);
            if (sfree[i]) { const int slot = sbefore + __builtin_amdgcn_mbcnt_hi((unsigned)(fm >> 32), __builtin_amdgcn_mbcnt_lo((unsigned)fm, 0));
                const int lr = __hip_atomic_fetch_add(lcnt + j, 1, __ATOMIC_RELAXED, __HIP_MEMORY_SCOPE_WORKGROUP);
                const int pi = __hip_atomic_fetch_add(npend, 1, __ATOMIC_RELAXED, __HIP_MEMORY_SCOPE_WORKGROUP);
                pendA[pi] = (unsigned)j | ((unsigned)lr << 8); pendB[pi] = (unsigned)(64 * qt + q) | ((unsigned)slot << 14); }
            sbefore += __popcll(fm); }
    }
    __syncthreads();
    if (tid < 256) { const int c = lcnt[tid]; lbase[tid] = c > 0 ? (int)__hip_atomic_fetch_add(scnt + tid, (unsigned)c, __ATOMIC_RELAXED, __HIP_MEMORY_SCOPE_AGENT) : 0; }
    __syncthreads();
    { const int np = *npend;
      for (int e = tid; e < np; e += 512) { const unsigned pa = pendA[e]; const int j = pa & 255, lr = pa >> 8; slist[sl_off(j) + lbase[j] + lr] = pendB[e]; } }
}

struct SelMergeF {
    static constexpr bool HAS_CS = false;
    const f16* proj; const unsigned char* PO; const float* PML; const float* gates; f16* O; int b, g, qt, nsl;
    int wid_, qpos, hd_, ql; LAS float* wtab;
    __device__ __forceinline__ void init(int wid, int r32, int hi) { wid_ = wid; ql = 8 * wid + (r32 >> 2); hd_ = 4 * g + (r32 & 3); qpos = 64 * qt + ql; }
    __device__ __forceinline__ const f16* qrow() const { return proj + (size_t)(24 + hd_) * (NB * SEQ * HD) + ((size_t)b * SEQ + qpos) * HD; }
    __device__ __forceinline__ int t_begin() const { return 0; }
    __device__ __forceinline__ int t_end() const { return qt >= 2 ? 3 : qt + 1; }
    __device__ __forceinline__ int blk(int t) const { return qt >= 2 ? (t == 0 ? 0 : qt - 2 + t) : t; }
    __device__ __forceinline__ const char* ktile(int t) const { return (const char*)(proj + (size_t)(34 + g) * (NB * SEQ * HD) + (size_t)b * SEQ * HD) + (size_t)blk(t) * 8192; }
    __device__ __forceinline__ const char* vtile(int t) const { return (const char*)(proj + (size_t)(40 + g) * (NB * SEQ * HD) + (size_t)b * SEQ * HD) + (size_t)blk(t) * 8192; }
    __device__ __forceinline__ const float* cs_src(int) const { return nullptr; }
    __device__ __forceinline__ void unit_prep(LAS unsigned char* lds, int) { wtab = (LAS float*)(lds + L_IMP); }
    __device__ __forceinline__ bool active(int) const { return true; }
    __device__ __forceinline__ void mask(f32x16& p0, f32x16& p1, int t, const LAS float*, int hi) const {
        if (blk(t) == qt) {
#pragma unroll
            for (int r = 0; r < 16; ++r) { const int kvp = crow(r, hi); if (kvp > ql) p0[r] = -INFINITY; if (kvp + 32 > ql) p1[r] = -INFINITY; }
        }
    }
    __device__ __forceinline__ void store(const LAS f16* stg, int lane, const LAS float* wsf) const {
        LAS float* tab = wtab + wid_ * 512;
        if (lane < 32) { const int row = lane; const int q = 64 * qt + 8 * wid_ + (row >> 2), hdl = row & 3;
            const float mF = wsf[row], lF = wsf[32 + row]; float M = mF; float ms[13], ls[13];
#pragma unroll
            for (int s_ = 0; s_ < 13; ++s_) { ms[s_] = -INFINITY; ls[s_] = 0.f; if (s_ < nsl) { const f32x2 ml = *(const f32x2*)(PML + 2 * (((size_t)q * 13 + s_) * 4 + hdl)); ms[s_] = ml[0]; ls[s_] = ml[1]; M = fmaxf(M, ml[0]); } }
            const float wF = fexp2(mF - M) * lF; float den = wF; float w[13];
#pragma unroll
            for (int s_ = 0; s_ < 13; ++s_) { w[s_] = (s_ < nsl) ? fexp2(ms[s_] - M) * ls[s_] : 0.f; den += w[s_]; }
            const float rd = 1.f / den; tab[row * 16] = wF * rd;
#pragma unroll
            for (int s_ = 0; s_ < 13; ++s_) tab[row * 16 + 1 + s_] = w[s_] * rd;
        }
        LDS_WAIT();
        float g1v[4]; h8 cv[4];
#pragma unroll
        for (int i = 0; i < 4; ++i) { const int row = i * 8 + (lane >> 3), ch = lane & 7; const int q = 64 * qt + 8 * wid_ + (row >> 2), hdl = row & 3;
            g1v[i] = ((const GAS float*)gates)[((size_t)b * SEQ + q) * 24 + (4 * g + hdl) * 3 + 1]; cv[i] = *(const GAS h8*)(O + ((size_t)b * SEQ + q) * DM + 512 + (4 * g + hdl) * HD + ch * 8); }
        u32x2 pvn[13];
        { const int row = lane >> 3, ch = lane & 7; const int q = 64 * qt + 8 * wid_ + (row >> 2), hdl = row & 3;
#pragma unroll
          for (int s_ = 0; s_ < 13; ++s_) pvn[s_] = *(const GAS u32x2*)(PO + (((size_t)q * 13 + (s_ < nsl ? s_ : 0)) * 4 + hdl) * 64 + ch * 8); }
#pragma unroll
        for (int i = 0; i < 4; ++i) { const int row = i * 8 + (lane >> 3), ch = lane & 7; const int q = 64 * qt + 8 * wid_ + (row >> 2), hdl = row & 3;
            const LAS float* a = tab + row * 16; const h8 own = *(const LAS h8*)(stg + row * 64 + ch * 8);
            float acc[8];
#pragma unroll
            for (int e = 0; e < 8; ++e) acc[e] = a[0] * (float)own[e];
            u32x2 pvs[13];
#pragma unroll
            for (int s_ = 0; s_ < 13; ++s_) pvs[s_] = pvn[s_];
            if (i + 1 < 4) { const int row1 = (i + 1) * 8 + (lane >> 3); const int q1 = 64 * qt + 8 * wid_ + (row1 >> 2), hdl1 = row1 & 3;
#pragma unroll
                for (int s_ = 0; s_ < 13; ++s_) pvn[s_] = *(const GAS u32x2*)(PO + (((size_t)q1 * 13 + (s_ < nsl ? s_ : 0)) * 4 + hdl1) * 64 + ch * 8); }
#pragma unroll
            for (int s_ = 0; s_ < 13; ++s_) if (s_ < nsl) { const float as = a[1 + s_];
                acc[0] += as * __builtin_amdgcn_cvt_f32_fp8(pvs[s_].x, 0); acc[1] += as * __builtin_amdgcn_cvt_f32_fp8(pvs[s_].x, 1); acc[2] += as * __builtin_amdgcn_cvt_f32_fp8(pvs[s_].x, 2); acc[3] += as * __builtin_amdgcn_cvt_f32_fp8(pvs[s_].x, 3);
                acc[4] += as * __builtin_amdgcn_cvt_f32_fp8(pvs[s_].y, 0); acc[5] += as * __builtin_amdgcn_cvt_f32_fp8(pvs[s_].y, 1); acc[6] += as * __builtin_amdgcn_cvt_f32_fp8(pvs[s_].y, 2); acc[7] += as * __builtin_amdgcn_cvt_f32_fp8(pvs[s_].y, 3); }
            const float g1 = g1v[i];
            f16* op = O + ((size_t)b * SEQ + q) * DM + 512 + (4 * g + hdl) * HD + ch * 8;
            const h8 c = cv[i]; float r_[8];
#pragma unroll
            for (int e = 0; e < 8; ++e) r_[e] = (float)c[e] + g1 * acc[e];
            u32x4 o4; o4.x = pkh(r_[0], r_[1]); o4.y = pkh(r_[2], r_[3]); o4.z = pkh(r_[4], r_[5]); o4.w = pkh(r_[6], r_[7]);
            *(u32x4*)op = o4; }
        LDS_WAIT();
    }
};
__device__ __forceinline__ void sel_gather_unit(const f16* proj, int b, int g, int j, const unsigned* ent, int cnt, unsigned char* PO, float* PML, LAS unsigned char* lds) {
    const int tid = opaque_tid(), lane = tid & 63, r32 = lane & 31, hi = lane >> 5; const int wid = __builtin_amdgcn_readfirstlane(tid >> 6);
    __syncthreads();
    { KVStage st; kv_issue(st, (const char*)(proj + (size_t)(34 + g) * (NB * SEQ * HD) + (size_t)b * SEQ * HD) + (size_t)j * 8192, (const char*)(proj + (size_t)(40 + g) * (NB * SEQ * HD) + (size_t)b * SEQ * HD) + (size_t)j * 8192, wid, lane); kv_write(st, lds, wid, lane); }
    __syncthreads();
    LAS float* wsf = (LAS float*)(lds + L_WSF) + wid * 64; LAS f16* stg = (LAS f16*)(lds + 32768) + wid * 4096; LAS int* tab = (LAS int*)(lds + L_SEL) + wid * 64;
    LAS float* rinv = (LAS float*)(lds + 98304) + wid * 64;
    const f16* qbase = proj + (size_t)(24 + 4 * g + (r32 & 3)) * (NB * SEQ * HD) + (size_t)b * SEQ * HD;
    const int nch = (cnt + 7) >> 3, el = r32 >> 2;
    const GAS unsigned* entg = (const GAS unsigned*)ent;
    int codeN[2], codeNN[2]; h8 qn[2][4];
#pragma unroll
    for (int k = 0; k < 2; ++k) { const int c = 2 * wid + k; codeN[k] = (c < nch && 8 * c + el < cnt) ? (int)entg[8 * c + el] : -1;
        const int c2 = c + 16; codeNN[k] = (c2 < nch && 8 * c2 + el < cnt) ? (int)entg[8 * c2 + el] : -1; }
#pragma unroll
    for (int k = 0; k < 2; ++k) { const f16* qp = qbase + (size_t)((codeN[k] < 0 ? 0 : codeN[k]) & 16383) * HD;
#pragma unroll
        for (int d0 = 0; d0 < 4; ++d0) qn[k][d0] = *(const GAS h8*)(qp + 16 * d0 + 8 * hi); }
    for (int c0 = 2 * wid; c0 < nch; c0 += 16) {
        int code[2]; h8 qr[2][4];
#pragma unroll
        for (int k = 0; k < 2; ++k) { code[k] = codeN[k];
#pragma unroll
            for (int d0 = 0; d0 < 4; ++d0) qr[k][d0] = qn[k][d0]; }
#pragma unroll
        for (int k = 0; k < 2; ++k) { codeN[k] = codeNN[k]; const int c2 = c0 + 32 + k; codeNN[k] = (c2 < nch && 8 * c2 + el < cnt) ? (int)entg[8 * c2 + el] : -1;
            const f16* qp = qbase + (size_t)((codeN[k] < 0 ? 0 : codeN[k]) & 16383) * HD;
#pragma unroll
            for (int d0 = 0; d0 < 4; ++d0) qn[k][d0] = *(const GAS h8*)(qp + 16 * d0 + 8 * hi); }
        f32x16 p0[2], p1[2], o[2][2]; float m[2], l[2];
#pragma unroll
        for (int k = 0; k < 2; ++k) qk_tile(p0[k], p1[k], lds, qr[k], r32, hi);
#pragma unroll
        for (int k = 0; k < 2; ++k) { m[k] = rowmax32(p0[k], p1[k]); l[k] = 0.f;
#pragma unroll
            for (int r = 0; r < 16; ++r) { p0[k][r] = fexp2(p0[k][r] - m[k]); p1[k][r] = fexp2(p1[k][r] - m[k]); l[k] += p0[k][r] + p1[k][r]; } }
#pragma unroll
        for (int k = 0; k < 2; ++k) {
#pragma unroll
            for (int r = 0; r < 16; ++r) { o[k][0][r] = 0.f; o[k][1][r] = 0.f; }
            u32x4 pw[4]; pack_p(pw, p0[k], p1[k]); pv_tile(o[k], lds + 8192, pw, lane, hi); l[k] = swapsum(l[k]); }
#pragma unroll
        for (int k = 0; k < 2; ++k) { const bool valid = code[k] >= 0; const int dst = valid ? (((code[k] & 16383) * 13 + (code[k] >> 14)) * 4 + (r32 & 3)) : -1;
            if (hi == 0) { tab[32 * k + r32] = dst; rinv[32 * k + r32] = 1.f / l[k]; if (valid) { f32x2 ml = {m[k], l[k]}; *(GAS f32x2*)(PML + 2 * (size_t)dst) = ml; } } }
        LDS_WAIT();
#pragma unroll
        for (int k = 0; k < 2; ++k)
#pragma unroll
            for (int r = 0; r < 16; ++r) { const int orow = crow(r, hi); const float rl = rinv[32 * k + orow];
                stg[(32 * k + orow) * 64 + r32] = (f16)(o[k][0][r] * rl); stg[(32 * k + orow) * 64 + 32 + r32] = (f16)(o[k][1][r] * rl); }
        LDS_WAIT();
#pragma unroll
        for (int i = 0; i < 8; ++i) { const int row = i * 8 + (lane >> 3), ch = lane & 7; const int d = tab[row];
            if (d >= 0) { const h8 v = *(const LAS h8*)(stg + row * 64 + ch * 8); u32x2 w = {0u, 0u};
                w.x = __builtin_amdgcn_cvt_pk_fp8_f32((float)v[0], (float)v[1], w.x, false); w.x = __builtin_amdgcn_cvt_pk_fp8_f32((float)v[2], (float)v[3], w.x, true);
                w.y = __builtin_amdgcn_cvt_pk_fp8_f32((float)v[4], (float)v[5], w.y, false); w.y = __builtin_amdgcn_cvt_pk_fp8_f32((float)v[6], (float)v[7], w.y, true);
                *(GAS u32x2*)(PO + (size_t)d * 64 + ch * 8) = w; } }
        LDS_WAIT();
    }
    (void)wsf;
}
constexpr int LIST_BH = 256 * 2016;
__device__ __forceinline__ int list_off(int j) { return 256 * (63 * j - (j * (j - 1)) / 2); }
__device__ __forceinline__ void top3_ins(float s, int n, float& v0, float& v1, float& v2, int& i0, int& i1, int& i2) {
    const bool g0 = s > v0, g1 = s > v1, g2 = s > v2;
    v2 = g1 ? v1 : (g2 ? s : v2); i2 = g1 ? i1 : (g2 ? n : i2);
    v1 = g0 ? v0 : (g1 ? s : v1); i1 = g0 ? i0 : (g1 ? n : i1);
    v0 = g0 ? s : v0; i0 = g0 ? n : i0;
}
__device__ __forceinline__ void top3_ins_tie(float s, int n, float& v0, float& v1, float& v2, int& i0, int& i1, int& i2) {
    const bool g0 = s > v0 || (s == v0 && n < i0), g1 = s > v1 || (s == v1 && n < i1), g2 = s > v2 || (s == v2 && n < i2);
    v2 = g1 ? v1 : (g2 ? s : v2); i2 = g1 ? i1 : (g2 ? n : i2);
    v1 = g0 ? v0 : (g1 ? s : v1); i1 = g0 ? i0 : (g1 ? n : i1);
    v0 = g0 ? s : v0; i0 = g0 ? n : i0;
}
__device__ __forceinline__ float swapf(float x) { auto rr = __builtin_amdgcn_permlane32_swap(__float_as_uint(x), __float_as_uint(x), false, false); const int hi = (opaque_tid() >> 5) & 1; return __uint_as_float(hi ? rr[0] : rr[1]); }
__device__ __forceinline__ void moba_gate_unit(const f16* qslot, const f16* kimg, unsigned short* lists, gu32* cnt, int unit, LAS unsigned char* lds) {
    const int tid = opaque_tid(), lane = tid & 63, r32 = lane & 31, hi = lane >> 5; const int wid = __builtin_amdgcn_readfirstlane(tid >> 6);
    const int bh = unit >> 6, blk = unit & 63;
    LAS int* lcnt = (LAS int*)(lds + 16384); LAS int* lbase = lcnt + 64;
    __syncthreads();
    { const u32x4* src = (const u32x4*)(kimg + (size_t)bh * 8192); LAS u32x4* dst = (LAS u32x4*)lds; dst[tid] = src[tid]; dst[tid + 512] = src[tid + 512]; }
    if (tid < 64) lcnt[tid] = 0;
    __syncthreads();
    const int qpos = 256 * blk + 32 * wid + r32;
    const f16* qp = qslot + ((size_t)bh * SEQ + qpos) * HD;
    h8 qr[4];
#pragma unroll
    for (int d0 = 0; d0 < 4; ++d0) qr[d0] = *(const h8*)(qp + 16 * d0 + 8 * hi);
    float v0 = -INFINITY, v1 = -INFINITY, v2 = -INFINITY; int i0 = -1, i1 = -1, i2 = -1;
    if (blk > 0) {
        f32x16 ph0, ph1, pl0, pl1;
        qk_tile(ph0, ph1, lds, qr, r32, hi); qk_tile(pl0, pl1, lds + 8192, qr, r32, hi);
#pragma unroll
        for (int r = 0; r < 16; ++r) { const int n = crow(r, hi); const float g = ph0[r] + pl0[r] * (1.f / 4096.f); if (n < blk) top3_ins(g, n, v0, v1, v2, i0, i1, i2); }
#pragma unroll
        for (int r = 0; r < 16; ++r) { const int n = 32 + crow(r, hi); const float g = ph1[r] + pl1[r] * (1.f / 4096.f); if (n < blk) top3_ins(g, n, v0, v1, v2, i0, i1, i2); }
        const float w0 = swapf(v0), w1 = swapf(v1), w2 = swapf(v2); const int j0 = __float_as_int(swapf(__int_as_float(i0))), j1 = __float_as_int(swapf(__int_as_float(i1))), j2 = __float_as_int(swapf(__int_as_float(i2)));
        if (j0 >= 0) top3_ins_tie(w0, j0, v0, v1, v2, i0, i1, i2);
        if (j1 >= 0) top3_ins_tie(w1, j1, v0, v1, v2, i0, i1, i2);
        if (j2 >= 0) top3_ins_tie(w2, j2, v0, v1, v2, i0, i1, i2);
    }
    const bool own = (hi == 0);
    int r0 = 0, r1 = 0, r2 = 0;
    if (own && i0 >= 0) r0 = __hip_atomic_fetch_add(lcnt + i0, 1, __ATOMIC_RELAXED, __HIP_MEMORY_SCOPE_WORKGROUP);
    if (own && i1 >= 0) r1 = __hip_atomic_fetch_add(lcnt + i1, 1, __ATOMIC_RELAXED, __HIP_MEMORY_SCOPE_WORKGROUP);
    if (own && i2 >= 0) r2 = __hip_atomic_fetch_add(lcnt + i2, 1, __ATOMIC_RELAXED, __HIP_MEMORY_SCOPE_WORKGROUP);
    __syncthreads();
    if (tid < 64) { const int c = lcnt[tid]; lbase[tid] = c > 0 ? (int)__hip_atomic_fetch_add(cnt + bh * 64 + tid, (unsigned)c, __ATOMIC_RELAXED, __HIP_MEMORY_SCOPE_AGENT) : 0; }
    __syncthreads();
    unsigned short* lb = lists + (size_t)bh * LIST_BH;
    if (own && i0 >= 0) lb[list_off(i0) + lbase[i0] + r0] = (unsigned short)(qpos);
    if (own && i1 >= 0) lb[list_off(i1) + lbase[i1] + r1] = (unsigned short)(qpos | (1 << 14));
    if (own && i2 >= 0) lb[list_off(i2) + lbase[i2] + r2] = (unsigned short)(qpos | (2 << 14));
}
__device__ __forceinline__ void moba_gather_unit3(const f16* qs, const f16* kblk, const f16* vblk, const unsigned short* ent, int n, int hh, f16* PO, float* PML, LAS unsigned char* lds, char* shm) {
    const int tid = opaque_tid(), lane = tid & 63; const int wid = __builtin_amdgcn_readfirstlane(tid >> 6);
    const int qoff = wid < 4 ? 32768 + wid * 4096 : fa::RES_V + 32768 + (wid - 4) * 4096;
    const unsigned qst = (unsigned)(uintptr_t)shm + (unsigned)qoff;
    __syncthreads();
    const GAS unsigned short* entg = (const GAS unsigned short*)ent;
    int codeN = (wid * 32 + (lane & 31) < n) ? (int)entg[wid * 32 + (lane & 31)] : -1;
    int codeNN = ((wid + 8) * 32 + (lane & 31) < n) ? (int)entg[(wid + 8) * 32 + (lane & 31)] : -1;
    KVStage st[4];
#pragma unroll
    for (int t = 0; t < 4; ++t) kv_issue(st[t], (const char*)kblk + t * 8192, (const char*)vblk + t * 8192, wid, lane);
    {
#pragma unroll
        for (int i = 0; i < 4; ++i) { const int cn = __shfl(codeN, 8 * i + (lane >> 3), 64);
            fa::glds16(qs + (size_t)((cn < 0 ? 0 : cn) & 16383) * HD + (lane & 7) * 8, (unsigned)__builtin_amdgcn_readfirstlane(qst + i * 1024)); }
    }
#pragma unroll
    for (int t = 0; t < 4; ++t) { *(LAS u32x4*)(lds + t * 8192 + wid * 1024 + lane * 16) = st[t].k; *(LAS u32x4*)(lds + fa::RES_V + t * 8192 + wid * 1024 + lane * 16) = st[t].v; }
    __syncthreads();
    for (int c = wid; c * 32 < n; c += 8) {
        const int code = codeN;
        const int dst = code >= 0 ? (hh * SEQ + (code & 16383)) * 3 + (code >> 14) : -1;
        asm volatile("s_waitcnt vmcnt(0)" ::: "memory");
        codeN = codeNN;
        { const int e2 = (c + 16) * 32 + (opaque_tid() & 31); codeNN = (e2 < n) ? (int)entg[e2] : -1; }
        fa::unit<8, false, false, fa::EpiPartial, false, true>((const f16*)(shm + qoff) + (opaque_tid() & 31) * HD, nullptr, nullptr, nullptr, nullptr, 4, fa::QREL_ROW, fa::EpiPartial{PO, PML, dst, qs, codeN, qst}, shm);
    }
}
__device__ __forceinline__ void fox_norm_unit(const f16* qb_, const f16* kb_, float* qn2, float* qdmin, gu32* kn2, LAS unsigned char* lds) {
    const int tid = opaque_tid(); const int t = tid & 255; const bool isq = tid < 256;
    const f16* rp = (isq ? qb_ : kb_) + (size_t)t * HD; const f16* kp = kb_ + (size_t)t * HD;
    float s = 0.f, d = 0.f;
#pragma unroll
    for (int c = 0; c < 8; ++c) { const h8 x = *(const h8*)(rp + 8 * c); const h8 y = *(const h8*)(kp + 8 * c);
#pragma unroll
        for (int e = 0; e < 8; ++e) { s += (float)x[e] * (float)x[e]; d += (float)x[e] * (float)y[e]; } }
#pragma unroll
    for (int o = 1; o < 64; o <<= 1) { s = fmaxf(s, __shfl_xor(s, o)); d = fminf(d, __shfl_xor(d, o)); }
    LAS float* red = (LAS float*)lds;
    __syncthreads();
    if ((tid & 63) == 0) { red[tid >> 6] = s; red[8 + (tid >> 6)] = d; }
    __syncthreads();
    if (tid == 0) { *qn2 = fmaxf(fmaxf(red[0], red[1]), fmaxf(red[2], red[3])); *qdmin = fminf(fminf(red[8], red[9]), fminf(red[10], red[11])); }
    if (tid == 256) (void)__hip_atomic_fetch_max(kn2, __float_as_uint(fmaxf(fmaxf(red[4], red[5]), fmaxf(red[6], red[7]))), __ATOMIC_RELAXED, __HIP_MEMORY_SCOPE_AGENT);
}
__device__ __forceinline__ void kbar_block(const f16* kslot, f16* kimg, int unit, int lane) {
    const int kg = lane >> 3, dc = lane & 7;
    const f16* kp = kslot + ((size_t)(unit >> 6) * SEQ + 256 * (unit & 63)) * HD + dc * 8;
    float a[8];
#pragma unroll
    for (int e = 0; e < 8; ++e) a[e] = 0.f;
#pragma unroll 1
    for (int i0 = 0; i0 < 32; i0 += 8) {
        h8 x[8];
#pragma unroll
        for (int i = 0; i < 8; ++i) x[i] = *(const h8*)(kp + (size_t)(kg + 8 * (i0 + i)) * HD);
#pragma unroll
        for (int i = 0; i < 8; ++i)
#pragma unroll
            for (int e = 0; e < 8; ++e) a[e] += (float)x[i][e]; }
#pragma unroll
    for (int e = 0; e < 8; ++e) { a[e] += __shfl_xor(a[e], 8); a[e] += __shfl_xor(a[e], 16); a[e] += __shfl_xor(a[e], 32); }
    if (kg == 0) {
        h8 hi8, lo8;
#pragma unroll
        for (int e = 0; e < 8; ++e) { const float mval = a[e] * (1.f / 256.f); const f16 hh = (f16)mval; hi8[e] = hh; lo8[e] = (f16)((mval - (float)hh) * 4096.f); }
        f16* ib = kimg + (size_t)(unit >> 6) * 8192 + dc * 512 + (unit & 63) * 8;
        *(h8*)ib = hi8; *(h8*)(ib + 4096) = lo8;
    }
}
__device__ __forceinline__ void scan_bh(const float* logf, float* c, LAS unsigned char* lds) {
    const int tid = opaque_tid(), lane = tid & 63, wid = tid >> 6;
    LAS double* wsum = (LAS double*)lds;
    float x[32]; double run = 0.0;
#pragma unroll
    for (int i = 0; i < 8; ++i) { const f32x4 v = *(const f32x4*)(logf + tid * 32 + 4 * i); x[4 * i] = v[0]; x[4 * i + 1] = v[1]; x[4 * i + 2] = v[2]; x[4 * i + 3] = v[3]; }
#pragma unroll
    for (int i = 0; i < 32; ++i) run += (double)x[i];
    double inc = run;
#pragma unroll
    for (int o = 1; o < 64; o <<= 1) { const double y = __shfl_up(inc, o); if (lane >= o) inc += y; }
    __syncthreads();
    if (lane == 63) wsum[wid] = inc;
    __syncthreads();
    double base = inc - run;
    for (int w = 0; w < wid; ++w) base += wsum[w];
    double acc = base;
#pragma unroll
    for (int i = 0; i < 8; ++i) { f32x4 o;
#pragma unroll
        for (int j = 0; j < 4; ++j) { acc += (double)x[4 * i + j]; o[j] = (float)(acc * (double)LOG2E); }
        *(f32x4*)(c + tid * 32 + 4 * i) = o; }
    __syncthreads();
}

typedef f16 ytype;
#define YF16 1
template <int NR, bool LAST> __device__ __forceinline__ void norm_rows(const f16* xin, const f16* y, f16* xout, float* rsout, float* fout, const float* gpost, size_t rstride, int lane) {
    h8 xw[NR][2], yw[NR][2];
#pragma unroll
    for (int k = 0; k < NR; ++k)
#pragma unroll
        for (int j = 0; j < 2; ++j) { xw[k][j] = *(const h8*)(xin + k * rstride + 8 * lane + 512 * j); yw[k][j] = *(const h8*)(y + k * rstride + 8 * lane + 512 * j); }
    f32x4 gp[2][2];
#pragma unroll
    for (int j = 0; j < 2; ++j) { gp[j][0] = *(const f32x4*)(gpost + 8 * lane + 512 * j); gp[j][1] = *(const f32x4*)(gpost + 8 * lane + 512 * j + 4); }
#pragma unroll
    for (int k = 0; k < NR; ++k) {
        float yv[2][8]; float ss = 0.f;
#pragma unroll
        for (int j = 0; j < 2; ++j)
#pragma unroll
            for (int e = 0; e < 8; ++e) { yv[j][e] = (float)yw[k][j][e]; ss += yv[j][e] * yv[j][e]; }
        const float rs = 1.f / sqrtf(wave_sum(ss) * (1.f / DM) + RMS_EPS);
        float xn[2][8]; float s2 = 0.f;
#pragma unroll
        for (int j = 0; j < 2; ++j)
#pragma unroll
            for (int e = 0; e < 8; ++e) { xn[j][e] = (float)xw[k][j][e] + yv[j][e] * rs * gp[j][e >> 2][e & 3]; s2 += xn[j][e] * xn[j][e]; }
        if (LAST) {
#pragma unroll
            for (int j = 0; j < 2; ++j) { float* op = fout + k * rstride + 8 * lane + 512 * j;
                *(GAS f32x4*)op = (f32x4){xn[j][0], xn[j][1], xn[j][2], xn[j][3]}; *(GAS f32x4*)(op + 4) = (f32x4){xn[j][4], xn[j][5], xn[j][6], xn[j][7]}; }
        } else {
            const float r2 = 1.f / sqrtf(wave_sum(s2) * (1.f / DM) + RMS_EPS);
#pragma unroll
            for (int j = 0; j < 2; ++j) { u32x4 w; w.x = pkh(xn[j][0], xn[j][1]); w.y = pkh(xn[j][2], xn[j][3]); w.z = pkh(xn[j][4], xn[j][5]); w.w = pkh(xn[j][6], xn[j][7]);
                *(GAS u32x4*)(xout + k * rstride + 8 * lane + 512 * j) = w; }
            if (lane == 0) rsout[k * (rstride / DM)] = r2;
        }
    }
}
struct RowPair { h8 xw[2][2], yw[2][2]; };
__device__ __forceinline__ void rowpair_load(RowPair& r, const f16* xin, const f16* y, int lane) {
#pragma unroll
    for (int k = 0; k < 2; ++k)
#pragma unroll
        for (int j = 0; j < 2; ++j) { r.xw[k][j] = *(const GAS h8*)(xin + (size_t)k * 8 * DM + 8 * lane + 512 * j); r.yw[k][j] = *(const GAS h8*)(y + (size_t)k * 8 * DM + 8 * lane + 512 * j); }
}
template <bool LAST> __device__ __forceinline__ void rowpair_finish(const RowPair& r, const f32x4 (&gp)[2][2], f16* xout, float* rsout, float* fout, int lane) {
#pragma unroll
    for (int k = 0; k < 2; ++k) {
        float yv[2][8]; float ss = 0.f;
#pragma unroll
        for (int j = 0; j < 2; ++j)
#pragma unroll
            for (int e = 0; e < 8; ++e) { yv[j][e] = (float)r.yw[k][j][e]; ss += yv[j][e] * yv[j][e]; }
        const float rs = 1.f / sqrtf(wave_sum(ss) * (1.f / DM) + RMS_EPS);
        float xn[2][8]; float s2 = 0.f;
#pragma unroll
        for (int j = 0; j < 2; ++j)
#pragma unroll
            for (int e = 0; e < 8; ++e) { xn[j][e] = (float)r.xw[k][j][e] + yv[j][e] * rs * gp[j][e >> 2][e & 3]; s2 += xn[j][e] * xn[j][e]; }
        if (LAST) {
#pragma unroll
            for (int j = 0; j < 2; ++j) { float* op = fout + (size_t)k * 8 * DM + 8 * lane + 512 * j;
                *(GAS f32x4*)op = (f32x4){xn[j][0], xn[j][1], xn[j][2], xn[j][3]}; *(GAS f32x4*)(op + 4) = (f32x4){xn[j][4], xn[j][5], xn[j][6], xn[j][7]}; }
        } else {
            const float r2 = 1.f / sqrtf(wave_sum(s2) * (1.f / DM) + RMS_EPS);
#pragma unroll
            for (int j = 0; j < 2; ++j) { u32x4 w; w.x = pkh(xn[j][0], xn[j][1]); w.y = pkh(xn[j][2], xn[j][3]); w.z = pkh(xn[j][4], xn[j][5]); w.w = pkh(xn[j][6], xn[j][7]);
                *(GAS u32x4*)(xout + (size_t)k * 8 * DM + 8 * lane + 512 * j) = w; }
            if (lane == 0) ((GAS float*)rsout)[k * 8] = r2;
        }
    }
}
template <bool LAST> __device__ __forceinline__ void norm_rows16(const f16* xin, const f16* y, f16* xout, float* rsout, float* fout, const float* gpost, int lane) {
    f32x4 gp[2][2];
#pragma unroll
    for (int j = 0; j < 2; ++j) { gp[j][0] = *(const GAS f32x4*)(gpost + 8 * lane + 512 * j); gp[j][1] = *(const GAS f32x4*)(gpost + 8 * lane + 512 * j + 4); }
    RowPair a, b;
    rowpair_load(a, xin, y, lane);
#pragma unroll
    for (int i = 0; i < 8; i += 2) {
        rowpair_load(b, xin + (size_t)(i + 1) * DM, y + (size_t)(i + 1) * DM, lane);
        rowpair_finish<LAST>(a, gp, LAST ? nullptr : xout + (size_t)i * DM, LAST ? nullptr : rsout + i, LAST ? fout + (size_t)i * DM : nullptr, lane);
        if (i + 2 < 8) rowpair_load(a, xin + (size_t)(i + 2) * DM, y + (size_t)(i + 2) * DM, lane);
        rowpair_finish<LAST>(b, gp, LAST ? nullptr : xout + (size_t)(i + 1) * DM, LAST ? nullptr : rsout + i + 1, LAST ? fout + (size_t)(i + 1) * DM : nullptr, lane);
    }
}
__device__ __forceinline__ void norm0_rows2(const float* xin, f16* xh, float* rsout, size_t rstride, int lane) {
    f32x4 xv[2][4];
#pragma unroll
    for (int k = 0; k < 2; ++k)
#pragma unroll
        for (int j = 0; j < 4; ++j) xv[k][j] = *(const GAS f32x4*)(xin + k * rstride * DM + 4 * lane + 256 * j);
#pragma unroll
    for (int k = 0; k < 2; ++k) { float s2 = 0.f;
#pragma unroll
        for (int j = 0; j < 4; ++j) s2 += (xv[k][j][0] * xv[k][j][0] + xv[k][j][1] * xv[k][j][1]) + (xv[k][j][2] * xv[k][j][2] + xv[k][j][3] * xv[k][j][3]);
        const float r2 = 1.f / sqrtf(wave_sum(s2) * (1.f / DM) + RMS_EPS);
#pragma unroll
        for (int j = 0; j < 4; ++j) { u32x2 w; w.x = pkh(xv[k][j][0], xv[k][j][1]); w.y = pkh(xv[k][j][2], xv[k][j][3]); *(GAS u32x2*)(xh + k * rstride * DM + 4 * lane + 256 * j) = w; }
        if (lane == 0) rsout[k * rstride] = r2; }
}
__device__ __forceinline__ void norm0_row(const float* xin, f16* xh, float* rsout, int lane) {
    f32x4 xv[4]; float s2 = 0.f;
#pragma unroll
    for (int j = 0; j < 4; ++j) { xv[j] = *(const f32x4*)(xin + 4 * lane + 256 * j); s2 += (xv[j][0] * xv[j][0] + xv[j][1] * xv[j][1]) + (xv[j][2] * xv[j][2] + xv[j][3] * xv[j][3]); }
    const float r2 = 1.f / sqrtf(wave_sum(s2) * (1.f / DM) + RMS_EPS);
#pragma unroll
    for (int j = 0; j < 4; ++j) { u32x2 w; w.x = pkh(xv[j][0], xv[j][1]); w.y = pkh(xv[j][2], xv[j][3]); *(u32x2*)(xh + 4 * lane + 256 * j) = w; }
    if (lane == 0) *rsout = r2;
}

struct RmId { __device__ __forceinline__ int operator()(int n) const { return n; } };
struct RmGate { int off; __device__ __forceinline__ int operator()(int n) const { return (n >> 7) * 256 + off + (n & 127); } };
__device__ __forceinline__ int slot_row(int hs, int d) { return (hs >> 2) * 256 + (d >> 5) * 128 + (hs & 3) * 32 + (d & 31); }
struct RmIn0 { __device__ __forceinline__ int operator()(int n) const {
    int hs, d;
    if (n < 1536) { hs = n >> 6; d = n & 63; }
    else if (n < 1544) { hs = 38; d = n - 1536; }
    else if (n < 2056) { hs = 24 + ((n - 1544) >> 6); d = (n - 1544) & 63; }
    else if (n < 2184) { hs = 32 + ((n - 2056) >> 6); d = (n - 2056) & 63; }
    else if (n < 2312) { hs = 40 + ((n - 2184) >> 6); d = (n - 2184) & 63; }
    else if (n < 2440) { hs = 34 + ((n - 2312) >> 6); d = (n - 2312) & 63; }
    else if (n < 2568) { hs = 42 + ((n - 2440) >> 6); d = (n - 2440) & 63; }
    else if (n < 2696) { hs = 36 + ((n - 2568) >> 6); d = (n - 2568) & 63; }
    else if (n < 2824) { hs = 44 + ((n - 2696) >> 6); d = (n - 2696) & 63; }
    else { hs = 38; d = 8 + (n - 2824); }
    return slot_row(hs, d); } };
struct RmIn1 { __device__ __forceinline__ int operator()(int n) const { return slot_row(n >> 6, n & 63); } };
template <class RM> __device__ __forceinline__ void transpose_item(const float* W, int K, int N, f16* WT, const RM rm, LAS float* scr, int item, int lane, const float* gk = nullptr) {
    const int nblk = N / 32, kb = item / nblk, nb = item % nblk, k0 = 64 * kb, n0 = 32 * nb;
    float wv[32];
#pragma unroll
    for (int i = 0; i < 32; ++i) { const int kk = 2 * i + (lane >> 5); wv[i] = W[(size_t)(k0 + kk) * N + n0 + (lane & 31)]; }
#pragma unroll
    for (int i = 0; i < 32; ++i) { const int kk = 2 * i + (lane >> 5); scr[kk * 33 + (lane & 31)] = gk ? wv[i] * gk[k0 + kk] : wv[i]; }
    LDS_WAIT(); asm volatile("" ::: "memory");
    const int c = lane & 7;
#pragma unroll
    for (int j = 0; j < 4; ++j) { const int n = (lane >> 3) + 8 * j; const LAS float* s = scr + (8 * c) * 33 + n;
        u32x4 o; o.x = pkh(s[0 * 33], s[1 * 33]); o.y = pkh(s[2 * 33], s[3 * 33]); o.z = pkh(s[4 * 33], s[5 * 33]); o.w = pkh(s[6 * 33], s[7 * 33]);
        *(GAS u32x4*)(WT + (size_t)rm(n0 + n) * K + k0 + 8 * c) = o; }
    LDS_WAIT(); asm volatile("" ::: "memory");
}

constexpr int N_PHASES = 15;
struct Args { const float* in[19]; float* out; unsigned char* ws; int ph_lo, ph_hi, rep, pad; };
static_assert(sizeof(Args) == 184 && offsetof(Args, out) == 152 && offsetof(Args, ws) == 160 && offsetof(Args, ph_lo) == 168, "kernarg offsets used by arg_in()");
__device__ __forceinline__ int q_next(gu32* ctr, volatile LAS int* slot, int) {
    __syncthreads();
    if (threadIdx.x == 0) *slot = (int)__hip_atomic_fetch_add(ctr, 1u, __ATOMIC_RELAXED, __HIP_MEMORY_SCOPE_AGENT);
    __syncthreads();
    return *slot;
}
__device__ __forceinline__ const float* arg_in(int k) { const CAS char* kp = (const CAS char*)__builtin_amdgcn_kernarg_segment_ptr(); asm volatile("" : "+s"(kp)); return *(const float* const CAS*)(kp + 8 * k); }
__device__ __forceinline__ f16* slot_ptr(unsigned char* ws, int slot, int b) { return (f16*)(ws + WS_PROJ) + ((size_t)slot * NB + b) * SEQ * HD; }

__global__ void __launch_bounds__(512, 2) trunk_fwd(Args args) {
    extern __shared__ __attribute__((aligned(16))) unsigned char lds_raw[];
    LAS unsigned char* lds = (LAS unsigned char*)lds_raw;
    volatile LAS unsigned* MISC = (volatile LAS unsigned*)(lds + L_MISC);
    volatile LAS int* qslot = (volatile LAS int*)(lds + L_MISC);
    const int G = gridDim.x, bid = blockIdx.x, NGW = G * 8;
    const int qrep = 8 * ((const CAS int*)__builtin_amdgcn_kernarg_segment_ptr())[44];
    unsigned char* ws_ = (unsigned char*)arg_in(20);
    gu32* ctl = (gu32*)(ws_ + WS_CTL);
#define PH_LOCALS unsigned char* ws = ws_; asm volatile("" : "+s"(ws)); const int tid = opaque_tid(), lane = tid & 63; const int wave = __builtin_amdgcn_readfirstlane(tid >> 6); const int gw = bid * 8 + wave; \
    f16* Hb = (f16*)(ws + WS_H); f16* Xh = (f16*)arg_in(19); float* RSb = (float*)(ws + WS_RS); f16* Ob = (f16*)(ws + WS_O); ytype* Yh = (ytype*)(ws + WS_Y); f16* PROJ = (f16*)(ws + WS_PROJ); f16* HID = (f16*)(ws + WS_PROJ); \
    (void)tid; (void)lane; (void)wave; (void)gw; (void)Hb; (void)Xh; (void)RSb; (void)Ob; (void)Yh; (void)PROJ; (void)HID
    if (threadIdx.x < 64) MISC[threadIdx.x] = 0u;
    __syncthreads();
    XcdBarrier bar; bar.bar = (unsigned*)(ctl + CW_BAR); bar.x = 0; bar.st = nullptr;
    if (N_LAUNCH_MODE) bar = xcd_barrier_post((unsigned*)(ctl + CW_BAR), MISC + 8);
    const int lo = ((const CAS int*)__builtin_amdgcn_kernarg_segment_ptr())[42], hi_ = ((const CAS int*)__builtin_amdgcn_kernarg_segment_ptr())[43];
#ifndef PH_MASK
#define PH_MASK 0x3FFu
#endif
#define IN(k) (lo <= (k) && (k) < hi_)
#define INR(r) (IN(pb + (r)))
#define SNAKE(i) ((i) * G + (((i) & 1) ? (G - 1 - bid) : bid))
#define SEAM(k) do { if (IN(k) && IN((k) + 1)) xcd_barrier(bar); } while (0)

    (void)args;

    if (IN(0)) {
        PH_LOCALS;
        LAS float* scr = (LAS float*)(lds + wave * 16384);
        constexpr int I_IN0 = 16 * 89, I_OUT = 16 * 32, I_IN1 = 16 * 96, I_GU = 16 * 88, I_DN = 44 * 32, I_C1 = 32 * 8, I_C2 = 4 * 2;
        constexpr int E0 = I_IN0, E1 = E0 + I_OUT, E2 = E1 + I_IN1, E3 = E2 + I_OUT, E4 = E3 + 4 * I_GU, E5 = E4 + 2 * I_DN, E6 = E5 + 2 * I_C1, E7 = E6 + 2 * I_C2;
        constexpr int Z0 = E7 + 224, Z1 = Z0 + 384, R0 = Z1 + (SEQ * 32) / 64, NBI = 64, CB = R0 + NBI;
        constexpr int SC = CB - E7;
        for (int itr = gw; itr < CB; itr += NGW) {
            const int it = itr < NBI ? R0 + itr : (itr < NBI + (R0 - Z1) ? Z1 + (itr - NBI) : (itr < SC ? E7 + (itr - NBI - (R0 - Z1)) : itr - SC));
            if (it < E0) { transpose_item(arg_in(1), 1024, EVEN_IN, (f16*)(ws + WS_W_IN0), RmIn0{}, scr, it, lane, arg_in(12)); }
            else if (it < E1) { transpose_item(arg_in(9), 1024, 1024, (f16*)(ws + WS_W_OUT0), RmId{}, scr, it - E0, lane); }
            else if (it < E2) { transpose_item(arg_in(10), 1024, 3072, (f16*)(ws + WS_W_IN1), RmIn1{}, scr, it - E1, lane, arg_in(12) + DM); }
            else if (it < E3) { transpose_item(arg_in(11), 1024, 1024, (f16*)(ws + WS_W_OUT1), RmId{}, scr, it - E2, lane); }
            else if (it < E4) { const int r = it - E3, w = r / I_GU, i = r % I_GU; const int layer = w >> 1, up = w & 1;
                transpose_item(arg_in(up ? 17 : 16) + (size_t)layer * 1024 * FF, 1024, FF, (f16*)(ws + (layer ? WS_W_GU1 : WS_W_GU0)), RmGate{up * 128}, scr, i, lane, arg_in(14) + layer * DM); }
            else if (it < E5) { const int r = it - E4, layer = r / I_DN, i = r % I_DN;
                transpose_item(arg_in(18) + (size_t)layer * FF * 1024, FF, 1024, (f16*)(ws + (layer ? WS_W_DN1 : WS_W_DN0)), RmId{}, scr, i, lane); }
            else if (it < E6) { const int r = it - E5, w = r / I_C1, i = r % I_C1;
                transpose_item(arg_in(w ? 7 : 4), 2048, 256, (f16*)(ws + (w ? WS_W_C1V : WS_W_C1K)), RmId{}, scr, i, lane); }
            else if (it < E7) { const int r = it - E6, w = r / I_C2, i = r % I_C2;
                transpose_item(arg_in(w ? 8 : 5), 256, 64, (f16*)(ws + (w ? WS_W_C2V : WS_W_C2K)), RmId{}, scr, i, lane); }
            else if (it < Z0) { const int r = it - E7; int row;
                if (r < 32) row = slot_row(38, 32 + r); else if (r < 96) row = slot_row(39, r - 32); else if (r < 160) row = slot_row(46, r - 96); else row = slot_row(47, r - 160);
                u32x4 z = {0u, 0u, 0u, 0u}; u32x4* p = (u32x4*)((f16*)(ws + WS_W_IN0) + (size_t)row * 1024); p[lane] = z; p[lane + 64] = z; }
            else if (it < Z1) { const int r = it - Z0, w = r / 192, row = 64 + r % 192;
                if (lane < 32) ((u32x4*)((f16*)(ws + (w ? WS_W_C2V : WS_W_C2K)) + (size_t)row * 256))[lane] = (u32x4){0u, 0u, 0u, 0u}; }
            else if (it < R0) { const int e = (it - Z1) * 64 + lane; const int pos = e >> 5, i = e & 31;
                constexpr float INVF[32] = {1.000000000e+00f, 7.498942018e-01f, 5.623413324e-01f, 4.216965139e-01f, 3.162277639e-01f, 2.371373773e-01f, 1.778279394e-01f, 1.333521456e-01f, 1.000000015e-01f, 7.498942316e-02f, 5.623413250e-02f, 4.216964915e-02f, 3.162277490e-02f, 2.371373773e-02f, 1.778279431e-02f, 1.333521400e-02f, 9.999999776e-03f, 7.498942316e-03f, 5.623413250e-03f, 4.216964822e-03f, 3.162277630e-03f, 2.371373819e-03f, 1.778279431e-03f, 1.333521446e-03f, 1.000000047e-03f, 7.498941850e-04f, 5.623413017e-04f, 4.216965172e-04f, 3.162277571e-04f, 2.371373703e-04f, 1.778279402e-04f, 1.333521504e-04f};
                const float ang = (float)pos * INVF[i];
                const double a_ = (double)ang, kk_ = rint(a_ * 0.15915494309189535); double r_ = fma(-kk_, 6.283185307179586, a_); r_ = fma(-kk_, 2.4492935982947064e-16, r_);
                const float rf_ = (float)r_;
                ((float*)(ws + WS_COS))[e] = cosf(rf_); ((float*)(ws + WS_SIN))[e] = sinf(rf_); }
            else { const int r = it - R0, part = r >> 3, w = (r >> 2) & 1, n = (r & 3) * 64 + lane;
                const float* pe = arg_in(w ? 6 : 3) + 256 * part; const float* w1 = arg_in(w ? 7 : 4) + (size_t)256 * part * 256; float sa[8];
#pragma unroll
                for (int i = 0; i < 8; ++i) sa[i] = 0.f;
                for (int k = 0; k < 256; k += 8) {
#pragma unroll
                    for (int i = 0; i < 8; ++i) sa[i] += pe[k + i] * w1[(size_t)(k + i) * 256 + n]; }
                ((float*)(ws + WS_CBIAS))[part * 512 + w * 256 + n] = ((sa[0] + sa[1]) + (sa[2] + sa[3])) + ((sa[4] + sa[5]) + (sa[6] + sa[7])); }
        }
        const float* xin0 = arg_in(0);
        for (int m = gw; m < MROWS / 2; m += NGW) norm0_rows2(xin0 + (size_t)m * DM, Xh + (size_t)m * DM, RSb + m, (size_t)(MROWS / 2), lane);
    }
    SEAM(0);

    for (int layer = 0; layer < 2; ++layer) {
        const int pb = 1 + 8 * layer;
        const int ro = layer == 0 ? 7 : 4;
        if (INR(0)) {
            PH_LOCALS;
            pg8::Gemm g{Xh, (const f16*)(ws + (layer ? WS_W_IN1 : WS_W_IN0)), 1024, 1024}; pg8::StaticOrder S; S.init(MROWS, NIN, G, bid);
            pg8::EpiInProj E{PROJ, (const float*)(ws + WS_COS), (const float*)(ws + WS_SIN), (float*)(ws + WS_LOGF), (float*)(ws + WS_GATES), arg_in(2), layer, RSb, (f16*)(ws + WS_KBAR), (LAS float*)(lds + L_WSF)};
            pg8::gemm_phase<pg8::EpiInProj, pg8::StaticOrder, true>(lds, g, S, E);
        }
        SEAM(pb);
        if (layer == 0) {
            if (INR(1)) {
                PH_LOCALS;
                if (bid < 16) scan_bh((const float*)(ws + WS_LOGF) + (size_t)bid * SEQ, (float*)(ws + WS_C) + (size_t)bid * SEQ, lds);
                for (int u = bid; u < 1024; u += G) { const int bh = u >> 6, blk = u & 63, b = bh >> 3, h = bh & 7;
                    fox_norm_unit(slot_ptr(ws, h, b) + (size_t)256 * blk * HD, slot_ptr(ws, 8 + h, b) + (size_t)256 * blk * HD, (float*)(ws + WS_QN2) + u, (float*)(ws + WS_QN2) + 1024 + u, ctl + CW_KN2 + bh, lds); }
                if (bid >= G - 32) {
                    const int cb = bid - (G - 32), which = cb >> 4, pm = cb & 15;
                    int c1k = 2048, c1lda = 1024, c2k = 256; asm volatile("" : "+s"(c1k), "+s"(c1lda), "+s"(c2k));
                    f16* hid = (f16*)(ws + (which ? WS_HIDV : WS_HIDK));
                    { pg8::Gemm g{slot_ptr(ws, which ? 38 : 32, 0), (const f16*)(ws + (which ? WS_W_C1V : WS_W_C1K)), c1lda, c1k}; pg8::SingleOrder S{{pm, 0}, G > 0 ? 1 : 0};
                      pg8::EpiCmp1 E{hid, (const float*)(ws + WS_CBIAS) + which * 256};
                      pg8::gemm_phase<pg8::EpiCmp1, pg8::SingleOrder, false>(lds, g, S, E); }
                    VM_WAIT(); __syncthreads(); __builtin_amdgcn_fence(__ATOMIC_ACQUIRE, "agent"); VM_WAIT(); __syncthreads();
                    { pg8::Gemm g{hid, (const f16*)(ws + (which ? WS_W_C2V : WS_W_C2K)), c2k, c2k}; pg8::SingleOrder S{{pm, 0}, G > 0 ? 1 : 0};
                      pg8::EpiCmp2 E{(f16*)(ws + (which ? WS_VCMP : WS_KCMP))};
                      pg8::gemm_phase<pg8::EpiCmp2, pg8::SingleOrder, false>(lds, g, S, E); }
                }
                ((LAS unsigned*)(lds + L_SEL))[opaque_tid() & 7] = 0xFFFFFFFFu;
                for (int u = q_next(ctl + CW_Q + qrep, qslot, tid); u < 1024; u = q_next(ctl + CW_Q + qrep, qslot, tid)) {
                    const int qt = 255 - (u >> 2), b = (u & 3) >> 1, g = u & 1; const int tq = opaque_tid(); const int wv = __builtin_amdgcn_readfirstlane(tq >> 6);
                    const int hd = 4 * g + (wv >> 1), ql = 32 * (wv & 1) + (tq & 31);
                    const int t0 = qt >= 8 ? qt - 8 : 0;
                    fa::unit_sel<8, fa::EpiWinGate>(slot_ptr(ws, 24 + hd, b) + (size_t)(64 * qt + ql) * HD, slot_ptr(ws, 36 + g, b) + (size_t)t0 * 64 * HD, slot_ptr(ws, 42 + g, b) + (size_t)t0 * 64 * HD,
                        (const LAS unsigned*)(lds + L_SEL), qt - t0, ql, qt >= 8,
                        fa::EpiWinGate{(const float*)(ws + WS_GATES), Ob, b, hd, 64 * qt + 32 * (wv & 1)}, (char*)lds_raw);
                }
            }
            SEAM(pb + 1);
            if (INR(2)) {
                PH_LOCALS;
                for (int u = q_next(ctl + CW_Q + 64 + qrep, qslot, tid); u < 1024; u = q_next(ctl + CW_Q + 64 + qrep, qslot, tid)) {
                    const int qb = 63 - (u >> 4), b = (u & 15) >> 3, h = u & 7; const int tq = opaque_tid(); const int wv = __builtin_amdgcn_readfirstlane(tq >> 6); const int row = 256 * qb + 32 * wv + (tq & 31);
                    const float* cbh = (const float*)(ws + WS_C) + ((size_t)b * 8 + h) * SEQ;
                    int t0 = 0;
                    { const float bnd = sqrtf(((const float*)(ws + WS_QN2))[((b * 8 + h) << 6) + qb] * __uint_as_float(__hip_atomic_load(ctl + CW_KN2 + b * 8 + h, __ATOMIC_RELAXED, __HIP_MEMORY_SCOPE_AGENT)))
                                        - ((const float*)(ws + WS_QN2))[1024 + ((b * 8 + h) << 6) + qb] + 1.f;
                      const float cq0 = cbh[256 * qb]; const int ln = tq & 63; int cntv = 0;
#pragma unroll
                      for (int i = 0; i < 4; ++i) { const int tt = ln + 64 * i; const bool sk = (tt < 4 * qb) && (bnd + cq0 - cbh[64 * tt + 63] < -40.f); cntv += __popcll(__ballot(sk)); }
                      t0 = __builtin_amdgcn_readfirstlane(cntv) & ~1; }
                    fa::unit<8, true, true, fa::EpiPlain>(slot_ptr(ws, h, b) + (size_t)row * HD, slot_ptr(ws, 8 + h, b) + (size_t)t0 * 64 * HD, slot_ptr(ws, 16 + h, b) + (size_t)t0 * 64 * HD, cbh + row, cbh + 64 * t0, 4 * qb + 4 - t0, fa::QREL_ROW,
                                      fa::EpiPlain{Ob + ((size_t)b * SEQ + 256 * qb + 32 * wv) * DM + h * HD, DM}, (char*)lds_raw);
                }
                for (int u = q_next(ctl + CW_Q + 128 + qrep, qslot, tid); u < 1024; u = q_next(ctl + CW_Q + 128 + qrep, qslot, tid)) {
                    nsa_cmp_unit(PROJ, (const f16*)(ws + WS_KCMP), (const f16*)(ws + WS_VCMP), (const float*)(ws + WS_GATES), Ob, (unsigned*)(ws + WS_SLIST) + (size_t)((u & 3)) * SL_BG, ctl + CW_SCNT + 256 * (u & 3), (u & 3) >> 1, u & 1, 255 - (u >> 2), lds, (char*)lds_raw);
                }
            }
            SEAM(pb + 2);
            for (int b = 0; b < 2; ++b) {
                constexpr size_t SPO_G = 52 * MiB, SPML_G = 7 * MiB;
                if (INR(3 + 2 * b)) {
                    PH_LOCALS;
                    LAS int* pref = (LAS int*)(lds + 102400);
                    __syncthreads();
                    { const int jj = tid & 255; const int n = (jj >= 1 && jj <= 253) ? (int)__hip_atomic_load(ctl + CW_SCNT + 256 * (2 * b) + tid, __ATOMIC_RELAXED, __HIP_MEMORY_SCOPE_AGENT) : 0; pref[tid + 1] = (n + PIECE - 1) / PIECE; }
                    if (tid == 0) pref[0] = 0;
                    __syncthreads();
                    for (int st = 1; st < 512; st <<= 1) { int v = 0; if (tid + 1 > st) v = pref[tid + 1 - st]; __syncthreads(); if (tid + 1 > st) pref[tid + 1] += v; __syncthreads(); }
                    const int nunits = pref[512];
                    for (int u = q_next(ctl + CW_Q + 512 + 64 * b + qrep, qslot, tid); u < nunits; u = q_next(ctl + CW_Q + 512 + 64 * b + qrep, qslot, tid)) {
                        int lo_ = 0, hi2 = 511;
                        while (lo_ < hi2) { const int mid = (lo_ + hi2 + 1) >> 1; if (pref[mid] <= u) lo_ = mid; else hi2 = mid - 1; }
                        const int g = lo_ >> 8, j = lo_ & 255, piece = u - pref[lo_], rnd = 2 * b + g;
                        const int n = (int)__hip_atomic_load(ctl + CW_SCNT + 256 * rnd + j, __ATOMIC_RELAXED, __HIP_MEMORY_SCOPE_AGENT);
                        const int cnt = (n - PIECE * piece) < PIECE ? (n - PIECE * piece) : PIECE;
                        sel_gather_unit(PROJ, b, g, j, (const unsigned*)(ws + WS_SLIST) + (size_t)rnd * SL_BG + sl_off(j) + PIECE * piece, cnt, (unsigned char*)(ws + WS_SPO + g * SPO_G), (float*)(ws + WS_SPML + g * SPML_G), lds);
                    }
                }
                SEAM(pb + 3 + 2 * b);
                if (INR(4 + 2 * b)) {
                    PH_LOCALS;
                    for (int u = bid; u < 512; u += G) {
                        const int g = u & 1;
                        SelMergeF f; f.proj = PROJ; f.PO = (const unsigned char*)(ws + WS_SPO + g * SPO_G); f.PML = (const float*)(ws + WS_SPML + g * SPML_G); f.gates = (const float*)(ws + WS_GATES); f.O = Ob;
                        f.b = b; f.g = g; f.qt = 255 - (u >> 1); f.nsl = f.qt - 2 < 0 ? 0 : (f.qt - 2 > 13 ? 13 : f.qt - 2);
                        attn_unit(f, lds);
                    }
                }
                SEAM(pb + 4 + 2 * b);
            }
        } else {
            if (INR(1)) { PH_LOCALS; for (int u = bid; u < 2048; u += G) moba_gate_unit(slot_ptr(ws, 0, 0), (const f16*)(ws + WS_KBAR), (unsigned short*)(ws + WS_LISTS), ctl + CW_LCNT, u, lds); }
            SEAM(pb + 1);
#define PO_HEAD(half, hh) ((half) == 0 ? (f16*)(ws + WS_Y) + (size_t)(hh) * (SEQ * 192) : (hh) < 10 ? (f16*)((unsigned char*)arg_in(19) + 64 * MiB) + (size_t)(hh) * (SEQ * 192) \
        : (hh) < 14 ? (f16*)(ws + WS_H + 40 * MiB) + (size_t)((hh) - 10) * (SEQ * 192) : (f16*)(ws + WS_Y + 102 * MiB) + (size_t)((hh) - 14) * (SEQ * 192))
#define PML_HEAD(half, hh) ((float*)(ws + WS_Y + ((half) ? 114 : 96) * MiB) + (size_t)(hh) * (SEQ * 6))
            if (INR(2)) {
                PH_LOCALS;
                for (int u = q_next(ctl + CW_Q + 256 + qrep, qslot, tid); u < 63 * 32; u = q_next(ctl + CW_Q + 256 + qrep, qslot, tid)) {
                    const int j = u >> 5, half = (u >> 4) & 1, hh = u & 15, bh = hh * 2 + half;
                    const int n = (int)__hip_atomic_load(ctl + CW_LCNT + bh * 64 + j, __ATOMIC_RELAXED, __HIP_MEMORY_SCOPE_AGENT);
                    const unsigned short* ent = (const unsigned short*)(ws + WS_LISTS) + (size_t)bh * LIST_BH + list_off(j);
                    const f16* qs = slot_ptr(ws, 0, 0) + (size_t)bh * SEQ * HD; const f16* ks = slot_ptr(ws, 16, 0) + ((size_t)bh * SEQ + 256 * j) * HD; const f16* vs = slot_ptr(ws, 32, 0) + ((size_t)bh * SEQ + 256 * j) * HD;
                    moba_gather_unit3(qs, ks, vs, ent, n, 0, PO_HEAD(half, hh), PML_HEAD(half, hh), lds, (char*)lds_raw);
                }
            }
            SEAM(pb + 2);
            if (INR(3)) {
                PH_LOCALS;
                for (int u = q_next(ctl + CW_Q + 384 + qrep, qslot, tid); u < 2048; u = q_next(ctl + CW_Q + 384 + qrep, qslot, tid)) {
                    const int qb = 63 - (u >> 5), half = (u >> 4) & 1, hh = u & 15, bh = hh * 2 + half; const int tq = opaque_tid(); const int wv = __builtin_amdgcn_readfirstlane(tq >> 6); const int row = 256 * qb + 32 * wv + (tq & 31);
                    const f16* ks = slot_ptr(ws, 16, 0) + ((size_t)bh * SEQ + 256 * qb) * HD; const f16* vs = slot_ptr(ws, 32, 0) + ((size_t)bh * SEQ + 256 * qb) * HD;
                    fa::unit<8, false, true, fa::EpiMerge>(slot_ptr(ws, 0, 0) + ((size_t)bh * SEQ + row) * HD, ks, vs, nullptr, nullptr, 4, fa::QREL_ROW,
                        fa::EpiMerge{PO_HEAD(half, hh), PML_HEAD(half, hh), (size_t)(256 * qb + 32 * wv), qb < 3 ? qb : 3, Ob + ((size_t)half * SEQ + 256 * qb + 32 * wv) * DM + hh * HD, DM}, (char*)lds_raw);
                }
            }
            SEAM(pb + 3);
#undef PO_HEAD
#undef PML_HEAD
        }
        const bool segA = INR(ro), segB = layer == 0 ? INR(ro) : INR(ro + 1);
#define PAIR_LEARN() do { if (MISC[15] == 0u) { __syncthreads(); if (opaque_tid() == 0) MISC[15] = (__hip_atomic_load(pctr + 8 + (1 - pr), __ATOMIC_RELAXED, __HIP_MEMORY_SCOPE_AGENT) == xb_xcc_id() + 1u) ? 2u : 1u; \
        __syncthreads(); same_l2 = MISC[15] == 2u; } } while (0)
        if (segA || segB) {
            PH_LOCALS;
            const int pr = (bid >> 3) & 1, pairidx = (bid >> 4) * 8 + (bid & 7), npairs = G >> 1;
            gu32* pctr = ctl + CW_PAIR + 64 * pairidx; unsigned* ptmo = (unsigned*)(ctl + CW_BAR) + XB_TMO;
            unsigned psn = MISC[14];
            bool same_l2 = MISC[15] == 2u;
            if (MISC[15] == 0u && opaque_tid() == 0) __hip_atomic_store(pctr + 8 + pr, xb_xcc_id() + 1u, __ATOMIC_RELAXED, __HIP_MEMORY_SCOPE_AGENT);
            f16* xdst = layer == 0 ? Xh : Hb;
            if (segA) {
                for (int p = pairidx; p < MROWS / 256; p += npairs) {
                    { pg8::Gemm g{Ob, (const f16*)(ws + (layer ? WS_W_OUT1 : WS_W_OUT0)), 1024, 1024}; pg8::PairOrder S{p, 2 * pr, 2};
                      pg8::EpiF16 E{Yh, DM};
                      pg8::gemm_phase<pg8::EpiF16, pg8::PairOrder, true>(lds, g, S, E); }
                    psn += 2; pair_sync(pctr, psn, ptmo, same_l2); PAIR_LEARN();
                    { const int tq = opaque_tid(); const int wv = __builtin_amdgcn_readfirstlane(tq >> 6), ln = tq & 63; const int m0 = 256 * p + 128 * pr + 16 * wv;
                      norm_rows16<false>(Xh + (size_t)m0 * DM, Yh + (size_t)m0 * DM, xdst + (size_t)m0 * DM, RSb + m0, nullptr, arg_in(13) + layer * DM, ln); }
                }
            }
            if (layer == 1) { if (opaque_tid() == 0) MISC[14] = psn; SEAM(pb + ro); psn = MISC[14]; }
            if (segB) {
                for (int p = pairidx; p < MROWS / 256; p += npairs) {
                    if (layer == 0) { psn += 2; pair_sync(pctr, psn, ptmo, same_l2); PAIR_LEARN(); }
                    { pg8::Gemm g{xdst, (const f16*)(ws + (layer ? WS_W_GU1 : WS_W_GU0)), 1024, 1024}; pg8::PairOrder S{p, 11 * pr, 11};
                      pg8::EpiSwiGLU E{HID, RSb};
                      pg8::gemm_phase<pg8::EpiSwiGLU, pg8::PairOrder, true>(lds, g, S, E); }
                    psn += 2; pair_sync(pctr, psn, ptmo, same_l2); PAIR_LEARN();
                    { pg8::Gemm g{HID, (const f16*)(ws + (layer ? WS_W_DN1 : WS_W_DN0)), FF, FF}; pg8::PairOrder S{p, 2 * pr, 2};
                      pg8::EpiF16 E{Yh, DM};
                      pg8::gemm_phase<pg8::EpiF16, pg8::PairOrder, true>(lds, g, S, E); }
                    psn += 2; pair_sync(pctr, psn, ptmo, same_l2); PAIR_LEARN();
                    { const int tq = opaque_tid(); const int wv = __builtin_amdgcn_readfirstlane(tq >> 6), ln = tq & 63; const int m0 = 256 * p + 128 * pr + 16 * wv;
                      if (layer == 0) norm_rows16<false>(Xh + (size_t)m0 * DM, Yh + (size_t)m0 * DM, Xh + (size_t)m0 * DM, RSb + m0, nullptr, arg_in(15), ln);
                      else norm_rows16<true>(Hb + (size_t)m0 * DM, Yh + (size_t)m0 * DM, nullptr, nullptr, (float*)arg_in(19) + (size_t)m0 * DM, arg_in(15) + DM, ln); }
                }
            }
            __syncthreads();
            if (opaque_tid() == 0) MISC[14] = psn;
        } else if (layer == 1) { SEAM(pb + ro); }
        SEAM(pb + ro + (layer == 0 ? 0 : 1));
#undef PAIR_LEARN
    }
#undef IN
#undef SEAM
}

extern "C" void kernel_launch(void* const* d_in, const int* in_sizes, int n_in, void* d_out, int out_size, void* d_ws, size_t ws_size, hipStream_t stream) {
    static int grid = 0;
    if (grid == 0) {
        if (n_in != 19 || out_size != MROWS * DM || ws_size < WS_END) { fprintf(stderr, "kernel_launch: unexpected problem (n_in %d, out %d, ws %zu)\n", n_in, out_size, ws_size); grid = -1; return; }
        int dev = 0, cus = 0, per_cu = 0;
        if (hipGetDevice(&dev) != hipSuccess || hipDeviceGetAttribute(&cus, hipDeviceAttributeMultiprocessorCount, dev) != hipSuccess) { grid = -1; return; }
        if (hipFuncSetAttribute((const void*)trunk_fwd, hipFuncAttributeMaxDynamicSharedMemorySize, LDS_BYTES) != hipSuccess) { fprintf(stderr, "kernel_launch: hipFuncSetAttribute failed\n"); grid = -1; return; }
        if (hipOccupancyMaxActiveBlocksPerMultiprocessor(&per_cu, (const void*)trunk_fwd, 512, LDS_BYTES) != hipSuccess || per_cu < 1) fprintf(stderr, "kernel_launch: occupancy query says %d\n", per_cu);
        (void)hipGetLastError();
        grid = cus;
        if (cus % 16 != 0 || N_LAUNCH_MODE == 0) { fprintf(stderr, "kernel_launch: the token-local chain pairs workgroups c and c + 8 in one launch (needs a CU count that is a multiple of 16; got %d)\n", cus); grid = -1; return; }
    }
    if (grid < 0) return;
    (void)hipMemsetAsync((char*)d_ws + WS_CTL, 0, CTL_ZERO_BYTES, stream);
    Args a{};
    for (int i = 0; i < 19; ++i) a.in[i] = (const float*)d_in[i];
    a.out = (float*)d_out; a.ws = (unsigned char*)d_ws;
#if N_LAUNCH_MODE
    a.ph_lo = 0; a.ph_hi = N_PHASES;
    hipLaunchKernelGGL(trunk_fwd, dim3(grid), dim3(512), LDS_BYTES, stream, a);
#else
    for (int p = 0; p < N_PHASES; ++p) { a.ph_lo = p; a.ph_hi = p + 1; a.rep = 0; hipLaunchKernelGGL(trunk_fwd, dim3(grid), dim3(512), LDS_BYTES, stream, a);
#ifdef REPEAT_PHASES
        if ((REPEAT_PHASES >> p) & 1) for (int r = 1; r <= 2; ++r) { a.rep = r; hipLaunchKernelGGL(trunk_fwd, dim3(grid), dim3(512), LDS_BYTES, stream, a); }
#endif
    }
#endif
}
```
